# Optimizing an MI355X kernel written in HIP

```python
import math
import jax
import jax.numpy as jnp
from jax import lax
import numpy as np

D_MODEL = 2048
BATCH = 8
SEQ = 2048
DEPTH = 2
DEC_BATCH = 32
DEC_SEQ = 4
PAST_LEN = 8192
PAGE_SIZE = 128

N_A = DEPTH // 2
N_B = DEPTH - N_A
HEAD_DIM = 128
MIX_WIDTH = D_MODEL
MEM_HEADS = 4
MEM_LEN = 256
MEM_WIDTH = MEM_HEADS * HEAD_DIM
TOK_WIDTH = MIX_WIDTH - MEM_WIDTH
H_A = TOK_WIDTH // HEAD_DIM
DK_A = HEAD_DIM
DV_A = HEAD_DIM
HGRN_CHUNK = 32
H_B = TOK_WIDTH // HEAD_DIM
G_B = 2
HPG = H_B // G_B
CMP_BLOCK = 32
CMP_STRIDE = 16
SEL_BLOCK = 64
N_SEL = 16
WINDOW = 512
SEL_QBLOCK = 16
WIN_QBLOCK = 128
FORCE_BONUS = 1e4
D_FF = 11 * D_MODEL // 4
CONV_W = 3
N_KV_ROWS = 4
EPS = 1e-6
NEG = -1e30
SCALE = HEAD_DIM ** -0.5

kernel_name = 'yoco_hgrn2_nsa_memory_step'


def rmsnorm(x, g):
    xf = x.astype(jnp.float32)
    y = xf * lax.rsqrt(jnp.mean(xf * xf, axis=-1, keepdims=True) + EPS)
    return (y * g.astype(jnp.float32)).astype(x.dtype)


def masked_softmax(s, mask):
    s = jnp.where(mask, s, NEG)
    m = jnp.max(s, axis=-1, keepdims=True)
    p = jnp.exp(s - m) * mask
    return p / jnp.maximum(jnp.sum(p, axis=-1, keepdims=True), 1e-30)


def alibi_slopes():
    h = np.arange(1, H_B + 1, dtype=np.float32)
    return jnp.asarray(np.exp2(-8.0 * h / H_B).astype(np.float32)).reshape(G_B, HPG)


def hgrn2_chunked(q, k, v, logf, s0):
    B, T, H, _ = q.shape
    C = math.gcd(T, HGRN_CHUNK)
    n = T // C

    def chunks(a):
        return a.reshape(B, n, C, *a.shape[2:]).swapaxes(0, 1)

    causal = jnp.tril(jnp.ones((C, C), dtype=bool))[None, :, :, None, None]

    def step(S, inp):
        qc, kc, vc, lc = inp
        b = jnp.cumsum(lc, axis=1)
        diff = b[:, :, None] - b[:, None, :]
        decay = jnp.where(causal, jnp.exp(jnp.where(causal, diff, 0.0)), 0.0)
        a = jnp.einsum('bthk,bshk,btshk->btsh', qc, kc, decay)
        o = jnp.einsum('btsh,bshv->bthv', a, vc) + jnp.einsum('bthk,bhkv->bthv', qc * jnp.exp(b), S)
        b_last = b[:, -1]
        S = jnp.exp(b_last)[..., None] * S + jnp.einsum(
            'bshk,bshv->bhkv', kc * jnp.exp(b_last[:, None] - b), vc)
        return S, o

    S, o = lax.scan(step, s0, (chunks(q), chunks(k), chunks(v), chunks(logf)))
    return o.swapaxes(0, 1).reshape(B, T, H, -1), S


def hgrn2_mixer(xn, w_in, lb, gnorm, s0):
    B, T, _ = xn.shape
    W = TOK_WIDTH
    u = xn @ w_in

    def hs(a):
        return a.reshape(B, T, H_A, -1)

    q = hs(jax.nn.silu(u[..., :W].astype(jnp.float32)))
    fg = lb + (1.0 - lb) * jax.nn.sigmoid(u[..., W:2 * W].astype(jnp.float32))
    k = hs(1.0 - fg)
    logf = hs(jnp.log(fg))
    v = hs(u[..., 2 * W:3 * W].astype(jnp.float32))
    og = hs(jax.nn.sigmoid(u[..., 3 * W:4 * W].astype(jnp.float32)))
    mem_q = u[..., 4 * W:].reshape(B, T, MEM_HEADS, HEAD_DIM)
    o, s_fin = hgrn2_chunked(q, k, v, logf, s0.astype(jnp.float32))
    o = rmsnorm(o, gnorm) * og
    return o.reshape(B, T, W).astype(xn.dtype), mem_q, s_fin


def compress(seq, pe, w1, w2):
    B, L = seq.shape[:2]
    r = CMP_BLOCK // CMP_STRIDE
    nch = L // CMP_STRIDE
    nc = nch - r + 1
    ch = seq[:, :nch * CMP_STRIDE].reshape(B, nch, CMP_STRIDE, G_B, HEAD_DIM)
    w1r = w1.reshape(r, CMP_STRIDE, HEAD_DIM, HEAD_DIM)
    part = jnp.einsum('bcsgd,jsdh->jbcgh', ch, w1r)
    pre = jnp.einsum('jsd,jsdh->h', pe.reshape(r, CMP_STRIDE, HEAD_DIM), w1r)
    for j in range(r):
        pre = pre + part[j][:, j:j + nc]
    return jax.nn.gelu(pre) @ w2


def shared_kv(h, kv_past, win_past, prm):
    B, T, _ = h.shape
    kv = (rmsnorm(h, prm['kv_norm']) @ prm['w_kv_b']).reshape(B, T, N_KV_ROWS + 2, G_B, HEAD_DIM)
    rows, win_rows = kv[:, :, :N_KV_ROWS], kv[:, :, N_KV_ROWS:]
    if kv_past is None:
        full = rows
        nb = T // WIN_QBLOCK
        kidx = jnp.arange(nb)[:, None] * WIN_QBLOCK + jnp.arange(WIN_QBLOCK + WINDOW)[None, :]
        wpad = jnp.pad(win_rows, ((0, 0), (WINDOW, 0), (0, 0), (0, 0), (0, 0)))
        wblk = wpad[:, kidx]
        wkpos = kidx - WINDOW
    else:
        past = kv_past.shape[1]
        full = jnp.concatenate([kv_past.astype(rows.dtype), rows], axis=1)
        wb = win_past.shape[1]
        wblk = jnp.concatenate([win_past.astype(win_rows.dtype), win_rows], axis=1)[:, None]
        wkpos = (past - wb + jnp.arange(wb + T))[None, :]
    L = full.shape[1]
    ns = -(-L // SEL_BLOCK)
    kc = compress(full[:, :, 0], prm['cmp_pos'][0], prm['w_cmp1'][0], prm['w_cmp2'][0])
    vc = compress(full[:, :, 1], prm['cmp_pos'][1], prm['w_cmp1'][1], prm['w_cmp2'][1])
    sel = jnp.pad(full[:, :, 2:4], ((0, 0), (0, ns * SEL_BLOCK - L), (0, 0), (0, 0), (0, 0)))
    sel = sel.reshape(B, ns, SEL_BLOCK, 2, G_B, HEAD_DIM)
    shared = dict(kc=kc, vc=vc, kb=sel[:, :, :, 0], vb=sel[:, :, :, 1],
                  wk=wblk[:, :, :, 0], wv=wblk[:, :, :, 1], wkpos=wkpos)
    return shared, rows, win_rows


def cmp_branch(q, qpos, kc, vc, slopes):
    nc = kc.shape[1]
    s = jnp.einsum('btgrd,bigd->btgri', q, kc).astype(jnp.float32) * SCALE
    end = jnp.arange(nc) * CMP_STRIDE + CMP_BLOCK - 1
    dist = qpos[:, None] - end[None, :]
    mask = (dist >= 0)[None, :, None, None, :]
    s = s - slopes[None, None, :, :, None] * dist.astype(jnp.float32)[None, :, None, None, :]
    p = masked_softmax(s, mask)
    o = jnp.einsum('btgri,bigd->btgrd', p.astype(vc.dtype), vc)
    return o, p.sum(axis=3)


def cmp_to_sel(p, ns):
    r = SEL_BLOCK // CMP_STRIDE
    back = CMP_BLOCK // CMP_STRIDE - 1
    nc = p.shape[-1]
    pp = jnp.pad(p, [(0, 0)] * (p.ndim - 1) + [(back, r * ns - nc)])
    out = pp[..., 0:r * (ns - 1) + 1:r]
    for o in range(1, back + r):
        out = out + pp[..., o:o + r * (ns - 1) + 1:r]
    return out


def select_blocks(imp, qpos, ns):
    p = cmp_to_sel(imp, ns)
    j = jnp.arange(ns)[None, :]
    cur = (qpos // SEL_BLOCK)[:, None]
    valid = (j <= cur)[None, :, None, :]
    forced = ((j == 0) | (j == cur) | (j == cur - 1))[None, :, None, :]
    score = jnp.where(valid, p + jnp.where(forced, FORCE_BONUS, 0.0), NEG)
    _, idx = lax.top_k(score, min(N_SEL, ns))
    ok = idx <= cur[None, :, :, None]
    return idx, ok


def sel_branch(q, qpos, idx, ok, kb, vb, slopes):
    B, T = q.shape[:2]
    qb = math.gcd(T, SEL_QBLOCK)
    nq = T // qb

    def split(a):
        return a.reshape(B, nq, qb, *a.shape[2:]).swapaxes(0, 1)

    bi = jnp.arange(B)[:, None, None, None]
    gi = jnp.arange(G_B)[None, None, :, None]

    def blk(args):
        qq, pp, ii, oo = args
        kk = kb[bi, ii, :, gi]
        vv = vb[bi, ii, :, gi]
        n = ii.shape[-1]
        s = jnp.einsum('bqgrd,bqgnkd->bqgrnk', qq, kk).astype(jnp.float32) * SCALE
        kpos = ii[..., None] * SEL_BLOCK + jnp.arange(SEL_BLOCK)
        dist = pp[None, :, None, None, None] - kpos
        mask = oo[..., None] & (dist >= 0)
        s = s - slopes[None, None, :, :, None, None] * dist.astype(jnp.float32)[:, :, :, None]
        s = s.reshape(B, qb, G_B, HPG, n * SEL_BLOCK)
        p = masked_softmax(s, mask.reshape(B, qb, G_B, 1, n * SEL_BLOCK))
        p = p.reshape(B, qb, G_B, HPG, n, SEL_BLOCK)
        return jnp.einsum('bqgrnk,bqgnkd->bqgrd', p.astype(vv.dtype), vv)

    o = lax.map(blk, (split(q), qpos.reshape(nq, qb), split(idx), split(ok)))
    return o.swapaxes(0, 1).reshape(B, T, G_B, HPG, HEAD_DIM)


def win_branch(q, qpos, wk, wv, wkpos, slopes):
    B, T = q.shape[:2]
    nb = wkpos.shape[0]
    qb = T // nb
    qs = q.reshape(B, nb, qb, G_B, HPG, HEAD_DIM).swapaxes(0, 1)

    def blk(args):
        qq, pp, kk, vv, kp = args
        s = jnp.einsum('bqgrd,bkgd->bqgrk', qq, kk).astype(jnp.float32) * SCALE
        dist = pp[:, None] - kp[None, :]
        mask = (dist >= 0) & (dist < WINDOW) & (kp[None, :] >= 0)
        s = s - slopes[None, None, :, :, None] * dist.astype(jnp.float32)[None, :, None, None, :]
        p = masked_softmax(s, mask[None, :, None, None, :])
        return jnp.einsum('bqgrk,bkgd->bqgrd', p.astype(vv.dtype), vv)

    o = lax.map(blk, (qs, qpos.reshape(nb, qb), wk.swapaxes(0, 1), wv.swapaxes(0, 1), wkpos))
    return o.swapaxes(0, 1).reshape(B, T, G_B, HPG, HEAD_DIM)


def nsa_mixer(xn, w_in, sh, qpos, slopes):
    B, T, _ = xn.shape
    u = xn @ w_in
    q = u[..., :TOK_WIDTH].reshape(B, T, G_B, HPG, HEAD_DIM)
    gates = jax.nn.sigmoid(u[..., TOK_WIDTH:TOK_WIDTH + 3 * H_B].astype(jnp.float32))
    gates = gates.reshape(B, T, G_B, HPG, 3)
    mem_q = u[..., TOK_WIDTH + 3 * H_B:].reshape(B, T, MEM_HEADS, HEAD_DIM)
    o_cmp, imp = cmp_branch(q, qpos, sh['kc'], sh['vc'], slopes)
    idx, ok = select_blocks(imp, qpos, sh['kb'].shape[1])
    o_sel = sel_branch(q, qpos, idx, ok, sh['kb'], sh['vb'], slopes)
    o_win = win_branch(q, qpos, sh['wk'], sh['wv'], sh['wkpos'], slopes)
    o = (gates[..., 0:1] * o_cmp.astype(jnp.float32) + gates[..., 1:2] * o_sel.astype(jnp.float32)
         + gates[..., 2:3] * o_win.astype(jnp.float32))
    return o.reshape(B, T, TOK_WIDTH).astype(xn.dtype), mem_q


def mem_attend(q, mkv):
    B, T = q.shape[:2]
    k, v = mkv[:, :, 0], mkv[:, :, 1]
    s = jnp.einsum('bthd,bmhd->bthm', q, k.astype(q.dtype)).astype(jnp.float32) * SCALE
    p = jax.nn.softmax(s, axis=-1)
    return jnp.einsum('bthm,bmhd->bthd', p.astype(q.dtype), v.astype(q.dtype)).reshape(B, T, MEM_WIDTH)


def conv_ffn(x, buf, w_in, w_conv, b_conv, w_out):
    T = x.shape[1]
    u = x @ w_in
    a, b = u[..., :D_FF], u[..., D_FF:]
    ext = jnp.concatenate([buf.astype(a.dtype), a], axis=1)
    c = b_conv
    for j in range(CONV_W):
        c = c + ext[:, j:j + T] * w_conv[j]
    y = (jax.nn.gelu(c) * b) @ w_out
    return y, ext[:, ext.shape[1] - (CONV_W - 1):]


def trunk(x, qpos, mem_kv, hgrn_s0, conv_buf0, kv_past, win_past, prm):
    B = x.shape[0]
    slopes = alibi_slopes()
    lbs = jnp.cumsum(jax.nn.softmax(prm['lb_logits'].astype(jnp.float32), axis=0), axis=0)
    h = x
    shared, kv_rows, win_rows = None, None, None
    new_s, new_buf = [], []
    for l in range(DEPTH):
        g = prm['norm_gains'][l]
        xn = rmsnorm(h, g[0])
        if l < N_A:
            s0 = (jnp.zeros((B, H_A, DK_A, DV_A), jnp.float32) if hgrn_s0 is None else hgrn_s0[l])
            mix, mem_q, s_fin = hgrn2_mixer(xn, prm['w_in_a'][l], lbs[l], prm['hgrn_norm'][l], s0)
            new_s.append(s_fin)
        else:
            mix, mem_q = nsa_mixer(xn, prm['w_in_b'][l - N_A], shared, qpos, slopes)
        mo = mem_attend(mem_q, mem_kv[l])
        o = jnp.concatenate([mix, mo.astype(mix.dtype)], axis=-1) @ prm['w_o'][l]
        h = h + rmsnorm(o, g[1])
        buf0 = (jnp.zeros((B, CONV_W - 1, D_FF), h.dtype) if conv_buf0 is None else conv_buf0[l])
        f, nb = conv_ffn(rmsnorm(h, g[2]), buf0, prm['w_ffn_in'][l], prm['w_ffn_conv'][l],
                         prm['b_ffn_conv'][l], prm['w_ffn_out'][l])
        new_buf.append(nb)
        h = h + rmsnorm(f, g[3])
        if l == N_A - 1:
            shared, kv_rows, win_rows = shared_kv(h, kv_past, win_past, prm)
    return h, jnp.stack(new_s), jnp.stack(new_buf), kv_rows, win_rows


def setup_inputs(seed: int = 0) -> dict:
    key = jax.random.key(seed)
    ks = jax.random.split(key, 26)
    n_pages = PAST_LEN // PAGE_SIZE
    n_phys = (DEC_BATCH * n_pages * 5) // 4
    wb = min(WINDOW, PAST_LEN)

    def nrm(k, shape, scale=1.0):
        return jax.random.normal(k, shape, jnp.float32) * scale

    page_table = jax.random.permutation(ks[8], n_phys)[:DEC_BATCH * n_pages]
    page_table = page_table.reshape(DEC_BATCH, n_pages).astype(jnp.int32)
    return {
        'x_prompt': nrm(ks[0], (BATCH, SEQ, D_MODEL)),
        'x_sample': nrm(ks[1], (DEC_BATCH, DEC_SEQ, D_MODEL)),
        'mem_prompt': nrm(ks[2], (BATCH, MEM_LEN, D_MODEL)),
        'state_hgrn': nrm(ks[3], (N_A, DEC_BATCH, H_A, DK_A, DV_A), 0.5),
        'cache_conv': nrm(ks[4], (DEPTH, DEC_BATCH, CONV_W - 1, D_FF)),
        'cache_mem': nrm(ks[5], (DEPTH, DEC_BATCH, MEM_LEN, 2, MEM_HEADS, HEAD_DIM)),
        'cache_kv': nrm(ks[6], (n_phys, PAGE_SIZE, N_KV_ROWS, G_B, HEAD_DIM)),
        'cache_win': nrm(ks[7], (DEC_BATCH, wb, 2, G_B, HEAD_DIM)),
        'page_table': page_table,
        'norm_gains': 1.0 + nrm(ks[9], (DEPTH, 4, D_MODEL), 0.05),
        'w_in_a': nrm(ks[10], (N_A, D_MODEL, 4 * TOK_WIDTH + MEM_WIDTH), D_MODEL ** -0.5),
        'lb_logits': nrm(ks[11], (N_A + 1, TOK_WIDTH), 0.5),
        'hgrn_norm': 1.0 + nrm(ks[12], (N_A, H_A, DV_A), 0.05),
        'w_in_b': nrm(ks[13], (N_B, D_MODEL, TOK_WIDTH + 3 * H_B + MEM_WIDTH), D_MODEL ** -0.5),
        'w_o': nrm(ks[14], (DEPTH, MIX_WIDTH, D_MODEL), MIX_WIDTH ** -0.5),
        'w_mem_kv': nrm(ks[15], (DEPTH, D_MODEL, 2 * MEM_WIDTH), D_MODEL ** -0.5),
        'kv_norm': 1.0 + nrm(ks[16], (D_MODEL,), 0.05),
        'w_kv_b': nrm(ks[17], (D_MODEL, (N_KV_ROWS + 2) * G_B * HEAD_DIM), D_MODEL ** -0.5),
        'cmp_pos': nrm(ks[18], (2, CMP_BLOCK, HEAD_DIM), 0.5),
        'w_cmp1': nrm(ks[19], (2, CMP_BLOCK * HEAD_DIM, HEAD_DIM), (CMP_BLOCK * HEAD_DIM) ** -0.5),
        'w_cmp2': nrm(ks[20], (2, HEAD_DIM, HEAD_DIM), HEAD_DIM ** -0.5),
        'w_ffn_in': nrm(ks[21], (DEPTH, D_MODEL, 2 * D_FF), D_MODEL ** -0.5),
        'w_ffn_conv': nrm(ks[22], (DEPTH, CONV_W, D_FF), CONV_W ** -0.5),
        'b_ffn_conv': nrm(ks[23], (DEPTH, D_FF), 0.01),
        'w_ffn_out': nrm(ks[24], (DEPTH, D_FF, D_MODEL), D_FF ** -0.5),
    }


def reference(x_prompt, x_sample, mem_prompt, state_hgrn, cache_conv, cache_mem, cache_kv, cache_win,
              page_table, norm_gains, w_in_a, lb_logits, hgrn_norm, w_in_b, w_o, w_mem_kv, kv_norm,
              w_kv_b, cmp_pos, w_cmp1, w_cmp2, w_ffn_in, w_ffn_conv, b_ffn_conv, w_ffn_out):
    prm = dict(norm_gains=norm_gains, w_in_a=w_in_a, lb_logits=lb_logits, hgrn_norm=hgrn_norm,
               w_in_b=w_in_b, w_o=w_o, kv_norm=kv_norm, w_kv_b=w_kv_b, cmp_pos=cmp_pos,
               w_cmp1=w_cmp1, w_cmp2=w_cmp2, w_ffn_in=w_ffn_in, w_ffn_conv=w_ffn_conv,
               b_ffn_conv=b_ffn_conv, w_ffn_out=w_ffn_out)
    bp, tp = x_prompt.shape[:2]
    bs, ts = x_sample.shape[:2]
    mem_kv_prompt = jnp.einsum('bmd,ldk->lbmk', mem_prompt, w_mem_kv)
    mem_kv_prompt = mem_kv_prompt.reshape(DEPTH, bp, MEM_LEN, 2, MEM_HEADS, HEAD_DIM)
    y_prompt, hgrn_p, conv_p, kv_p, win_p = trunk(
        x_prompt, jnp.arange(tp, dtype=jnp.int32), mem_kv_prompt, None, None, None, None, prm)
    past_len = page_table.shape[1] * PAGE_SIZE
    kv_past = cache_kv[page_table].reshape(bs, past_len, N_KV_ROWS, G_B, HEAD_DIM)
    y_sample, hgrn_s, conv_s, kv_s, win_s = trunk(
        x_sample, past_len + jnp.arange(ts, dtype=jnp.int32), cache_mem, state_hgrn, cache_conv,
        kv_past, cache_win, prm)
    kv_prompt_pages = kv_p.reshape(bp, tp // PAGE_SIZE, PAGE_SIZE, N_KV_ROWS, G_B, HEAD_DIM)
    win_prompt = win_p[:, tp - min(WINDOW, tp):]
    return (y_prompt, y_sample, hgrn_p, hgrn_s, conv_p, conv_s, mem_kv_prompt,
            kv_prompt_pages, kv_s, win_prompt, win_s)
```

```cpp
#include <hip/hip_runtime.h>
#include <cstdio>
#include <cstdint>

#define DI __device__ __forceinline__
#define GAS __attribute__((address_space(1)))
#define LAS __attribute__((address_space(3)))
typedef unsigned short bf16;
typedef short bf16x8 __attribute__((ext_vector_type(8)));
typedef short s16x4 __attribute__((ext_vector_type(4)));
typedef float f32x2 __attribute__((ext_vector_type(2)));
typedef float f32x4 __attribute__((ext_vector_type(4)));
typedef float f32x16 __attribute__((ext_vector_type(16)));
typedef unsigned u32x2 __attribute__((ext_vector_type(2)));
typedef unsigned u32x4 __attribute__((ext_vector_type(4)));
typedef __bf16 hbf2 __attribute__((ext_vector_type(2)));

constexpr int D = 2048, BP = 8, TP = 2048, BS = 32, TS = 4, PAST = 8192, PAGE = 128, NPAGE = PAST / PAGE;
constexpr int MPR = BP * TP;
constexpr int MSR = BS * TS;
constexpr int MR = MPR + MSR;
constexpr int MPAD = 16640;
constexpr int TOK = 1536, MEMW = 512, HD = 128, NH = 12, GB = 2, HPG = 6, MEMH = 4, MEML = 256;
constexpr int NA = 4 * TOK + MEMW;
constexpr int NBM = 3840;
constexpr int FF = 5632, FF2 = 2 * FF;
constexpr int NCP = 127, NCS = 511, NSP = 32, NSS = 129;
constexpr float EPS = 1e-6f;
constexpr float LOG2E = 1.4426950408889634f;
constexpr float SCALE2 = 0.08838834764831845f * LOG2E;

constexpr size_t O_YP = 0;
constexpr size_t O_YS = O_YP + (size_t)MPR * D;
constexpr size_t O_HP = O_YS + (size_t)MSR * D;
constexpr size_t O_HS = O_HP + (size_t)BP * NH * HD * HD;
constexpr size_t O_CP = O_HS + (size_t)BS * NH * HD * HD;
constexpr size_t O_CS = O_CP + (size_t)2 * BP * 2 * FF;
constexpr size_t O_MP = O_CS + (size_t)2 * BS * 2 * FF;
constexpr size_t O_KVP = O_MP + (size_t)2 * BP * MEML * 1024;
constexpr size_t O_KVS = O_KVP + (size_t)MPR * 1024;
constexpr size_t O_WP = O_KVS + (size_t)MSR * 1024;
constexpr size_t O_WS = O_WP + (size_t)BP * 512 * 512;
constexpr size_t O_END = O_WS + (size_t)MSR * 512;
static_assert(O_END == 65847296, "d_out size");

constexpr size_t alup(size_t x) { return (x + 4095) & ~(size_t)4095; }
constexpr size_t WS_CTL = 0, CTL_BYTES = 1u << 20;
constexpr size_t WS_BTA = CTL_BYTES;
constexpr size_t WS_BTO0 = WS_BTA + alup((size_t)NA * D * 2);
constexpr size_t WS_BTO1 = WS_BTO0 + alup((size_t)D * D * 2);
constexpr size_t WS_BTF10 = WS_BTO1 + alup((size_t)D * D * 2);
constexpr size_t WS_BTF11 = WS_BTF10 + alup((size_t)FF2 * D * 2);
constexpr size_t WS_BTF20 = WS_BTF11 + alup((size_t)FF2 * D * 2);
constexpr size_t WS_BTF21 = WS_BTF20 + alup((size_t)D * FF * 2);
constexpr size_t WS_BTB = WS_BTF21 + alup((size_t)D * FF * 2);
constexpr size_t WS_BTM = WS_BTB + alup((size_t)NBM * D * 2);
constexpr size_t WS_BTC = WS_BTM + alup((size_t)D * D * 2);
constexpr size_t WS_LB = WS_BTC + alup((size_t)2 * 256 * 2048 * 2);
constexpr size_t WS_PRE0 = WS_LB + alup(1536 * 4);
constexpr size_t WS_XN = WS_PRE0 + alup(256 * 4);
constexpr size_t WS_MEMPB = WS_XN + alup((size_t)MPAD * D * 2);
constexpr size_t WS_QA = WS_MEMPB + alup((size_t)2048 * D * 2);
constexpr size_t WS_FA = WS_QA + alup((size_t)MPAD * TOK * 2);
constexpr size_t WS_VA = WS_FA + alup((size_t)MPAD * TOK * 4);
constexpr size_t WS_OGA = WS_VA + alup((size_t)MPAD * TOK * 2);
constexpr size_t WS_MEMQ = WS_OGA + alup((size_t)MPAD * TOK * 2);
constexpr size_t WS_ORAW = WS_MEMQ + alup((size_t)MPAD * MEMW * 2);
constexpr size_t WS_CAT = WS_ORAW + alup((size_t)MPAD * TOK * 4);
constexpr size_t WS_OB = WS_CAT + alup((size_t)MPAD * D * 2);
constexpr size_t WS_H = WS_OB + alup((size_t)MPAD * D * 2);
constexpr size_t WS_AB = WS_H + alup((size_t)MPAD * D * 4);
constexpr size_t WS_HID = WS_AB + alup((size_t)MPAD * FF2 * 2);
constexpr size_t WS_QB = WS_HID + alup((size_t)MPAD * FF * 2);
constexpr size_t WS_GATES = WS_QB + alup((size_t)MPAD * TOK * 2);
constexpr size_t KVB = (size_t)BP * GB * TP * HD * 2;
constexpr size_t WS_KCMP = WS_GATES + alup((size_t)MPAD * 40 * 4);
constexpr size_t WS_VCMP = WS_KCMP + alup(KVB);
constexpr size_t WS_KSEL = WS_VCMP + alup(KVB);
constexpr size_t WS_VSELT = WS_KSEL + alup(KVB);
constexpr size_t WS_KWIN = WS_VSELT + alup(KVB);
constexpr size_t WS_VWINT = WS_KWIN + alup(KVB);
constexpr size_t WS_CAK = WS_VWINT + alup(KVB);
constexpr size_t WS_CAV = WS_CAK + alup((size_t)32768 * 2048 * 2);
constexpr size_t WS_PPP = WS_CAV + alup((size_t)32768 * 2048 * 2);
constexpr size_t WS_PPS = WS_PPP + alup((size_t)2 * 2048 * 256 * 4);
constexpr size_t WS_KC = WS_PPS + alup((size_t)2 * 32768 * 256 * 4);
constexpr size_t WS_VCT = WS_KC + alup((size_t)16 * 128 * 128 * 2);
constexpr size_t WS_KCS = WS_VCT + alup((size_t)16 * 128 * 128 * 2);
constexpr size_t WS_VCS = WS_KCS + alup((size_t)64 * 512 * 128 * 4);
constexpr size_t WS_MK = WS_VCS + alup((size_t)64 * 512 * 128 * 4);
constexpr size_t WS_MVT = WS_MK + alup((size_t)2 * 40 * 4 * 256 * 128 * 2);
constexpr size_t WS_OCMP = WS_MVT + alup((size_t)2 * 40 * 4 * 256 * 128 * 2);
constexpr size_t WS_SELM = WS_OCMP + alup((size_t)MPAD * TOK * 2);
constexpr size_t WS_SOC = WS_SELM + alup((size_t)MPR * 2 * 4);
constexpr size_t WS_SIDX = WS_SOC + alup((size_t)MSR * TOK * 4);
constexpr size_t WS_DV = WS_SIDX + alup((size_t)MSR * 2 * 16 * 4);
constexpr size_t WS_FIX = WS_DV + alup((size_t)96 * 64 * 256 * 4);
constexpr size_t WS_HALO = WS_FIX + alup((size_t)256 * 2 * 2 * FF * 4);
constexpr size_t WS_W2T = WS_HALO + alup((size_t)256 * 2 * FF * 4);
constexpr size_t WS_END = WS_W2T + alup((size_t)2 * 128 * 128 * 2);
constexpr size_t WS_QP = WS_QA, WS_KP = WS_FA, WS_KT = WS_FA + (size_t)MPR * TOK * 2, WS_VF = WS_VA;

constexpr int NWAVES = 8, NTHR = 512;
constexpr int LDS_BYTES = 147456;
constexpr int RING_BYTES = 131072;
constexpr int MISC_OFF = RING_BYTES + 320;

DI unsigned pk2(float lo, float hi) { hbf2 v = __builtin_convertvector((f32x2){lo, hi}, hbf2); return __builtin_bit_cast(unsigned, v); }
DI bf16 f2bf(float f) { return (bf16)(pk2(f, 0.f) & 0xffffu); }
DI float bf2f(bf16 v) { return __uint_as_float((unsigned)v << 16); }
DI float bflo(unsigned w) { return __uint_as_float(w << 16); }
DI float bfhi(unsigned w) { return __uint_as_float(w & 0xffff0000u); }
DI float sigm(float x) { return __builtin_amdgcn_rcpf(1.f + __builtin_amdgcn_exp2f(-LOG2E * x)); }
DI float gelu_t(float x) { const float z = 1.5957691216f * (x + 0.044715f * x * x * x); return x * sigm(z); }
DI float wave_sum(float v) {
#pragma unroll
    for (int o = 1; o < 64; o <<= 1) v += __shfl_xor(v, o);
    return v;
}
DI float wave_max(float v) {
#pragma unroll
    for (int o = 1; o < 64; o <<= 1) v = fmaxf(v, __shfl_xor(v, o));
    return v;
}
#define LDS_WAIT() asm volatile("s_waitcnt lgkmcnt(0)" ::: "memory")
#define VM_WAIT() asm volatile("s_waitcnt vmcnt(0)" ::: "memory")
DI int kf_off(int r, int d) { return (((d >> 4) * 64 + r + 32 * ((d >> 3) & 1)) << 3) + (d & 7); }
DI int vf_off(int kvl, int d) { return ((((kvl >> 4) * 4 + (d >> 5)) * 64 + (d & 31) + 32 * ((kvl >> 2) & 1)) << 3) + ((((kvl >> 3) & 1) << 2) | (kvl & 3)); }
namespace pg8 {
#define PG8_LAS __attribute__((address_space(3)))
typedef unsigned short bf16_t;
typedef short bf16x8 __attribute__((ext_vector_type(8)));
typedef float f32x4 __attribute__((ext_vector_type(4)));
typedef unsigned u32x4 __attribute__((ext_vector_type(4)));
constexpr int BM = 256, BK = 64, HALF = 128, HTB = HALF * BK * 2  , STAGE_BYTES = 8 * HTB, NXCD = 8, WGM = 8;

__host__ __device__ __forceinline__ int lds_byte(int r, int c) { const int st = (r >> 4) * 2 + (c >> 5), rr = r & 15, cc = c & 31, ob = rr * 64 + cc * 2; return st * 1024 + (ob ^ (((ob >> 9) & 1) << 5)); }
__host__ __device__ __forceinline__ void stage_rc(int b, int& R, int& C) { const int st = b / 1024, sb = b % 1024, swz = sb ^ (((sb >> 9) & 1) << 5); R = (st >> 1) * 16 + swz / 64; C = (st & 1) * 32 + (swz % 64) / 2; }
__host__ __device__ __forceinline__ int perm32(int rho) { const int n = rho >> 4, i = rho & 15; return 8 * (i >> 2) + 4 * n + (i & 3); }

struct Unit { int pm, pn; };
struct Gemm { const bf16_t* A; const bf16_t* Bt; int M, N, K; };

struct StaticOrder {
    int nM, nN, nwg, G, c;
    __host__ __device__ void init(int M, int N, int G_, int c_) { nM = M / BM; nN = N / BM; nwg = nM * nN; G = G_; c = c_; }
    __host__ __device__ __forceinline__ bool next(int i, Unit& u) const {
        const long L = (long)i * G + c; if (L >= nwg) return false;
        int wgid = (int)L; { const int q = nwg / NXCD, r = nwg % NXCD, xcd = wgid % NXCD, off = wgid / NXCD; wgid = (xcd < r ? xcd * (q + 1) : r * (q + 1) + (xcd - r) * q) + off; }
        const int nig = WGM * nN, gid = wgid / nig, fm = gid * WGM, gsz = (nM - fm) < WGM ? (nM - fm) : WGM;
        u.pm = fm + ((wgid % nig) % gsz); u.pn = (wgid % nig) / gsz; return true;
    }
    __device__ __forceinline__ void a_ready(const Unit&) const {}
    __device__ __forceinline__ void done(const Unit&) const {}
};

template <class Epi, class Sched, bool ALIGN_EPI = false, bool SP2 = false>
__device__ __forceinline__ void gemm_phase(PG8_LAS unsigned char* lds, const Gemm g, const Sched& S, const Epi& E) {
    const int tid = threadIdx.x, wid = __builtin_amdgcn_readfirstlane(tid >> 6), lane = tid & 63, wr = wid >> 2, wc = wid & 3, fr = lane & 15, fq = lane >> 4;
    const int K = g.K, nt = K / BK;
    unsigned voffA[2], voffB[2];
#pragma unroll
    for (int i = 0; i < 2; ++i) { int R, C; stage_rc(tid * 16 + i * 8192, R, C); const int Rb = Epi::PERM ? ((R & ~31) + perm32(R & 31)) : R;
        voffA[i] = (unsigned)(R * K + C) * 2u; voffB[i] = (unsigned)(Rb * K + C) * 2u; }
    const size_t kstep = (size_t)(BK * 2);
    const size_t hstep = (size_t)HALF * K * 2;
    const size_t tstep = 2 * hstep;
    const unsigned ldsw = (unsigned)wid * 1024u;
    const int aoff = lds_byte(wr * 64 + fr, fq * 8), boff = lds_byte(wc * 32 + fr, fq * 8);
#define PG8_SA(b, h) (((b) * 2 + (h)) * HTB)
#define PG8_SB(b, h) ((4 + (b) * 2 + (h)) * HTB)
#define PG8_STAGE(bufoff, gbase, voff) do { _Pragma("unroll") for (int _i = 0; _i < 2; ++_i) \
        __builtin_amdgcn_global_load_lds((const unsigned*)((const char*)(gbase) + (voff)[_i]), (PG8_LAS unsigned*)(lds + (bufoff) + ldsw + _i * 8192), 16, 0, 0); } while (0)
#define PG8_LDA(dst, b, h) do { _Pragma("unroll") for (int m = 0; m < 4; ++m) _Pragma("unroll") for (int k = 0; k < 2; ++k) dst[m][k] = *(const PG8_LAS bf16x8*)(lds + PG8_SA(b, h) + aoff + m * 2048 + k * 1024); } while (0)
#define PG8_LDB(dst, b, h) do { _Pragma("unroll") for (int n = 0; n < 2; ++n) _Pragma("unroll") for (int k = 0; k < 2; ++k) dst[n][k] = *(const PG8_LAS bf16x8*)(lds + PG8_SB(b, h) + boff + n * 2048 + k * 1024); } while (0)
#define PG8_MMA(ai, bj, At, Bt) do { __builtin_amdgcn_s_setprio(1); _Pragma("unroll") for (int m = 0; m < 4; ++m) _Pragma("unroll") for (int n = 0; n < 2; ++n) _Pragma("unroll") for (int k = 0; k < 2; ++k) \
        acc[ai][bj][m][n] = __builtin_amdgcn_mfma_f32_16x16x32_bf16(Bt[n][k], At[m][k], acc[ai][bj][m][n], 0, 0, 0); __builtin_amdgcn_s_setprio(0); } while (0)
#define PG8_WAIT_V(n) asm volatile("s_waitcnt vmcnt(" #n ")" ::: "memory")
#define PG8_WAIT_L(n) asm volatile("s_waitcnt lgkmcnt(" #n ")" ::: "memory")
#define PG8_BAR __builtin_amdgcn_s_barrier()
#define PG8_SCHED __builtin_amdgcn_sched_barrier(0)
    Unit cur, nxt; int ui = 0;
    if (!S.next(0, cur)) return;
    f32x4 acc[2][2][4][2];
#pragma unroll
    for (int a = 0; a < 2; ++a)
#pragma unroll
        for (int b = 0; b < 2; ++b)
#pragma unroll
            for (int m = 0; m < 4; ++m)
#pragma unroll
                for (int n = 0; n < 2; ++n) acc[a][b][m][n] = (f32x4){0.f, 0.f, 0.f, 0.f};
    bf16x8 At[4][2], B0[2][2], B1[2][2];
    const char* cA = (const char*)g.A + (size_t)cur.pm * tstep; const char* cB = (const char*)g.Bt + (size_t)cur.pn * tstep;
    S.a_ready(cur);
    if constexpr (SP2) {
        PG8_STAGE(PG8_SB(0, 0), cB, voffB); PG8_STAGE(PG8_SB(0, 1), cB + hstep, voffB); PG8_STAGE(PG8_SA(0, 0), cA, voffA); PG8_STAGE(PG8_SA(0, 1), cA + hstep, voffA);
        if (wr == 1) PG8_BAR;
        PG8_WAIT_V(2); PG8_BAR;
        PG8_STAGE(PG8_SB(1, 0), cB + kstep, voffB); PG8_STAGE(PG8_SA(1, 0), cA + kstep, voffA); PG8_STAGE(PG8_SB(1, 1), cB + hstep + kstep, voffB);
        PG8_WAIT_V(6); PG8_BAR;
    } else {
        PG8_STAGE(PG8_SB(0, 0), cB, voffB); PG8_STAGE(PG8_SA(0, 0), cA, voffA); PG8_STAGE(PG8_SB(0, 1), cB + hstep, voffB); PG8_STAGE(PG8_SA(0, 1), cA + hstep, voffA);
        if (wr == 1) PG8_BAR;
        PG8_WAIT_V(4); PG8_BAR;
        PG8_STAGE(PG8_SB(1, 0), cB + kstep, voffB); PG8_STAGE(PG8_SA(1, 0), cA + kstep, voffA); PG8_STAGE(PG8_SB(1, 1), cB + hstep + kstep, voffB);
        PG8_WAIT_V(6); PG8_BAR;
    }
    for (;;) {
        const bool has_next = S.next(ui + 1, nxt);
        const char* nA = has_next ? (const char*)g.A + (size_t)nxt.pm * tstep : cA; const char* nB = has_next ? (const char*)g.Bt + (size_t)nxt.pn * tstep : cB;
        for (int t = 0; t < nt; t += 2) {
            const bool last = (t == nt - 2);
            const char* a1 = cA + (size_t)(t + 1) * kstep;
            const char* a2 = last ? nA : cA + (size_t)(t + 2) * kstep; const char* b2 = last ? nB : cB + (size_t)(t + 2) * kstep;
            const char* a3 = a2 + kstep; const char* b3 = b2 + kstep;
            if (last && has_next) S.a_ready(nxt);
            if constexpr (SP2) {
            PG8_LDB(B0, 0, 0); PG8_LDB(B1, 0, 1); PG8_SCHED; PG8_LDA(At, 0, 0); PG8_STAGE(PG8_SA(1, 1), a1 + hstep, voffA);
            PG8_WAIT_V(8); PG8_WAIT_L(0); PG8_BAR; PG8_MMA(0, 0, At, B0); PG8_MMA(0, 1, At, B1); PG8_BAR; PG8_SCHED;
            PG8_LDA(At, 0, 1); PG8_STAGE(PG8_SB(0, 0), b2, voffB); PG8_STAGE(PG8_SB(0, 1), b2 + hstep, voffB); PG8_STAGE(PG8_SA(0, 0), a2, voffA);
            PG8_WAIT_V(8); PG8_WAIT_L(0); PG8_BAR; PG8_MMA(1, 0, At, B0); PG8_MMA(1, 1, At, B1); PG8_BAR; PG8_SCHED;
            PG8_LDB(B0, 1, 0); PG8_LDB(B1, 1, 1); PG8_SCHED; PG8_LDA(At, 1, 0); PG8_STAGE(PG8_SA(0, 1), a2 + hstep, voffA);
            PG8_WAIT_V(8); PG8_WAIT_L(0); PG8_BAR; PG8_MMA(0, 0, At, B0); PG8_MMA(0, 1, At, B1); PG8_BAR; PG8_SCHED;
            PG8_LDA(At, 1, 1); PG8_STAGE(PG8_SB(1, 0), b3, voffB); PG8_STAGE(PG8_SB(1, 1), b3 + hstep, voffB); PG8_STAGE(PG8_SA(1, 0), a3, voffA);
            PG8_WAIT_V(8); PG8_WAIT_L(0); PG8_BAR; PG8_MMA(1, 0, At, B0); PG8_MMA(1, 1, At, B1); PG8_BAR; PG8_SCHED;
            } else {
            PG8_LDB(B0, 0, 0); PG8_SCHED; PG8_LDA(At, 0, 0); PG8_STAGE(PG8_SA(1, 1), a1 + hstep, voffA);
            PG8_WAIT_L(8); PG8_BAR; PG8_WAIT_L(0); PG8_MMA(0, 0, At, B0); PG8_BAR; PG8_SCHED;
            PG8_LDB(B1, 0, 1); PG8_STAGE(PG8_SB(0, 0), b2, voffB);
            PG8_BAR; PG8_WAIT_L(0); PG8_MMA(0, 1, At, B1); PG8_BAR;
            PG8_LDA(At, 0, 1); PG8_STAGE(PG8_SA(0, 0), a2, voffA);
            PG8_BAR; PG8_WAIT_L(0); PG8_MMA(1, 0, At, B0); PG8_BAR; PG8_SCHED;
            PG8_STAGE(PG8_SB(0, 1), b2 + hstep, voffB);
            PG8_WAIT_V(6); PG8_BAR; PG8_MMA(1, 1, At, B1); PG8_BAR;
            PG8_LDB(B0, 1, 0); PG8_SCHED; PG8_LDA(At, 1, 0); PG8_STAGE(PG8_SA(0, 1), a2 + hstep, voffA);
            PG8_WAIT_L(8); PG8_BAR; PG8_WAIT_L(0); PG8_MMA(0, 0, At, B0); PG8_BAR; PG8_SCHED;
            PG8_LDB(B1, 1, 1); PG8_STAGE(PG8_SB(1, 0), b3, voffB);
            PG8_BAR; PG8_WAIT_L(0); PG8_MMA(0, 1, At, B1); PG8_BAR;
            PG8_LDA(At, 1, 1); PG8_STAGE(PG8_SA(1, 0), a3, voffA);
            PG8_BAR; PG8_WAIT_L(0); PG8_MMA(1, 0, At, B0); PG8_BAR; PG8_SCHED;
            PG8_STAGE(PG8_SB(1, 1), b3 + hstep, voffB);
            PG8_WAIT_V(6); PG8_BAR; PG8_MMA(1, 1, At, B1); PG8_BAR;
            }
        }
        if constexpr (ALIGN_EPI) { if (wr == 0) PG8_BAR; }
        if constexpr (!Epi::AFTER_DRAIN) { E(acc, cur, wr, wc, fr, fq); S.done(cur); }
        if (!has_next) break;
#pragma unroll
        for (int a = 0; a < 2; ++a)
#pragma unroll
            for (int b = 0; b < 2; ++b)
#pragma unroll
                for (int m = 0; m < 4; ++m)
#pragma unroll
                    for (int n = 0; n < 2; ++n) acc[a][b][m][n] = (f32x4){0.f, 0.f, 0.f, 0.f};
        cur = nxt; cA = nA; cB = nB; ++ui;
        if constexpr (ALIGN_EPI) { if (wr == 1) PG8_BAR; }
    }
    PG8_WAIT_V(0);
    if constexpr (!ALIGN_EPI) { if (wr == 0) PG8_BAR; }
    PG8_BAR;
    if constexpr (Epi::AFTER_DRAIN) { E.fused(acc, cur, wr, wc, fr, fq, lds, wid, lane); S.done(cur); }
#undef PG8_SA
#undef PG8_SB
#undef PG8_STAGE
#undef PG8_LDA
#undef PG8_LDB
#undef PG8_MMA
#undef PG8_WAIT_V
#undef PG8_WAIT_L
#undef PG8_BAR
#undef PG8_SCHED
}
}
#define XB_TMO      128
#define XB_XCNT(j)  (256  + 64 * (j))
#define XB_XSUB(j)  (1280 + 64 * (j))
#define XB_XGEN(j)  (2304 + 64 * (j))
#define XB_TOP      3328
#define XB_TOPGEN   3392
#define XCD_BAR_WORDS 3456
#define XB_SPIN_CAP (1u << 18)

__device__ __forceinline__ unsigned xb_ld(unsigned* p)              { return __hip_atomic_load(p, __ATOMIC_RELAXED, __HIP_MEMORY_SCOPE_AGENT); }
__device__ __forceinline__ unsigned xb_add(unsigned* p, unsigned v) { return __hip_atomic_fetch_add(p, v, __ATOMIC_RELAXED, __HIP_MEMORY_SCOPE_AGENT); }
__device__ __forceinline__ unsigned xb_xcc_id() { return (unsigned)__builtin_amdgcn_s_getreg((3 << 11) | 20) & 0xFu; }
#define XB_SPIN(cond, bar) do { unsigned _sp = 0; while (cond) { __builtin_amdgcn_s_sleep(1); \
    if ((++_sp & 255u) == 0u) { if (xb_ld(&(bar)[XB_TMO])) break; if (_sp > XB_SPIN_CAP) { atomicAdd(&(bar)[XB_TMO], 1u); break; } } } } while (0)

struct XcdBarrier {
    unsigned* bar; unsigned x;
    volatile LAS unsigned* st;
};

__device__ __forceinline__ XcdBarrier xcd_barrier_post(unsigned* bar, volatile LAS unsigned* st) {
    XcdBarrier b; b.bar = bar; b.x = xb_xcc_id(); b.st = st;
    if (threadIdx.x == 0) (void)xb_add(&bar[XB_XCNT(b.x)], 1u);
    return b;
}
__device__ __forceinline__ void xcd_barrier_complete(unsigned* bar, unsigned x, unsigned& nloc, unsigned& nx) {
    const unsigned G = gridDim.x * gridDim.y * gridDim.z;
    unsigned sum, cnt, mine, sp = 0u;
    for (;;) {
        sum = 0u; cnt = 0u; mine = 0u;
#pragma unroll
        for (unsigned j = 0; j < 16; ++j) { const unsigned c = xb_ld(&bar[XB_XCNT(j)]); sum += c; cnt += (c > 0u) ? 1u : 0u; mine = (j == x) ? c : mine; }
        if (sum == G) break;
        __builtin_amdgcn_s_sleep(1);
        if ((++sp & 255u) == 0u) { if (xb_ld(&bar[XB_TMO])) break; if (sp > XB_SPIN_CAP) { atomicAdd(&bar[XB_TMO], 1u); break; } }
    }
    nloc = mine > 0u ? mine : 1u; nx = cnt > 0u ? cnt : 1u;
}

__device__ __forceinline__ void xcd_barrier(const XcdBarrier& b) {
    asm volatile("s_waitcnt vmcnt(0)" ::: "memory");
    __syncthreads();
    if (threadIdx.x == 0) {
        unsigned* bar = b.bar;
        __builtin_amdgcn_s_waitcnt(0);
        unsigned nloc = b.st[0], nx = b.st[1];
        if (nloc == 0u) { xcd_barrier_complete(bar, b.x, nloc, nx); b.st[0] = nloc; b.st[1] = nx; }
        const unsigned old = xb_add(&bar[XB_XSUB(b.x)], 1u);
        const unsigned gen = old / nloc;
        if (old + 1u == (gen + 1u) * nloc) {
            __builtin_amdgcn_fence(__ATOMIC_RELEASE, "agent");
            asm volatile("s_waitcnt vmcnt(0)" ::: "memory");
            const unsigned og = xb_add(&bar[XB_TOP], 1u);
            const unsigned tg = og / nx;
            if (og + 1u == (tg + 1u) * nx) xb_add(&bar[XB_TOPGEN], 1u);
            else XB_SPIN(xb_ld(&bar[XB_TOPGEN]) == tg, bar);
            __builtin_amdgcn_fence(__ATOMIC_ACQUIRE, "agent");
            xb_add(&bar[XB_XGEN(b.x)], 1u);
            asm volatile("s_waitcnt vmcnt(0)" ::: "memory");
        } else {
            XB_SPIN(xb_ld(&bar[XB_XGEN(b.x)]) == gen, bar);
            __builtin_amdgcn_fence(__ATOMIC_ACQUIRE, "agent");
            asm volatile("s_waitcnt vmcnt(0)" ::: "memory");
        }
    }
    __syncthreads();
}

template <class F> struct EpiFn {
    static constexpr bool PERM = true, AFTER_DRAIN = false;
    F f;
    DI void operator()(const f32x4 (&acc)[2][2][4][2], const pg8::Unit& u, int wr, int wc, int fr, int fq) const {
        const int row0 = u.pm * 256 + wr * 64 + fr, col0 = u.pn * 256 + wc * 32 + 8 * fq;
        const int kind = f.kind(u.pn);
#pragma unroll
        for (int ai = 0; ai < 2; ++ai)
#pragma unroll
            for (int m = 0; m < 4; ++m)
#pragma unroll
                for (int bj = 0; bj < 2; ++bj) f(kind, row0 + ai * 128 + m * 16, col0 + bj * 128, acc[ai][bj][m][0], acc[ai][bj][m][1]);
    }
};
DI u32x4 pack8(f32x4 a, f32x4 b) { u32x4 w; w.x = pk2(a[0], a[1]); w.y = pk2(a[2], a[3]); w.z = pk2(b[0], b[1]); w.w = pk2(b[2], b[3]); return w; }
DI void st8f(float* p, f32x4 a, f32x4 b) { *(f32x4*)p = a; *(f32x4*)(p + 4) = b; }

struct FnA {
    bf16* qa; float* fa; bf16* va; bf16* oga; bf16* memq; const float* lb;
    DI int kind(int pn) const { return pn < 12 ? 0 : pn < 18 ? 2 : pn < 24 ? 3 : 4; }
    DI void operator()(int kind, int row, int col, f32x4 v0, f32x4 v1) const {
        if (kind == 0) {
            const int ch = (col >> 8) * HD + (col & 127);
            if (((col >> 7) & 1) == 0) {
#pragma unroll
                for (int e = 0; e < 4; ++e) { v0[e] = v0[e] * sigm(v0[e]); v1[e] = v1[e] * sigm(v1[e]); }
                *(u32x4*)(qa + (size_t)row * TOK + ch) = pack8(v0, v1);
            } else {
                const f32x4 l0 = *(const f32x4*)(lb + ch), l1 = *(const f32x4*)(lb + ch + 4);
#pragma unroll
                for (int e = 0; e < 4; ++e) { v0[e] = l0[e] + (1.f - l0[e]) * sigm(v0[e]); v1[e] = l1[e] + (1.f - l1[e]) * sigm(v1[e]); }
                st8f(fa + (size_t)row * TOK + ch, v0, v1);
            }
        } else if (kind == 2) {
            *(u32x4*)(va + (size_t)row * TOK + (col - 2 * TOK)) = pack8(v0, v1);
        } else if (kind == 3) {
#pragma unroll
            for (int e = 0; e < 4; ++e) { v0[e] = sigm(v0[e]); v1[e] = sigm(v1[e]); }
            *(u32x4*)(oga + (size_t)row * TOK + (col - 3 * TOK)) = pack8(v0, v1);
        } else {
            *(u32x4*)(memq + (size_t)row * MEMW + (col - 4 * TOK)) = pack8(v0, v1);
        }
    }
};
template <int CTRL> DI float dpp_mov0(float x) { return __builtin_bit_cast(float, __builtin_amdgcn_update_dpp(0, __builtin_bit_cast(int, x), CTRL, 0xf, 0xf, false)); }
DI float row_scan16(float x) { x += dpp_mov0<0x111>(x); x += dpp_mov0<0x112>(x); x += dpp_mov0<0x114>(x); x += dpp_mov0<0x118>(x); return x; }
struct EpiA {
    static constexpr bool PERM = true, AFTER_DRAIN = false;
    bf16* qp; bf16* kp; bf16* kt; bf16* vf; float* dv; bf16* oga; bf16* memq; const float* lb; FnA fs;
    DI void operator()(const f32x4 (&acc)[2][2][4][2], const pg8::Unit& u, int wr, int wc, int fr, int fq) const {
        const int pn = u.pn;
        if (u.pm >= MPR / 256) {
            const int row0 = u.pm * 256 + wr * 64 + fr, col0 = pn * 256 + wc * 32 + 8 * fq, kind = fs.kind(pn);
#pragma unroll
            for (int ai = 0; ai < 2; ++ai)
#pragma unroll
                for (int m = 0; m < 4; ++m)
#pragma unroll
                    for (int bj = 0; bj < 2; ++bj) fs(kind, row0 + ai * 128 + m * 16, col0 + bj * 128, acc[ai][bj][m][0], acc[ai][bj][m][1]);
        } else if (pn < 12) {
            const int k0 = 32 * wc + 8 * fq;
            const f32x4 l0 = *(const f32x4*)(lb + pn * HD + k0), l1 = *(const f32x4*)(lb + pn * HD + k0 + 4);
#pragma unroll
            for (int ai = 0; ai < 2; ++ai)
#pragma unroll
                for (int mp = 0; mp < 2; ++mp) {
                    const int grow0 = u.pm * 256 + ai * 128 + wr * 64 + mp * 32, bh = (grow0 >> 11) * NH + pn, c = (grow0 & (TP - 1)) >> 5;
                    const size_t cb = ((size_t)bh * 64 + c) * 4096;
                    const size_t rowoff = (size_t)(wc * 2 + ((fq >> 1) & 1)) * 512 + (fq & 1) * 4;
#pragma unroll
                    for (int eh = 0; eh < 2; ++eh) {
                        float q1[2][4], k1[2][4], k2[2][4];
#pragma unroll
                        for (int e4 = 0; e4 < 4; ++e4) {
                            const float lbv = eh ? l1[e4] : l0[e4];
                            float qv[2], kk[2], sc[2];
#pragma unroll
                            for (int mo = 0; mo < 2; ++mo) {
                                const float uq = acc[ai][0][2 * mp + mo][eh][e4], uf = acc[ai][1][2 * mp + mo][eh][e4];
                                qv[mo] = uq * sigm(uq);
                                const float f = lbv + (1.f - lbv) * sigm(uf);
                                kk[mo] = 1.f - f;
                                sc[mo] = row_scan16(__builtin_amdgcn_logf(f));
                            }
                            const float tot0 = __shfl(sc[0], 15, 16), tot1 = __shfl(sc[1], 15, 16);
                            const float b0 = sc[0], b1 = tot0 + sc[1], r = tot0, b31 = tot0 + tot1;
                            q1[0][e4] = qv[0] * __builtin_amdgcn_exp2f(b0 - r); q1[1][e4] = qv[1] * __builtin_amdgcn_exp2f(b1 - r);
                            k1[0][e4] = kk[0] * __builtin_amdgcn_exp2f(r - b0); k1[1][e4] = kk[1] * __builtin_amdgcn_exp2f(r - b1);
                            k2[0][e4] = kk[0] * __builtin_amdgcn_exp2f(b31 - b0); k2[1][e4] = kk[1] * __builtin_amdgcn_exp2f(b31 - b1);
                            if (fr == 0) { float* dp = dv + ((size_t)bh * 64 + c) * 256 + k0 + 4 * eh + e4; dp[0] = __builtin_amdgcn_exp2f(b31); dp[128] = __builtin_amdgcn_exp2f(r); }
                        }
#pragma unroll
                        for (int mo = 0; mo < 2; ++mo) {
                            const int tt = 16 * mo + fr;
                            const size_t o = cb + rowoff + (size_t)(tt + 32 * eh) * 8;
                            u32x2 w; w.x = pk2(q1[mo][0], q1[mo][1]); w.y = pk2(q1[mo][2], q1[mo][3]); *(u32x2*)(qp + o) = w;
                            w.x = pk2(k1[mo][0], k1[mo][1]); w.y = pk2(k1[mo][2], k1[mo][3]); *(u32x2*)(kp + o) = w;
                            bf16* tp = kt + cb + vf_off(tt, k0 + 4 * eh);
#pragma unroll
                            for (int e4 = 0; e4 < 4; ++e4) tp[e4 * 8] = f2bf(k2[mo][e4]);
                        }
                    }
                }
        } else {
            const int row0 = u.pm * 256 + wr * 64 + fr, col0 = pn * 256 + wc * 32 + 8 * fq;
#pragma unroll
            for (int ai = 0; ai < 2; ++ai)
#pragma unroll
                for (int m = 0; m < 4; ++m)
#pragma unroll
                    for (int bj = 0; bj < 2; ++bj) {
                        const int row = row0 + ai * 128 + m * 16, col = col0 + bj * 128; f32x4 v0 = acc[ai][bj][m][0], v1 = acc[ai][bj][m][1];
                        if (pn < 18) {
                            const int hv = (col - 2 * TOK) >> 7, vd = col & 127, t = row & (TP - 1);
                            bf16* p = vf + ((size_t)((row >> 11) * NH + hv) * 64 + (t >> 5)) * 4096 + vf_off(t & 31, vd);
#pragma unroll
                            for (int e = 0; e < 4; ++e) { p[e * 8] = f2bf(v0[e]); p[(e + 4) * 8] = f2bf(v1[e]); }
                        } else if (pn < 24) {
#pragma unroll
                            for (int e = 0; e < 4; ++e) { v0[e] = sigm(v0[e]); v1[e] = sigm(v1[e]); }
                            *(u32x4*)(oga + (size_t)row * TOK + (col - 3 * TOK)) = pack8(v0, v1);
                        } else {
                            *(u32x4*)(memq + (size_t)row * MEMW + (col - 4 * TOK)) = pack8(v0, v1);
                        }
                    }
        }
    }
};
struct FnM {
    float* out; bf16* mk; bf16* mvt;
    DI int kind(int pn) const { return (pn & 3) >> 1; }
    DI void operator()(int kind, int row, int col, f32x4 v0, f32x4 v1) const {
        const int b = row >> 8, m = row & 255, l = col >> 10, c = col & 1023, h = (c >> 7) & 3, d = c & 127;
        st8f(out + O_MP + ((size_t)((l * BP + b) * MEML + m)) * 1024 + c, v0, v1);
        const size_t hb = ((size_t)((l * 40 + b) * 4 + h)) * MEML * HD + (size_t)(m >> 5) * 4096;
        if (kind == 0) {
            *(u32x4*)(mk + hb + kf_off(m & 31, d)) = pack8(v0, v1);
        } else {
            bf16* p = mvt + hb + vf_off(m & 31, d);
#pragma unroll
            for (int e = 0; e < 4; ++e) { p[e * 8] = f2bf(v0[e]); p[(e + 4) * 8] = f2bf(v1[e]); }
        }
    }
};
struct FnC {
    float* o; int ld;
    DI int kind(int) const { return 0; }
    DI void operator()(int, int row, int col, f32x4 v0, f32x4 v1) const { st8f(o + (size_t)row * ld + col, v0, v1); }
};
struct FnO {
    bf16* o; int ld;
    DI int kind(int) const { return 0; }
    DI void operator()(int, int row, int col, f32x4 v0, f32x4 v1) const { *(u32x4*)(o + (size_t)row * ld + col) = pack8(v0, v1); }
};
struct FnF1 {
    bf16* ab; float* out; int layer;
    DI int kind(int) const { return 0; }
    DI void operator()(int, int row, int col, f32x4 v0, f32x4 v1) const {
        const int half = (col >> 7) & 1, n = (col >> 8) * 128 + (col & 127);
        *(u32x4*)(ab + (size_t)row * FF2 + half * FF + n) = pack8(v0, v1);
        if (half == 0 && row >= MPR && row < MR) { const int rs = row - MPR, t = rs & 3; if (t >= 2) st8f(out + O_CS + ((size_t)((layer * BS + (rs >> 2)) * 2 + (t - 2))) * FF + n, v0, v1); }
    }
};
template <int CTRL> DI float dpp_ror(float x) { return __builtin_bit_cast(float, __builtin_amdgcn_update_dpp(0, __builtin_bit_cast(int, x), CTRL, 0xf, 0xf, false)); }
struct EpiF1 {
    static constexpr bool PERM = true, AFTER_DRAIN = false;
    bf16* hid; float* fix; float* halo; float* out; const float* wconv; const float* bconv; int layer;
    DI void operator()(const f32x4 (&acc)[2][2][4][2], const pg8::Unit& u, int wr, int wc, int fr, int fq) const {
        const int n0 = u.pn * 128 + wc * 32 + 8 * fq;
        f32x4 w0[2], w1[2], w2[2], bb[2];
#pragma unroll
        for (int eh = 0; eh < 2; ++eh) { w0[eh] = *(const f32x4*)(wconv + n0 + 4 * eh); w1[eh] = *(const f32x4*)(wconv + FF + n0 + 4 * eh); w2[eh] = *(const f32x4*)(wconv + 2 * FF + n0 + 4 * eh); bb[eh] = *(const f32x4*)(bconv + n0 + 4 * eh); }
#pragma unroll
        for (int ai = 0; ai < 2; ++ai) {
            const int rowb = u.pm * 256 + ai * 128 + wr * 64, blk = rowb >> 6;
            f32x4 p1[2] = {(f32x4){0.f, 0.f, 0.f, 0.f}, (f32x4){0.f, 0.f, 0.f, 0.f}}, p2[2] = {(f32x4){0.f, 0.f, 0.f, 0.f}, (f32x4){0.f, 0.f, 0.f, 0.f}};
#pragma unroll
            for (int m = 0; m < 4; ++m) {
                const int row = rowb + m * 16 + fr;
                f32x4 h[2];
#pragma unroll
                for (int eh = 0; eh < 2; ++eh) {
                    f32x4 c1, c2;
#pragma unroll
                    for (int e = 0; e < 4; ++e) { const float av = acc[ai][0][m][eh][e]; c1[e] = dpp_ror<0x121>(av); c2[e] = dpp_ror<0x122>(av); }
#pragma unroll
                    for (int e = 0; e < 4; ++e) {
                        const float e1 = fr >= 1 ? c1[e] : p1[eh][e], e0 = fr >= 2 ? c2[e] : p2[eh][e];
                        const float cc = bb[eh][e] + w0[eh][e] * e0 + w1[eh][e] * e1 + w2[eh][e] * acc[ai][0][m][eh][e];
                        h[eh][e] = gelu_t(cc) * acc[ai][1][m][eh][e];
                    }
                    p1[eh] = c1; p2[eh] = c2;
                }
                if (m == 0 && fr < 2) {
                    float* fp = fix + ((size_t)(blk * 2 + fr) * 2) * FF + n0;
                    st8f(fp, acc[ai][0][0][0], acc[ai][0][0][1]); st8f(fp + FF, acc[ai][1][0][0], acc[ai][1][0][1]);
                } else {
                    *(u32x4*)(hid + (size_t)row * FF + n0) = pack8(h[0], h[1]);
                }
                if (m == 3 && fr >= 14) {
                    st8f(halo + ((size_t)(blk * 2 + (fr - 14))) * FF + n0, acc[ai][0][3][0], acc[ai][0][3][1]);
                    const int t = row & (TP - 1);
                    if (t >= TP - 2) st8f(out + O_CP + ((size_t)((layer * BP + (row >> 11)) * 2 + (t - (TP - 2)))) * FF + n0, acc[ai][0][3][0], acc[ai][0][3][1]);
                }
            }
        }
    }
};
struct FnB {
    bf16* qb; bf16* memq; float* gates; float* out; bf16* kcmp; bf16* vcmp; bf16* ksel; bf16* vselt; bf16* kwin; bf16* vwint;
    DI int kind(int pn) const { return pn < 6 ? 0 : pn < 8 ? 1 : pn < 14 ? 2 + (pn - 8) : 8; }
    DI void operator()(int kind, int row, int col, f32x4 v0, f32x4 v1) const {
        if (kind == 0) { *(u32x4*)(qb + (size_t)row * TOK + col) = pack8(v0, v1); }
        else if (kind == 1) { *(u32x4*)(memq + (size_t)row * MEMW + (col - TOK)) = pack8(v0, v1); }
        else if (kind == 8) {
            const int c = col - 3584;
            if (c < 36) {
#pragma unroll
                for (int e = 0; e < 4; ++e) { v0[e] = sigm(v0[e]); v1[e] = sigm(v1[e]); }
                st8f(gates + (size_t)row * 40 + c, v0, v1);
            }
        } else {
            const int kk = kind - 2, cp = col - 2048, g = (col >> 7) & 1, d = col & 127;
            if (row < MPR) {
                const int b = row >> 11, t = row & (TP - 1);
                if (kk < 4) st8f(out + O_KVP + (size_t)row * 1024 + cp, v0, v1);
                else if (t >= TP - 512) st8f(out + O_WP + ((size_t)(b * 512 + (t - (TP - 512)))) * 512 + (cp - 1024), v0, v1);
                const size_t gb = (size_t)(b * GB + g) * TP * HD;
                if (kk == 3 || kk == 5) {
                    bf16* p = (kk == 3 ? vselt : vwint) + gb + (size_t)(t >> 5) * 4096 + vf_off(t & 31, d);
#pragma unroll
                    for (int e = 0; e < 4; ++e) { p[e * 8] = f2bf(v0[e]); p[(e + 4) * 8] = f2bf(v1[e]); }
                } else if (kk < 2) {
                    *(u32x4*)((kk == 0 ? kcmp : vcmp) + gb + (size_t)t * HD + d) = pack8(v0, v1);
                } else {
                    *(u32x4*)((kk == 2 ? ksel : kwin) + gb + (size_t)(t >> 5) * 4096 + kf_off(t & 31, d)) = pack8(v0, v1);
                }
            } else if (row < MR) {
                const int rs = row - MPR;
                if (kk < 4) st8f(out + O_KVS + (size_t)rs * 1024 + cp, v0, v1);
                else st8f(out + O_WS + (size_t)rs * 512 + (cp - 1024), v0, v1);
            }
        }
    }
};

struct Args { const float* in[25]; float* out; unsigned char* ws; };
typedef const __attribute__((address_space(4))) Args& ArgsRef;
DI const __attribute__((address_space(4))) Args* phase_args() { const __attribute__((address_space(4))) Args* p = (const __attribute__((address_space(4))) Args*)__builtin_amdgcn_kernarg_segment_ptr(); asm volatile("" : "+s"(p)); return p; }
enum { I_XP = 0, I_XS, I_MEMP, I_HST, I_CCONV, I_CMEM, I_CKV, I_CWIN, I_PT, I_NG, I_WINA, I_LBL, I_HGN, I_WINB, I_WO, I_WMKV, I_KVN, I_WKVB, I_CPOS, I_WC1, I_WC2, I_WF1, I_WCONV, I_BCONV, I_WF2 };

struct SegD { int in_idx, src_off, ldw, col0, nvalid, ncols, gain_idx, gain_off, row0, K; unsigned long long dst; };
static constexpr SegD k_segs[17] = {
    {I_WINA, 0, NA, 0, NA, NA, I_NG, 0, 0, 2048, WS_BTA},
    {I_WO, 0, D, 0, D, D, -1, 0, 0, 2048, WS_BTO0},
    {I_WO, D * D, D, 0, D, D, -1, 0, 0, 2048, WS_BTO1},
    {I_WF1, 0, FF2, 0, FF2, FF2, I_NG, 2 * D, 0, 2048, WS_BTF10},
    {I_WF1, D * FF2, FF2, 0, FF2, FF2, I_NG, 6 * D, 0, 2048, WS_BTF11},
    {I_WF2, 0, D, 0, D, D, -1, 0, 0, FF, WS_BTF20},
    {I_WF2, FF * D, D, 0, D, D, -1, 0, 0, FF, WS_BTF21},
    {I_WINB, 0, 2084, 0, 1536, 1536, I_NG, 4 * D, 0, 2048, WS_BTB},
    {I_WINB, 0, 2084, 1572, 512, 512, I_NG, 4 * D, 1536, 2048, WS_BTB},
    {I_WINB, 0, 2084, 1536, 36, 256, I_NG, 4 * D, 3584, 2048, WS_BTB},
    {I_WKVB, 0, 1536, 0, 1536, 1536, I_KVN, 0, 2048, 2048, WS_BTB},
    {I_WMKV, 0, 1024, 0, 1024, 1024, -1, 0, 0, 2048, WS_BTM},
    {I_WMKV, D * 1024, 1024, 0, 1024, 1024, -1, 0, 1024, 2048, WS_BTM},
    {I_WC1, 0, 128, 0, 128, 128, -1, 0, 0, 2048, WS_BTC},
    {I_WC1, 2048 * 128, 128, 0, 128, 128, -1, 0, 128, 2048, WS_BTC},
    {I_WC1, 4096 * 128, 128, 0, 128, 128, -1, 0, 0, 2048, WS_BTC + (size_t)256 * 2048 * 2},
    {I_WC1, 4096 * 128 + 2048 * 128, 128, 0, 128, 128, -1, 0, 128, 2048, WS_BTC + (size_t)256 * 2048 * 2},
};
static constexpr int k_tl_end[17] = { 832, 1088, 1344, 2752, 4160, 4864, 5568, 5760, 5824, 5856, 6048, 6176, 6304, 6336, 6368, 6400, 6432 };
constexpr int TL_A0 = 832, TL_LATE0 = 832, TL_LATE1 = 6048, TL_END = 6432;
struct TrTile { bf16* dst; int k0, n0, row0, K, ncols; f32x4 v[8]; float gk[8]; };
DI void tr_load(ArgsRef a, int tile, TrTile& T, int tid) {
    int s = 0, base = 0;
#pragma unroll
    for (int i = 0; i < 16; ++i) { const bool ge = tile >= k_tl_end[i]; s += ge ? 1 : 0; base = ge ? k_tl_end[i] : base; }
    SegD sd = k_segs[0];
#pragma unroll
    for (int i = 1; i < 17; ++i) if (s == i) sd = k_segs[i];
    const int r = tile - base, ncb = (sd.ncols + 255) >> 8, kb = r / ncb, nb = r - kb * ncb, k0 = 64 * kb, n0 = 256 * nb;
    const float* W = a.in[sd.in_idx] + sd.src_off;
    const float* gain = sd.gain_idx >= 0 ? a.in[sd.gain_idx] + sd.gain_off : nullptr;
    T.dst = (bf16*)(a.ws + sd.dst); T.k0 = k0; T.n0 = n0; T.row0 = sd.row0; T.K = sd.K; T.ncols = sd.ncols;
    const int ilv = (s == 0) ? TOK : (s == 3 || s == 4) ? FF : 0;
#pragma unroll
    for (int i = 0; i < 8; ++i) {
        const int idx = i * NTHR + tid, kk = idx >> 6, c4 = (idx & 63) * 4, n = n0 + c4, g128 = n & ~127;
        const int scol = (ilv && (s != 0 || g128 < 2 * TOK)) ? ((g128 >> 7) & 1) * ilv + (g128 >> 8) * 128 + (n & 127) : n;
        const float* src = W + (size_t)(k0 + kk) * sd.ldw + sd.col0 + scol;
        if (n + 3 < sd.nvalid) T.v[i] = *(const f32x4*)src;
        else { for (int e = 0; e < 4; ++e) T.v[i][e] = (n + e < sd.nvalid) ? src[e] : 0.f; }
        T.gk[i] = gain ? gain[k0 + kk] : 1.f;
    }
}
constexpr int TR_LD = 260, TR_BUF = 64 * TR_LD * 2;
DI void tr_write(const TrTile& T, LAS unsigned char* buf, int tid) {
#pragma unroll
    for (int i = 0; i < 8; ++i) {
        const int idx = i * NTHR + tid, kk = idx >> 6, c4 = (idx & 63) * 4; const float g = T.gk[i];
        u32x2 w; w.x = pk2(T.v[i][0] * g, T.v[i][1] * g); w.y = pk2(T.v[i][2] * g, T.v[i][3] * g);
        *(LAS u32x2*)(buf + (kk * TR_LD + c4) * 2) = w;
    }
}
DI void tr_store(const TrTile& T, const LAS unsigned char* buf, int tid) {
    const LAS bf16* B = (const LAS bf16*)buf;
#pragma unroll
    for (int j = 0; j < 4; ++j) {
        const int id = j * NTHR + tid, n = id >> 3, c = id & 7;
        if (T.n0 + n < T.ncols) {
            const LAS bf16* sp = B + (8 * c) * TR_LD + n;
            u32x4 o; o.x = (unsigned)sp[0] | ((unsigned)sp[TR_LD] << 16); o.y = (unsigned)sp[2 * TR_LD] | ((unsigned)sp[3 * TR_LD] << 16);
            o.z = (unsigned)sp[4 * TR_LD] | ((unsigned)sp[5 * TR_LD] << 16); o.w = (unsigned)sp[6 * TR_LD] | ((unsigned)sp[7 * TR_LD] << 16);
            *(u32x4*)(T.dst + (size_t)(T.row0 + T.n0 + n) * T.K + T.k0 + 8 * c) = o;
        }
    }
}
#define TR_BAR() asm volatile("s_waitcnt lgkmcnt(0)\n\ts_barrier" ::: "memory")
template <class MAP>
DI void wg_transpose_run(ArgsRef a, LAS unsigned char* lds, int first, int last, int step, const MAP& map, int tid) {
    if (first >= last) return;
    __syncthreads();
    TrTile T; tr_load(a, map(first), T, tid);
    int par = 0;
    for (int t = first; t < last; t += step) {
        LAS unsigned char* buf = lds + par * TR_BUF;
        tr_write(T, buf, tid);
        const TrTile Tc = T;
        if (t + step < last) tr_load(a, map(t + step), T, tid);
        TR_BAR();
        tr_store(Tc, buf, tid);
        par ^= 1;
    }
    __syncthreads();
}
template <bool NORM> DI void row_to_bf16(const float* xrow, bf16* orow, int lane) {
    const f32x4* xr = (const f32x4*)xrow + lane;
    f32x4 v[8]; float s = 0.f;
#pragma unroll
    for (int j = 0; j < 8; ++j) { v[j] = xr[64 * j]; s += (v[j][0] * v[j][0] + v[j][1] * v[j][1]) + (v[j][2] * v[j][2] + v[j][3] * v[j][3]); }
    float rs = 1.f;
    if (NORM) rs = rsqrtf(wave_sum(s) * (1.f / D) + EPS);
    u32x2* o8 = (u32x2*)orow + lane;
#pragma unroll
    for (int j = 0; j < 8; ++j) { u32x2 w; w.x = pk2(v[j][0] * rs, v[j][1] * rs); w.y = pk2(v[j][2] * rs, v[j][3] * rs); o8[64 * j] = w; }
}
DI void p0_prologue(ArgsRef a, LAS unsigned char* lds, int gw, int ngw, int wave, int lane) {
    bf16* XN = (bf16*)(a.ws + WS_XN);
    for (int m = gw; m < MR; m += ngw) {
        const float* src = m < MPR ? a.in[I_XP] + (size_t)m * D : a.in[I_XS] + (size_t)(m - MPR) * D;
        row_to_bf16<true>(src, XN + (size_t)m * D, lane);
    }
    bf16* MB = (bf16*)(a.ws + WS_MEMPB);
    for (int m = gw; m < BP * MEML; m += ngw) row_to_bf16<false>(a.in[I_MEMP] + (size_t)m * D, MB + (size_t)m * D, lane);
    bf16* MK = (bf16*)(a.ws + WS_MK); bf16* MVT = (bf16*)(a.ws + WS_MVT);
    for (int rr = gw; rr < 2 * BS * MEML; rr += ngw) {
        const int l = rr / (BS * MEML), b = (rr / MEML) % BS, m = rr % MEML;
        const float* src = a.in[I_CMEM] + (size_t)rr * 1024;
#pragma unroll
        for (int j = 0; j < 4; ++j) {
            const int idx = 4 * lane + 256 * j, h = (idx >> 7) & 3, d = idx & 127;
            const f32x4 v = *(const f32x4*)(src + idx);
            const size_t hb = ((size_t)((l * 40 + 8 + b) * 4 + h)) * MEML * HD + (size_t)(m >> 5) * 4096;
            if (j < 2) { u32x2 w; w.x = pk2(v[0], v[1]); w.y = pk2(v[2], v[3]); *(u32x2*)(MK + hb + kf_off(m & 31, d)) = w; }
            else { bf16* p = MVT + hb + vf_off(m & 31, d);
#pragma unroll
                for (int e = 0; e < 4; ++e) p[e * 8] = f2bf(v[e]); }
        }
    }
    for (int idx = gw * 64 + lane; idx < 2 * 128 * 128; idx += ngw * 64) { const int kv = idx >> 14, d = (idx >> 7) & 127, hh = idx & 127; ((bf16*)(a.ws + WS_W2T))[idx] = f2bf(a.in[I_WC2][(size_t)kv * 16384 + hh * 128 + d]); }
    if (gw < 24) { const int c = gw * 64 + lane; const float* ll = a.in[I_LBL]; ((float*)(a.ws + WS_LB))[c] = 1.f / (1.f + __expf(ll[TOK + c] - ll[c])); }
    for (int it = gw; it < 256; it += ngw) {
        const int kv = it >> 7, h = it & 127; const float* pe = a.in[I_CPOS] + kv * 4096; const float* w1 = a.in[I_WC1] + (size_t)kv * 4096 * 128 + h;
        float s = 0.f;
        for (int i = 0; i < 64; ++i) { const int n = lane + 64 * i; s += pe[n] * w1[(size_t)n * 128]; }
        s = wave_sum(s);
        if (lane == 0) ((float*)(a.ws + WS_PRE0))[it] = s;
    }
}


#define MFMA32(a, b, c) __builtin_amdgcn_mfma_f32_32x32x16_bf16((a), (b), (c), 0, 0, 0)
DI int crow(int i, int h) { return (i & 3) + 8 * (i >> 2) + 4 * h; }
DI f32x16 zero16() { f32x16 z; for (int i = 0; i < 16; ++i) z[i] = 0.f; return z; }
DI bf16x8 packp(const f32x16& s, int st) {
    u32x4 p; p.x = pk2(s[8 * st + 0], s[8 * st + 1]); p.y = pk2(s[8 * st + 2], s[8 * st + 3]); p.z = pk2(s[8 * st + 4], s[8 * st + 5]); p.w = pk2(s[8 * st + 6], s[8 * st + 7]);
    return __builtin_bit_cast(bf16x8, p);
}
struct AttnAcc { f32x16 o[4]; float m, l; };
DI void attn_init(AttnAcc& A) { for (int i = 0; i < 4; ++i) A.o[i] = zero16(); A.m = -1e30f; A.l = 0.f; }
DI void load_qf(bf16x8 (&qf)[8], const bf16* qrow, int h) {
#pragma unroll
    for (int ks = 0; ks < 8; ++ks) qf[ks] = *(const bf16x8*)(qrow + 16 * ks + 8 * h);
}
DI f32x16 qk_tile(const bf16x8 (&qf)[8], const bf16* Kt, int lane) {
    f32x16 s = zero16();
    const bf16x8* kp = (const bf16x8*)Kt + lane;
#pragma unroll
    for (int ks = 0; ks < 8; ++ks) s = MFMA32(kp[ks * 64], qf[ks], s);
    return s;
}
DI f32x16 qk_tile_l(const LAS bf16x8* ql, const bf16* Kt, int lane) {
    f32x16 s = zero16();
    const bf16x8* kp = (const bf16x8*)Kt + lane;
#pragma unroll
    for (int ks = 0; ks < 8; ++ks) s = MFMA32(kp[ks * 64], ql[ks * 64 + lane], s);
    return s;
}
DI void pv_tile(f32x16 (&o)[4], const f32x16& p, const bf16* Vt, int lane) {
    const bf16x8* vp = (const bf16x8*)Vt + lane;
#pragma unroll
    for (int st = 0; st < 2; ++st) {
        const bf16x8 pf = packp(p, st);
#pragma unroll
        for (int db = 0; db < 4; ++db) o[db] = MFMA32(vp[(st * 4 + db) * 64], pf, o[db]);
    }
}
template <class VF>
DI void attn_step(AttnAcc& A, f32x16 s, const bf16* Vt, float slope2, float kp0, float kps, const VF& valid, int lane) {
    const int h = lane >> 5;
    float mt = -1e30f;
#pragma unroll
    for (int i = 0; i < 16; ++i) {
        const int kvl = crow(i, h);
        float v = s[i] * SCALE2 + slope2 * (kp0 + kps * (float)kvl);
        v = valid(kvl) ? v : -1e30f;
        s[i] = v; mt = fmaxf(mt, v);
    }
    mt = fmaxf(mt, __shfl_xor(mt, 32));
    const float mn = fmaxf(A.m, mt), alpha = __builtin_amdgcn_exp2f(A.m - mn);
    A.m = mn;
    float ls = 0.f;
#pragma unroll
    for (int i = 0; i < 16; ++i) { const float p = s[i] > -1e29f ? __builtin_amdgcn_exp2f(s[i] - mn) : 0.f; s[i] = p; ls += p; }
    A.l = A.l * alpha + ls;
#pragma unroll
    for (int db = 0; db < 4; ++db) A.o[db] *= alpha;
    pv_tile(A.o, s, Vt, lane);
}
DI void load8(bf16x8 (&f)[8], const bf16* tile, int lane) {
    const bf16x8* p = (const bf16x8*)tile + lane;
#pragma unroll
    for (int i = 0; i < 8; ++i) f[i] = p[i * 64];
}
template <class VF, class FF>
DI void attn_run(AttnAcc& A, const LAS bf16x8* ql, const bf16* Kb, const bf16* Vb, unsigned long long tmask, float slope2, int t0, const VF& validf, const FF& fullf, int lane) {
    if (tmask == 0ull) return;
    const int h = lane >> 5;
    int kt = __builtin_ctzll(tmask); tmask &= tmask - 1ull;
    bf16x8 kf[8]; load8(kf, Kb + (size_t)kt * 4096, lane);
    for (;;) {
        const bf16x8* vp = (const bf16x8*)(Vb + (size_t)kt * 4096) + lane;
        bf16x8 va[4], vb[4];
#pragma unroll
        for (int db = 0; db < 4; ++db) va[db] = vp[db * 64];
#pragma unroll
        for (int db = 0; db < 4; ++db) vb[db] = vp[(4 + db) * 64];
        __builtin_amdgcn_sched_barrier(0);
        const LAS bf16x8* q2 = ql + lane; asm volatile("" : "+v"(q2));
        f32x16 s = zero16();
#pragma unroll
        for (int ks = 0; ks < 8; ++ks) s = MFMA32(kf[ks], q2[ks * 64], s);
        const bool more = tmask != 0ull; int kn = kt;
        const float kb0 = slope2 * (float)(kt * 32 - t0 + 4 * h);
        const bool full = fullf(kt);
        float mt = -1e30f;
        if (full) {
#pragma unroll
            for (int i = 0; i < 16; ++i) { const float v = fmaf(s[i], SCALE2, fmaf(slope2, (float)((i & 3) + 8 * (i >> 2)), kb0)); s[i] = v; mt = fmaxf(mt, v); }
        } else {
#pragma unroll
            for (int i = 0; i < 16; ++i) { float v = fmaf(s[i], SCALE2, fmaf(slope2, (float)((i & 3) + 8 * (i >> 2)), kb0)); v = validf(kt, crow(i, h)) ? v : -1e30f; s[i] = v; mt = fmaxf(mt, v); }
        }
        if (more) { kn = __builtin_ctzll(tmask); tmask &= tmask - 1ull; load8(kf, Kb + (size_t)kn * 4096, lane); }
        __builtin_amdgcn_sched_barrier(0);
        mt = fmaxf(mt, __shfl_xor(mt, 32));
        float mn = A.m;
        if (__any(mt > A.m + 8.f)) {
            mn = fmaxf(A.m, mt);
            const float alpha = __builtin_amdgcn_exp2f(A.m - mn);
            A.m = mn; A.l *= alpha;
#pragma unroll
            for (int db = 0; db < 4; ++db) A.o[db] *= alpha;
        }
        float ls = 0.f;
        if (full) {
#pragma unroll
            for (int i = 0; i < 16; ++i) { const float p = __builtin_amdgcn_exp2f(s[i] - mn); s[i] = p; ls += p; }
        } else {
#pragma unroll
            for (int i = 0; i < 16; ++i) { const float p = s[i] > -1e29f ? __builtin_amdgcn_exp2f(s[i] - mn) : 0.f; s[i] = p; ls += p; }
        }
        A.l += ls;
        { const bf16x8 pf = packp(s, 0);
#pragma unroll
          for (int db = 0; db < 4; ++db) A.o[db] = MFMA32(va[db], pf, A.o[db]); }
        { const bf16x8 pf = packp(s, 1);
#pragma unroll
          for (int db = 0; db < 4; ++db) A.o[db] = MFMA32(vb[db], pf, A.o[db]); }
        if (!more) break;
        kt = kn;
    }
}
DI float attn_inv(const AttnAcc& A) { const float lt = A.l + __shfl_xor(A.l, 32); return lt > 0.f ? 1.f / lt : 0.f; }
DI void store_ot(bf16* orow, const f32x16 (&o)[4], int h) {
#pragma unroll
    for (int db = 0; db < 4; ++db)
#pragma unroll
        for (int c = 0; c < 4; ++c) {
            u32x2 w; w.x = pk2(o[db][4 * c], o[db][4 * c + 1]); w.y = pk2(o[db][4 * c + 2], o[db][4 * c + 3]);
            *(u32x2*)(orow + 32 * db + 8 * c + 4 * h) = w;
        }
}

DI void memattn_item(ArgsRef a, int layer, int it, LAS float* wreg, int lane) {
    const int r = lane & 31, h = lane >> 5;
    int bq, hd, row, nvalid;
    if (it < BP * MEMH * 64) { bq = it >> 8; hd = (it >> 6) & 3; const int tau = it & 63; row = bq * TP + tau * 32 + r; nvalid = 32; }
    else { const int j = it - BP * MEMH * 64; const int bs = j >> 2; hd = j & 3; bq = 8 + bs; row = MPR + bs * 4 + (r < 4 ? r : 3); nvalid = 4; }
    const bf16* MEMQ = (const bf16*)(a.ws + WS_MEMQ);
    const bf16* K = (const bf16*)(a.ws + WS_MK) + ((size_t)((layer * 40 + bq) * 4 + hd)) * MEML * HD;
    const bf16* VT = (const bf16*)(a.ws + WS_MVT) + ((size_t)((layer * 40 + bq) * 4 + hd)) * HD * MEML;
    LAS bf16x8* ql = (LAS bf16x8*)(wreg + 2048);
    { bf16x8 qf[8]; load_qf(qf, MEMQ + (size_t)row * MEMW + hd * HD, h);
#pragma unroll
      for (int ks = 0; ks < 8; ++ks) ql[ks * 64 + lane] = qf[ks]; }
    LDS_WAIT(); asm volatile("" ::: "memory");
    AttnAcc A; attn_init(A);
    attn_run(A, ql, K, VT, 0xffull, 0.f, 0, [](int, int) { return true; }, [](int) { return true; }, lane);
    const float inv = attn_inv(A);
#pragma unroll
    for (int db = 0; db < 4; ++db) A.o[db] *= inv;
    if (r < nvalid) store_ot((bf16*)(a.ws + WS_CAT) + (size_t)row * D + TOK + hd * HD, A.o, h);
    LDS_WAIT(); asm volatile("" ::: "memory");
}

DI void memattn_wg(ArgsRef a, int layer, int item, LAS unsigned char* lds, int tid) {
    const int wave = __builtin_amdgcn_readfirstlane(tid >> 6), lane = tid & 63, r = lane & 31, h = lane >> 5;
    int bq, hd, row, nvalid; bool active;
    if (item < 256) { bq = item >> 5; hd = (item >> 3) & 3; const int tau = (item & 7) * 8 + wave; row = bq * TP + tau * 32 + r; nvalid = 32; active = true; }
    else { const int j = item - 256; const int bs = j >> 2; hd = j & 3; bq = 8 + bs; row = MPR + bs * 4 + (r < 4 ? r : 3); nvalid = 4; active = wave == 0; }
    const bf16* MEMQ = (const bf16*)(a.ws + WS_MEMQ);
    const bf16* K = (const bf16*)(a.ws + WS_MK) + ((size_t)((layer * 40 + bq) * 4 + hd)) * MEML * HD;
    const bf16* VT = (const bf16*)(a.ws + WS_MVT) + ((size_t)((layer * 40 + bq) * 4 + hd)) * HD * MEML;
    __syncthreads();
    { const u32x4* kc = (const u32x4*)K; const u32x4* vc = (const u32x4*)VT;
      u32x4 tk[8], tv[8];
#pragma unroll
      for (int j = 0; j < 8; ++j) { tk[j] = kc[j * NTHR + tid]; tv[j] = vc[j * NTHR + tid]; }
#pragma unroll
      for (int j = 0; j < 8; ++j) { ((LAS u32x4*)lds)[j * NTHR + tid] = tk[j]; ((LAS u32x4*)(lds + 65536))[j * NTHR + tid] = tv[j]; } }
    bf16x8 qf[8]; load_qf(qf, MEMQ + (size_t)row * MEMW + hd * HD, h);
    __syncthreads();
    if (active) {
        const LAS bf16x8* KL = (const LAS bf16x8*)lds + lane; const LAS bf16x8* VL = (const LAS bf16x8*)(lds + 65536) + lane;
        AttnAcc A; attn_init(A);
#pragma unroll 1
        for (int kt = 0; kt < 8; ++kt) {
            f32x16 s = zero16();
#pragma unroll
            for (int ks = 0; ks < 8; ++ks) s = MFMA32(KL[(kt * 8 + ks) * 64], qf[ks], s);
            float mt = -1e30f;
#pragma unroll
            for (int i = 0; i < 16; ++i) { s[i] *= SCALE2; mt = fmaxf(mt, s[i]); }
            mt = fmaxf(mt, __shfl_xor(mt, 32));
            float mn = A.m;
            if (__any(mt > A.m + 8.f)) { mn = fmaxf(A.m, mt); const float alpha = __builtin_amdgcn_exp2f(A.m - mn); A.m = mn; A.l *= alpha;
#pragma unroll
                for (int db = 0; db < 4; ++db) A.o[db] *= alpha; }
            float ls = 0.f;
#pragma unroll
            for (int i = 0; i < 16; ++i) { const float p = __builtin_amdgcn_exp2f(s[i] - mn); s[i] = p; ls += p; }
            A.l += ls;
#pragma unroll
            for (int st = 0; st < 2; ++st) { const bf16x8 pf = packp(s, st);
#pragma unroll
                for (int db = 0; db < 4; ++db) A.o[db] = MFMA32(VL[(kt * 8 + st * 4 + db) * 64], pf, A.o[db]); }
        }
        const float inv = attn_inv(A);
#pragma unroll
        for (int db = 0; db < 4; ++db) A.o[db] *= inv;
        if (r < nvalid) store_ot((bf16*)(a.ws + WS_CAT) + (size_t)row * D + TOK + hd * HD, A.o, h);
    }
    __syncthreads();
}

DI void cmp1_item(ArgsRef a, int it, int lane) {
    const int r = lane & 31, h = lane >> 5;
    const int kv = it >> 9, mt = (it >> 3) & 63, nt = it & 7;
    const bf16* Ap = (const bf16*)(a.ws + (kv ? WS_VCMP : WS_KCMP)) + (size_t)(32 * mt + r) * 2048 + 8 * h;
    const bf16* Bp = (const bf16*)(a.ws + WS_BTC) + (size_t)kv * 256 * 2048 + (size_t)(32 * nt + r) * 2048 + 8 * h;
    f32x16 c = zero16();
#pragma unroll 8
    for (int ks = 0; ks < 128; ++ks) { const bf16x8 af = *(const bf16x8*)(Ap + 16 * ks), bfr = *(const bf16x8*)(Bp + 16 * ks); c = MFMA32(af, bfr, c); }
    float* P = (float*)(a.ws + WS_PPP) + (size_t)kv * 2048 * 256;
#pragma unroll
    for (int i = 0; i < 16; ++i) P[(size_t)(32 * mt + crow(i, h)) * 256 + 32 * nt + r] = c[i];
}
DI void cmp2_item(ArgsRef a, int it, int lane) {
    const int r = lane & 31, h = lane >> 5;
    const bool prompt = it < 128; int kv, bg, blk, nI; const float* PP;
    if (prompt) { kv = it >> 6; bg = (it >> 2) & 15; blk = it & 3; nI = 128; PP = (const float*)(a.ws + WS_PPP) + (size_t)kv * 2048 * 256; }
    else { const int j = it - 128; kv = j >> 10; bg = (j >> 4) & 63; blk = j & 15; nI = 512; PP = (const float*)(a.ws + WS_PPS) + (size_t)kv * 32768 * 256; }
    const int irow = 32 * blk + r, ic = irow < nI - 1 ? irow : nI - 2;
    const float* p0r = PP + ((size_t)bg * nI + ic) * 256 + 8 * h; const float* p1r = p0r + 256 + 128; const float* c0r = (const float*)(a.ws + WS_PRE0) + kv * 128 + 8 * h;
    bf16x8 af[8];
#pragma unroll
    for (int ks = 0; ks < 8; ++ks) {
        const f32x4 x0 = *(const f32x4*)(p0r + 16 * ks), x1 = *(const f32x4*)(p0r + 16 * ks + 4), y0 = *(const f32x4*)(p1r + 16 * ks), y1 = *(const f32x4*)(p1r + 16 * ks + 4);
        const f32x4 z0 = *(const f32x4*)(c0r + 16 * ks), z1 = *(const f32x4*)(c0r + 16 * ks + 4);
        u32x4 w; w.x = pk2(gelu_t(x0[0] + y0[0] + z0[0]), gelu_t(x0[1] + y0[1] + z0[1])); w.y = pk2(gelu_t(x0[2] + y0[2] + z0[2]), gelu_t(x0[3] + y0[3] + z0[3]));
        w.z = pk2(gelu_t(x1[0] + y1[0] + z1[0]), gelu_t(x1[1] + y1[1] + z1[1])); w.w = pk2(gelu_t(x1[2] + y1[2] + z1[2]), gelu_t(x1[3] + y1[3] + z1[3]));
        af[ks] = __builtin_bit_cast(bf16x8, w);
    }
    const bf16* W2T = (const bf16*)(a.ws + WS_W2T) + (size_t)kv * 16384;
#pragma unroll
    for (int nb = 0; nb < 4; ++nb) {
        const bf16* bp = W2T + (size_t)(32 * nb + r) * 128 + 8 * h;
        f32x16 c = zero16();
#pragma unroll
        for (int ks = 0; ks < 8; ++ks) c = MFMA32(af[ks], *(const bf16x8*)(bp + 16 * ks), c);
        const int d = 32 * nb + r;
#pragma unroll
        for (int i = 0; i < 16; ++i) {
            const int ir = 32 * blk + crow(i, h);
            if (prompt) {
                const float v = ir < NCP ? c[i] : 0.f;
                if (kv == 0) ((bf16*)(a.ws + WS_KC))[(size_t)bg * 16384 + (size_t)(ir >> 5) * 4096 + kf_off(ir & 31, d)] = f2bf(v);
                else ((bf16*)(a.ws + WS_VCT))[(size_t)bg * 16384 + (size_t)(ir >> 5) * 4096 + vf_off(ir & 31, d)] = f2bf(v);
            } else if (ir < NCS) {
                ((float*)(a.ws + (kv ? WS_VCS : WS_KCS)))[((size_t)bg * 512 + ir) * 128 + d] = c[i];
            }
        }
    }
}
template <int KS, class FN>
DI void skinny_gemm(const FN& f, const bf16* A, const bf16* Bt, int N, int K, LAS unsigned char* lds, int bx, int G, int tid, int MT = 4, int orow0 = MPR) {
    constexpr int TPW = NWAVES / KS;
    const int wave = tid >> 6, lane = tid & 63, r = lane & 31, h = lane >> 5;
    const int ntiles = MT * (N >> 5), kw = K / KS, tl = wave / KS, ksub = wave % KS;
    LAS float* red = (LAS float*)lds;
    for (int step = bx; step * TPW < ntiles; step += G) {
        const int tile = step * TPW + tl, tcl = tile < ntiles ? tile : ntiles - 1, mt = tcl % MT, nt = tcl / MT;
        const bf16* Ap = A + (size_t)(32 * mt + r) * K + ksub * kw + 8 * h;
        const bf16* Bp = Bt + (size_t)(32 * nt + r) * K + ksub * kw + 8 * h;
        f32x16 c = zero16();
        for (int k0 = 0; k0 < (kw >> 4); k0 += 16) {
            bf16x8 af[16], bfr[16];
#pragma unroll
            for (int u = 0; u < 16; ++u) { const int ks = k0 + u < (kw >> 4) ? k0 + u : (kw >> 4) - 1; af[u] = *(const bf16x8*)(Ap + 16 * ks); bfr[u] = *(const bf16x8*)(Bp + 16 * ks); }
#pragma unroll
            for (int u = 0; u < 16; ++u) if (k0 + u < (kw >> 4)) c = MFMA32(af[u], bfr[u], c);
        }
        __syncthreads();
#pragma unroll
        for (int i = 0; i < 16; ++i) red[(wave * 16 + i) * 64 + lane] = c[i];
        __syncthreads();
        for (int q = tid; q < TPW * 128; q += NTHR) {
            const int tq = q >> 7, t7 = q & 127, tile2 = step * TPW + tq;
            if (tile2 < ntiles) {
                const int row = t7 >> 2, cg = (t7 & 3) * 8, hh = (row >> 2) & 1, ii = (row & 3) + 4 * (row >> 3);
                float v[8];
#pragma unroll
                for (int e = 0; e < 8; ++e) { float s = 0.f;
#pragma unroll
                    for (int w = 0; w < KS; ++w) s += red[((tq * KS + w) * 16 + ii) * 64 + cg + e + 32 * hh];
                    v[e] = s; }
                const int mt2 = tile2 % MT, nt2 = tile2 / MT;
                f(f.kind((32 * nt2) >> 8), orow0 + 32 * mt2 + row, 32 * nt2 + cg, (f32x4){v[0], v[1], v[2], v[3]}, (f32x4){v[4], v[5], v[6], v[7]});
            }
        }
    }
    __syncthreads();
}


DI void cmpgemm_direct(ArgsRef a, LAS unsigned char* lds, int item, int tid) {
    const int wave = __builtin_amdgcn_readfirstlane(tid >> 6), lane = tid & 63, r = lane & 31, h = lane >> 5;
    const int kv = item >> 7, blk = item & 127;
    const int R = blk * 256 + wave * 32 + r, b = R >> 10, g = (R >> 9) & 1, cc = R & 511;
    const int page = ((const int*)a.in[I_PT])[b * NPAGE + (cc >> 3)];
    const float* ab = a.in[I_CKV] + ((size_t)page * PAGE + (cc & 7) * 16) * 1024 + kv * 256 + g * 128 + 8 * h;
    const bf16* bs = (const bf16*)(a.ws + WS_BTC) + (size_t)kv * 256 * 2048 + (size_t)(32 * (tid >> 6) + r) * 2048 + 8 * h;
    f32x16 acc[8];
#pragma unroll
    for (int nb = 0; nb < 8; ++nb) acc[nb] = zero16();
    f32x4 ac[4][2], an[4][2]; u32x4 bn[4];
    auto lda = [&](f32x4 (&A)[4][2], int t) {
#pragma unroll
        for (int q = 0; q < 4; ++q) { const int k0 = 64 * t + 16 * q; const float* p = ab + (size_t)(k0 >> 7) * 1024 + (k0 & 127); A[q][0] = *(const f32x4*)p; A[q][1] = *(const f32x4*)(p + 4); }
    };
    auto ldb = [&](int t) {
#pragma unroll
        for (int q = 0; q < 4; ++q) bn[q] = *(const u32x4*)(bs + 64 * t + 16 * q);
    };
    auto stb = [&](int t) {
        LAS u32x4* B = (LAS u32x4*)(lds + (t & 1) * 32768);
#pragma unroll
        for (int q = 0; q < 4; ++q) B[(q * 8 + wave) * 64 + lane] = bn[q];
    };
    __syncthreads();
    lda(ac, 0); ldb(0); stb(0);
    TR_BAR();
    for (int t = 0; t < 32; ++t) {
        if (t + 1 < 32) { lda(an, t + 1); ldb(t + 1); }
        const LAS bf16x8* B = (const LAS bf16x8*)(lds + (t & 1) * 32768) + lane;
#pragma unroll
        for (int q = 0; q < 4; ++q) {
            u32x4 w; w.x = pk2(ac[q][0][0], ac[q][0][1]); w.y = pk2(ac[q][0][2], ac[q][0][3]); w.z = pk2(ac[q][1][0], ac[q][1][1]); w.w = pk2(ac[q][1][2], ac[q][1][3]);
            const bf16x8 af = __builtin_bit_cast(bf16x8, w);
#pragma unroll
            for (int nb = 0; nb < 8; ++nb) acc[nb] = MFMA32(af, B[(q * 8 + nb) * 64], acc[nb]);
        }
        if (t + 1 < 32) { stb(t + 1);
#pragma unroll
            for (int q = 0; q < 4; ++q) { ac[q][0] = an[q][0]; ac[q][1] = an[q][1]; } }
        TR_BAR();
    }
    float* P = (float*)(a.ws + WS_PPS) + (size_t)kv * 32768 * 256 + (size_t)(blk * 256 + wave * 32) * 256;
#pragma unroll
    for (int nb = 0; nb < 8; ++nb)
#pragma unroll
        for (int i = 0; i < 16; ++i) P[(size_t)crow(i, h) * 256 + 32 * nb + r] = acc[nb][i];
    __syncthreads();
}

DI void hgrn_sample_item(ArgsRef a, LAS unsigned char* lds, int bs, int hh, int tid) {
    const int wave = tid >> 6, lane = tid & 63, vloc = lane & 15, kg = lane >> 4, v = wave * 16 + vloc;
    const bf16* QA = (const bf16*)(a.ws + WS_QA); const float* FA = (const float*)(a.ws + WS_FA); const bf16* VA = (const bf16*)(a.ws + WS_VA);
    const float* s0 = a.in[I_HST] + ((size_t)(bs * NH + hh) * HD + kg * 32) * HD + v;
    float S[32];
#pragma unroll
    for (int i = 0; i < 32; ++i) S[i] = s0[(size_t)i * HD];
    LAS float* OS = (LAS float*)lds;
#pragma unroll 1
    for (int tp = 0; tp < TS; tp += 2) {
        u32x4 qw[2][4]; f32x4 fw[2][8]; float vv[2];
#pragma unroll
        for (int u = 0; u < 2; ++u) {
            const size_t ro = (size_t)(MPR + bs * TS + tp + u) * TOK + hh * HD;
#pragma unroll
            for (int j = 0; j < 4; ++j) qw[u][j] = *(const u32x4*)(QA + ro + kg * 32 + 8 * j);
#pragma unroll
            for (int j = 0; j < 8; ++j) fw[u][j] = *(const f32x4*)(FA + ro + kg * 32 + 4 * j);
            vv[u] = bf2f(VA[ro + v]);
        }
#pragma unroll
        for (int u = 0; u < 2; ++u) {
            float acc = 0.f;
#pragma unroll
            for (int j = 0; j < 8; ++j) {
                const unsigned w0 = qw[u][j >> 1][(j & 1) * 2], w1 = qw[u][j >> 1][(j & 1) * 2 + 1];
                const float q4[4] = {bflo(w0), bfhi(w0), bflo(w1), bfhi(w1)};
#pragma unroll
                for (int e = 0; e < 4; ++e) { const float f = fw[u][j][e]; const int i = 4 * j + e; S[i] = f * S[i] + (1.f - f) * vv[u]; acc += S[i] * q4[e]; }
            }
            acc += __shfl_xor(acc, 16); acc += __shfl_xor(acc, 32);
            if (kg == 0) OS[(tp + u) * HD + v] = acc;
        }
    }
    float* so = a.out + O_HS + ((size_t)(bs * NH + hh) * HD + kg * 32) * HD + v;
#pragma unroll
    for (int i = 0; i < 32; ++i) so[(size_t)i * HD] = S[i];
    __syncthreads();
    if (wave < TS) {
        const int row = MPR + bs * TS + wave;
        const f32x2 o = *(const LAS f32x2*)(OS + wave * HD + 2 * lane);
        const float rs = rsqrtf(wave_sum(o[0] * o[0] + o[1] * o[1]) * (1.f / HD) + EPS);
        const f32x2 gn = *(const f32x2*)(a.in[I_HGN] + hh * HD + 2 * lane);
        const unsigned og = *(const unsigned*)((const bf16*)(a.ws + WS_OGA) + (size_t)row * TOK + hh * HD + 2 * lane);
        *(unsigned*)((bf16*)(a.ws + WS_CAT) + (size_t)row * D + hh * HD + 2 * lane) = pk2(o[0] * rs * gn[0] * bflo(og), o[1] * rs * gn[1] * bfhi(og));
    }
    __syncthreads();
}

constexpr int HG_BUF = 33792;
constexpr int HG_SSQ = 3 * HG_BUF;
#define HG_BAR() asm volatile("s_waitcnt lgkmcnt(0)\n\ts_barrier" ::: "memory")
DI void hgrn_mfma_item(ArgsRef a, LAS unsigned char* lds, int bh, int tid) {
    const int wave = __builtin_amdgcn_readfirstlane(tid >> 6), lane = tid & 63, r = lane & 31, hh = lane >> 5;
    const int b = bh / NH, h = bh - b * NH;
    const size_t img = (size_t)bh * 64 * 4096;
    __syncthreads();
    if (wave >= 4) {
        const int lw = wave - 4;
        const bf16* src[4] = {(const bf16*)(a.ws + WS_QP) + img, (const bf16*)(a.ws + WS_KP) + img, (const bf16*)(a.ws + WS_KT) + img, (const bf16*)(a.ws + WS_VF) + img};
        const float* dvs = (const float*)(a.ws + WS_DV) + (size_t)bh * 64 * 256;
        u32x4 R0[9], R1[9];
        auto gl = [&](u32x4 (&R)[9], int c) {
            c = c < 64 ? c : 63;
#pragma unroll
            for (int j = 0; j < 8; ++j) R[j] = *(const u32x4*)(src[j >> 1] + (size_t)c * 4096 + (size_t)(((j & 1) * 256 + lw * 64 + lane) * 8));
            R[8] = *(const u32x4*)(dvs + (size_t)c * 256 + lane * 4);
        };
        auto lw_ = [&](const u32x4 (&R)[9], int c) {
            LAS unsigned char* bufp = lds + (c % 3) * HG_BUF;
#pragma unroll
            for (int j = 0; j < 8; ++j) *(LAS u32x4*)(bufp + (j >> 1) * 8192 + ((j & 1) * 256 + lw * 64 + lane) * 16) = R[j];
            if (lw == 0) *(LAS u32x4*)(bufp + 32768 + lane * 16) = R[8];
        };
        gl(R0, 0); gl(R1, 1);
        lw_(R0, 0); gl(R0, 2);
        HG_BAR();
        for (int c = 0; c < 64; c += 2) {
            lw_(R1, c + 1); gl(R1, c + 3);
            HG_BAR();
            if (c + 2 < 64) lw_(R0, c + 2);
            gl(R0, c + 4);
            HG_BAR();
        }
    } else {
        const int vb = wave;
        f32x16 S[4]; for (int kb = 0; kb < 4; ++kb) S[kb] = zero16();
        f32x16 Oprev = zero16(); u32x2 ogp[4] = {};
        float gn[16];
#pragma unroll
        for (int i = 0; i < 16; ++i) gn[i] = a.in[I_HGN][h * HD + 32 * vb + crow(i, hh)];
        LAS float* SSQ = (LAS float*)(lds + HG_SSQ);
        const bf16* OGA = (const bf16*)(a.ws + WS_OGA); bf16* CAT = (bf16*)(a.ws + WS_CAT);
        auto finish = [&](int cp) {
            const LAS float* sq = SSQ + (cp & 1) * 128;
            const float ss = (sq[r] + sq[32 + r]) + (sq[64 + r] + sq[96 + r]);
            const float rs = rsqrtf(ss * (1.f / HD) + EPS);
            bf16* orow = CAT + (size_t)(b * TP + cp * 32 + r) * D + h * HD + 32 * vb + 4 * hh;
#pragma unroll
            for (int c4 = 0; c4 < 4; ++c4) {
                const u32x2 g = ogp[c4];
                u32x2 w; w.x = pk2(Oprev[4 * c4] * rs * gn[4 * c4] * bflo(g.x), Oprev[4 * c4 + 1] * rs * gn[4 * c4 + 1] * bfhi(g.x));
                w.y = pk2(Oprev[4 * c4 + 2] * rs * gn[4 * c4 + 2] * bflo(g.y), Oprev[4 * c4 + 3] * rs * gn[4 * c4 + 3] * bfhi(g.y));
                *(u32x2*)(orow + 8 * c4) = w;
            }
        };
        HG_BAR();
        for (int c = 0; c < 64; ++c) {
            const LAS unsigned char* bufp = lds + (c % 3) * HG_BUF;
            const LAS bf16x8* QF = (const LAS bf16x8*)bufp + lane; const LAS bf16x8* KF = (const LAS bf16x8*)(bufp + 8192) + lane;
            const LAS bf16x8* TF = (const LAS bf16x8*)(bufp + 16384) + lane; const LAS bf16x8* VF = (const LAS bf16x8*)(bufp + 24576) + lane;
            const LAS float* dvec = (const LAS float*)(bufp + 32768);
            if (c > 0) finish(c - 1);
            { const bf16* ogr = OGA + (size_t)(b * TP + c * 32 + r) * TOK + h * HD + 32 * vb + 4 * hh;
#pragma unroll
              for (int c4 = 0; c4 < 4; ++c4) ogp[c4] = *(const u32x2*)(ogr + 8 * c4); }
            f32x16 X = zero16();
#pragma unroll
            for (int f = 0; f < 8; ++f) X = MFMA32(KF[f * 64], QF[f * 64], X);
#pragma unroll
            for (int i = 0; i < 16; ++i) X[i] = crow(i, hh) <= r ? X[i] : 0.f;
            const bf16x8 v0 = VF[(0 * 4 + vb) * 64], v1 = VF[(1 * 4 + vb) * 64];
            f32x16 O = zero16();
            O = MFMA32(v0, packp(X, 0), O); O = MFMA32(v1, packp(X, 1), O);
#pragma unroll
            for (int kb = 0; kb < 4; ++kb) {
                f32x16 T;
#pragma unroll
                for (int c4 = 0; c4 < 4; ++c4) { const f32x4 e1 = *(const LAS f32x4*)(dvec + 128 + 32 * kb + 8 * c4 + 4 * hh);
#pragma unroll
                    for (int e = 0; e < 4; ++e) T[4 * c4 + e] = S[kb][4 * c4 + e] * e1[e]; }
                O = MFMA32(packp(T, 0), QF[(kb * 2 + 0) * 64], O); O = MFMA32(packp(T, 1), QF[(kb * 2 + 1) * 64], O);
            }
            { float q = 0.f;
#pragma unroll
              for (int i = 0; i < 16; ++i) q += O[i] * O[i];
              q += __shfl_xor(q, 32);
              if (hh == 0) SSQ[(c & 1) * 128 + vb * 32 + r] = q; }
            Oprev = O;
#pragma unroll
            for (int kb = 0; kb < 4; ++kb) {
                f32x16 U = zero16();
                U = MFMA32(TF[(0 * 4 + kb) * 64], v0, U); U = MFMA32(TF[(1 * 4 + kb) * 64], v1, U);
#pragma unroll
                for (int c4 = 0; c4 < 4; ++c4) { const f32x4 dd = *(const LAS f32x4*)(dvec + 32 * kb + 8 * c4 + 4 * hh);
#pragma unroll
                    for (int e = 0; e < 4; ++e) S[kb][4 * c4 + e] = S[kb][4 * c4 + e] * dd[e] + U[4 * c4 + e]; }
            }
            HG_BAR();
        }
        finish(63);
        float* so = a.out + O_HP + (size_t)bh * HD * HD + 32 * vb + r;
#pragma unroll
        for (int kb = 0; kb < 4; ++kb)
#pragma unroll
            for (int i = 0; i < 16; ++i) so[(size_t)(32 * kb + crow(i, hh)) * HD] = S[kb][i];
    }
    __syncthreads();
}

template <bool FIRST, bool LAST>
DI void normpass(ArgsRef a, const float* gain, int gw, int ngw, int lane) {
    const bf16* OB = (const bf16*)(a.ws + WS_OB); bf16* H = (bf16*)(a.ws + WS_H); bf16* XN = (bf16*)(a.ws + WS_XN);
    f32x4 g4[8];
#pragma unroll
    for (int j = 0; j < 8; ++j) g4[j] = ((const f32x4*)gain)[lane + 64 * j];
    u32x2 ow[8], own[8]; f32x4 hf[8], hfn[8]; u32x2 hw[8], hwn[8];
    auto ldrow = [&](int m, u32x2 (&o_)[8], f32x4 (&hf_)[8], u32x2 (&hw_)[8]) {
        const u32x2* orow = (const u32x2*)(OB + (size_t)m * D) + lane;
#pragma unroll
        for (int j = 0; j < 8; ++j) o_[j] = orow[64 * j];
        if (FIRST) { const float* hrow = m < MPR ? a.in[I_XP] + (size_t)m * D : a.in[I_XS] + (size_t)(m - MPR) * D;
#pragma unroll
            for (int j = 0; j < 8; ++j) hf_[j] = ((const f32x4*)hrow)[lane + 64 * j]; }
        else { const u32x2* hrow = (const u32x2*)(H + (size_t)m * D) + lane;
#pragma unroll
            for (int j = 0; j < 8; ++j) hw_[j] = hrow[64 * j]; }
    };
    if (gw < MR) ldrow(gw, ow, hf, hw);
    for (int m = gw; m < MR; m += ngw) {
        if (m + ngw < MR) ldrow(m + ngw, own, hfn, hwn);
        f32x4 o[8], hv[8]; float ss = 0.f;
#pragma unroll
        for (int j = 0; j < 8; ++j) { hv[j] = FIRST ? hf[j] : (f32x4){bflo(hw[j].x), bfhi(hw[j].x), bflo(hw[j].y), bfhi(hw[j].y)};
            o[j] = (f32x4){bflo(ow[j].x), bfhi(ow[j].x), bflo(ow[j].y), bfhi(ow[j].y)};
            ss += (o[j][0] * o[j][0] + o[j][1] * o[j][1]) + (o[j][2] * o[j][2] + o[j][3] * o[j][3]); }
        const float rs = rsqrtf(wave_sum(ss) * (1.f / D) + EPS);
        float s2 = 0.f;
#pragma unroll
        for (int j = 0; j < 8; ++j) { hv[j] = hv[j] + o[j] * rs * g4[j]; s2 += (hv[j][0] * hv[j][0] + hv[j][1] * hv[j][1]) + (hv[j][2] * hv[j][2] + hv[j][3] * hv[j][3]); }
        if (LAST) {
            float* y = m < MPR ? a.out + O_YP + (size_t)m * D : a.out + O_YS + (size_t)(m - MPR) * D;
#pragma unroll
            for (int j = 0; j < 8; ++j) ((f32x4*)y)[lane + 64 * j] = hv[j];
        } else {
            const float r2 = rsqrtf(wave_sum(s2) * (1.f / D) + EPS);
            u32x2* xo = (u32x2*)(XN + (size_t)m * D) + lane;
#pragma unroll
            for (int j = 0; j < 8; ++j) { u32x2 hw; hw.x = pk2(hv[j][0], hv[j][1]); hw.y = pk2(hv[j][2], hv[j][3]); ((u32x2*)(H + (size_t)m * D))[lane + 64 * j] = hw;
                u32x2 w; w.x = pk2(hv[j][0] * r2, hv[j][1] * r2); w.y = pk2(hv[j][2] * r2, hv[j][3] * r2); xo[64 * j] = w; }
        }
#pragma unroll
        for (int j = 0; j < 8; ++j) { ow[j] = own[j]; if (FIRST) hf[j] = hfn[j]; else hw[j] = hwn[j]; }
    }
}

DI f32x4 cvlo(u32x4 w) { return (f32x4){bflo(w.x), bfhi(w.x), bflo(w.y), bfhi(w.y)}; }
DI f32x4 cvhi(u32x4 w) { return (f32x4){bflo(w.z), bfhi(w.z), bflo(w.w), bfhi(w.w)}; }
DI void ffn_fixup(ArgsRef a, int layer, int gtid, int nthr) {
    const float* FIX = (const float*)(a.ws + WS_FIX); const float* HALO = (const float*)(a.ws + WS_HALO); bf16* HID = (bf16*)(a.ws + WS_HID);
    const float* wc = a.in[I_WCONV] + (size_t)layer * 3 * FF; const float* bc = a.in[I_BCONV] + (size_t)layer * FF;
    constexpr int C8 = FF / 8;
    for (int it = gtid; it < 512 * C8; it += nthr) {
        const int ri = it / C8, c8 = (it - ri * C8) * 8, blk = ri >> 1, i = ri & 1, row = blk * 64 + i, t = row & (TP - 1);
        const float* fp = FIX + ((size_t)ri * 2) * FF + c8;
        f32x4 cl = *(const f32x4*)(bc + c8), ch = *(const f32x4*)(bc + c8 + 4);
        cl += *(const f32x4*)(wc + 2 * FF + c8) * *(const f32x4*)fp; ch += *(const f32x4*)(wc + 2 * FF + c8 + 4) * *(const f32x4*)(fp + 4);
        if (t >= 1) { const float* p1 = i == 0 ? HALO + ((size_t)((blk - 1) * 2 + 1)) * FF + c8 : FIX + ((size_t)(blk * 2) * 2) * FF + c8;
            cl += *(const f32x4*)(wc + FF + c8) * *(const f32x4*)p1; ch += *(const f32x4*)(wc + FF + c8 + 4) * *(const f32x4*)(p1 + 4); }
        if (t >= 2) { const float* p0 = HALO + ((size_t)((blk - 1) * 2 + i)) * FF + c8;
            cl += *(const f32x4*)(wc + c8) * *(const f32x4*)p0; ch += *(const f32x4*)(wc + c8 + 4) * *(const f32x4*)(p0 + 4); }
        const f32x4 gl = *(const f32x4*)(fp + FF), gh = *(const f32x4*)(fp + FF + 4);
#pragma unroll
        for (int e = 0; e < 4; ++e) { cl[e] = gelu_t(cl[e]) * gl[e]; ch[e] = gelu_t(ch[e]) * gh[e]; }
        *(u32x4*)(HID + (size_t)row * FF + c8) = pack8(cl, ch);
    }
}
DI void gating_pass(ArgsRef a, int layer, int gtid, int nthr) {
    const bf16* AB = (const bf16*)(a.ws + WS_AB); bf16* HID = (bf16*)(a.ws + WS_HID);
    const float* wc = a.in[I_WCONV] + (size_t)layer * 3 * FF; const float* bc = a.in[I_BCONV] + (size_t)layer * FF;
    constexpr int C8 = FF / 8;
    for (int it = gtid; it < MSR * C8; it += nthr) {
        const int row = MPR + it / C8, c8 = (it % C8) * 8;
        const bool prm = row < MPR; const int t = prm ? (row & (TP - 1)) : ((row - MPR) & 3);
        const bf16* ar = AB + (size_t)row * FF2 + c8;
        const u32x4 wa = *(const u32x4*)ar, wb = *(const u32x4*)(ar + FF);
        f32x4 e2l = cvlo(wa), e2h = cvhi(wa), e1l, e1h, e0l, e0h;
        const float* cb = prm ? nullptr : a.in[I_CCONV] + ((size_t)(layer * BS + ((row - MPR) >> 2)) * 2) * FF + c8;
        if (t >= 1) { const u32x4 w = *(const u32x4*)(ar - FF2); e1l = cvlo(w); e1h = cvhi(w); }
        else if (prm) { e1l = (f32x4){0.f, 0.f, 0.f, 0.f}; e1h = e1l; }
        else { e1l = *(const f32x4*)(cb + FF); e1h = *(const f32x4*)(cb + FF + 4); }
        if (t >= 2) { const u32x4 w = *(const u32x4*)(ar - 2 * FF2); e0l = cvlo(w); e0h = cvhi(w); }
        else if (prm) { e0l = (f32x4){0.f, 0.f, 0.f, 0.f}; e0h = e0l; }
        else { e0l = *(const f32x4*)(cb + (size_t)t * FF); e0h = *(const f32x4*)(cb + (size_t)t * FF + 4); }
        const f32x4 w0l = *(const f32x4*)(wc + c8), w0h = *(const f32x4*)(wc + c8 + 4), w1l = *(const f32x4*)(wc + FF + c8), w1h = *(const f32x4*)(wc + FF + c8 + 4);
        const f32x4 w2l = *(const f32x4*)(wc + 2 * FF + c8), w2h = *(const f32x4*)(wc + 2 * FF + c8 + 4), bl = *(const f32x4*)(bc + c8), bh = *(const f32x4*)(bc + c8 + 4);
        f32x4 cl = bl + w0l * e0l + w1l * e1l + w2l * e2l, ch = bh + w0h * e0h + w1h * e1h + w2h * e2h;
        const f32x4 gbl = cvlo(wb), gbh = cvhi(wb);
#pragma unroll
        for (int e = 0; e < 4; ++e) { cl[e] = gelu_t(cl[e]) * gbl[e]; ch[e] = gelu_t(ch[e]) * gbh[e]; }
        *(u32x4*)(HID + (size_t)row * FF + c8) = pack8(cl, ch);
    }
}

DI float alibi_slope2(int head) { return exp2f(-8.f * (float)(head + 1) / 12.f) * LOG2E; }

DI void nsa_cmp_wg(ArgsRef a, LAS unsigned char* lds, int p, int tid) {
    const int wave = __builtin_amdgcn_readfirstlane(tid >> 6), lane = tid & 63;
    const int r = lane & 31, h = lane >> 5;
    const int bg = p >> 3, jq = (p & 7) * 4 + (wave & 3), tau = wave < 4 ? 63 - jq : jq, ntile = (tau >> 4) + 1, b = bg >> 1, g = bg & 1, t0 = tau * 32, row = b * TP + t0 + r, qpos = t0 + r;
    const bf16* QB = (const bf16*)(a.ws + WS_QB); const float* GATES = (const float*)(a.ws + WS_GATES);
    bf16* OCMP = (bf16*)(a.ws + WS_OCMP);
    __syncthreads();
    { const u32x4* kc = (const u32x4*)((const bf16*)(a.ws + WS_KC) + (size_t)bg * 16384); const u32x4* vc = (const u32x4*)((const bf16*)(a.ws + WS_VCT) + (size_t)bg * 16384);
      u32x4 tk[4], tv[4];
#pragma unroll
      for (int j = 0; j < 4; ++j) { tk[j] = kc[j * NTHR + tid]; tv[j] = vc[j * NTHR + tid]; }
#pragma unroll
      for (int j = 0; j < 4; ++j) { ((LAS u32x4*)lds)[j * NTHR + tid] = tk[j]; ((LAS u32x4*)(lds + 32768))[j * NTHR + tid] = tv[j]; } }
    __syncthreads();
    const LAS bf16x8* KL = (const LAS bf16x8*)lds + lane; const LAS bf16x8* VL = (const LAS bf16x8*)(lds + 32768) + lane;
    LAS float* CL = (LAS float*)(lds + 65536 + wave * 8192);
    for (int u = ntile * 512 + lane; u < 2048; u += 64) CL[u] = 0.f;
    for (int hr = 0; hr < HPG; ++hr) {
        const int head = g * HPG + hr; const float slope2 = alibi_slope2(head);
        bf16x8 qf[8]; load_qf(qf, QB + (size_t)row * TOK + head * HD, h);
        float m = -1e30f, l = 0.f;
#pragma unroll 1
        for (int kt = 0; kt < ntile; ++kt) {
            f32x16 s = zero16();
#pragma unroll
            for (int ks = 0; ks < 8; ++ks) s = MFMA32(KL[(kt * 8 + ks) * 64], qf[ks], s);
            float mt = -1e30f;
#pragma unroll
            for (int i = 0; i < 16; ++i) {
                const int n = 32 * kt + crow(i, h), kp = 16 * n + 31;
                float v = s[i] * SCALE2 + slope2 * (float)(kp - t0);
                v = (n < NCP && kp <= qpos) ? v : -1e30f;
                s[i] = v; mt = fmaxf(mt, v);
            }
            mt = fmaxf(mt, __shfl_xor(mt, 32));
            const float mn = fmaxf(m, mt); float ls = 0.f;
#pragma unroll
            for (int i = 0; i < 16; ++i) ls += s[i] > -1e29f ? __builtin_amdgcn_exp2f(s[i] - mn) : 0.f;
            l = l * __builtin_amdgcn_exp2f(m - mn) + ls; m = mn;
        }
        l += __shfl_xor(l, 32);
        const float inv = l > 0.f ? 1.f / l : 0.f;
        f32x16 o[4];
#pragma unroll
        for (int db = 0; db < 4; ++db) o[db] = zero16();
#pragma unroll 1
        for (int kt = 0; kt < ntile; ++kt) {
            f32x16 s = zero16();
#pragma unroll
            for (int ks = 0; ks < 8; ++ks) s = MFMA32(KL[(kt * 8 + ks) * 64], qf[ks], s);
#pragma unroll
            for (int i = 0; i < 16; ++i) {
                const int n = 32 * kt + crow(i, h), kp = 16 * n + 31;
                const float v = s[i] * SCALE2 + slope2 * (float)(kp - t0);
                s[i] = (n < NCP && kp <= qpos) ? __builtin_amdgcn_exp2f(v - m) * inv : 0.f;
            }
#pragma unroll
            for (int c = 0; c < 4; ++c) {
                const float co = (s[4 * c] + s[4 * c + 1]) + (s[4 * c + 2] + s[4 * c + 3]), la = s[4 * c + 3];
                LAS float* cp = CL + ((kt * 4 + c) * 2) * 64 + lane;
                if (hr == 0) { cp[0] = co; cp[64] = la; } else { cp[0] += co; cp[64] += la; }
            }
#pragma unroll
            for (int st = 0; st < 2; ++st) { const bf16x8 pf = packp(s, st);
#pragma unroll
                for (int db = 0; db < 4; ++db) o[db] = MFMA32(VL[(kt * 8 + st * 4 + db) * 64], pf, o[db]); }
        }
        const float g0 = GATES[(size_t)row * 40 + head * 3 + 0];
#pragma unroll
        for (int db = 0; db < 4; ++db) o[db] *= g0;
        store_ot(OCMP + (size_t)row * TOK + head * HD, o, h);
    }
    LDS_WAIT(); asm volatile("" ::: "memory");
    float core[16], last[16];
#pragma unroll
    for (int idx = 0; idx < 16; ++idx) {
        core[idx] = CL[(idx * 2) * 64 + lane]; last[idx] = CL[(idx * 2 + 1) * 64 + lane];
    }
    LDS_WAIT(); asm volatile("" ::: "memory");
    const int cur = qpos >> 6;
    float sc[16], osc[16];
#pragma unroll
    for (int idx = 0; idx < 16; ++idx) {
        const float x = __shfl_xor(last[idx], 32);
        float xp = 0.f; if (idx > 0) xp = __shfl_xor(last[idx > 0 ? idx - 1 : 0], 32);
        const float prev = h ? x : xp;
        const int j = 2 * idx + h;
        const bool valid = j <= cur, forced = (j == 0) || (j == cur) || (j == cur - 1);
        sc[idx] = valid ? (core[idx] + prev) + (forced ? 1e4f : 0.f) : -1e30f;
    }
#pragma unroll
    for (int idx = 0; idx < 16; ++idx) osc[idx] = __shfl_xor(sc[idx], 32);
    unsigned mask = 0u;
#pragma unroll
    for (int idx = 0; idx < 16; ++idx) {
        const int j = 2 * idx + h; const float me = sc[idx]; int rank = 0;
#pragma unroll
        for (int k = 0; k < 16; ++k) {
            const int j1 = 2 * k + h, j2 = 2 * k + 1 - h;
            rank += (sc[k] > me || (sc[k] == me && j1 < j)) ? 1 : 0;
            rank += (osc[k] > me || (osc[k] == me && j2 < j)) ? 1 : 0;
        }
        if (rank < 16 && j <= cur) mask |= 1u << j;
    }
    mask |= __shfl_xor(mask, 32);
    if (h == 0) ((unsigned*)(a.ws + WS_SELM))[(size_t)row * 2 + g] = mask;
}

DI void nsa_selwin_item(ArgsRef a, int it, LAS float* stash, int lane) {
    const int r = lane & 31, h = lane >> 5;
    const int hr = it % HPG, bg = (it / HPG) & 15, tau = 63 - it / (HPG * 16);
    const int b = bg >> 1, g = bg & 1, head = g * HPG + hr, t0 = tau * 32, row = b * TP + t0 + r, qpos = t0 + r;
    const float slope2 = alibi_slope2(head);
    const bf16* QB = (const bf16*)(a.ws + WS_QB); const float* GATES = (const float*)(a.ws + WS_GATES);
    const size_t kvo = (size_t)bg * TP * HD;
    const bf16* KSEL = (const bf16*)(a.ws + WS_KSEL) + kvo; const bf16* VSELT = (const bf16*)(a.ws + WS_VSELT) + kvo;
    const bf16* KWIN = (const bf16*)(a.ws + WS_KWIN) + kvo; const bf16* VWINT = (const bf16*)(a.ws + WS_VWINT) + kvo;
    LAS bf16x8* ql = (LAS bf16x8*)(stash + 2048);
    { bf16x8 qf[8]; load_qf(qf, QB + (size_t)row * TOK + head * HD, h);
#pragma unroll
      for (int ks = 0; ks < 8; ++ks) ql[ks * 64 + lane] = qf[ks]; }
    LDS_WAIT(); asm volatile("" ::: "memory");
    LAS unsigned* stu = (LAS unsigned*)stash;
    const unsigned selm = ((const unsigned*)(a.ws + WS_SELM))[(size_t)row * 2 + g];
    unsigned um = selm;
#pragma unroll
    for (int o = 1; o < 64; o <<= 1) um |= __shfl_xor(um, o);
    um = __builtin_amdgcn_readfirstlane(um);
    unsigned long long x = um;
    x = (x | (x << 16)) & 0x0000FFFF0000FFFFull; x = (x | (x << 8)) & 0x00FF00FF00FF00FFull; x = (x | (x << 4)) & 0x0F0F0F0F0F0F0F0Full;
    x = (x | (x << 2)) & 0x3333333333333333ull; x = (x | (x << 1)) & 0x5555555555555555ull;
    const unsigned long long causal = tau >= 63 ? ~0ull : ((1ull << (tau + 1)) - 1ull);
    const unsigned long long tsel = (x | (x << 1)) & causal;
    const int wlo = tau > 16 ? tau - 16 : 0;
    const unsigned long long twin = causal & ~((1ull << wlo) - 1ull);
    {
        AttnAcc A; attn_init(A);
        attn_run(A, ql, KSEL, VSELT, tsel, slope2, t0, [&](int kt, int kvl) { return ((selm >> (kt >> 1)) & 1u) && (kt * 32 + kvl <= qpos); },
                 [&](int kt) { return kt < tau && __all((selm >> (kt >> 1)) & 1u); }, lane);
        const float g1 = GATES[(size_t)row * 40 + head * 3 + 1] * attn_inv(A);
#pragma unroll
        for (int db = 0; db < 4; ++db)
#pragma unroll
            for (int i = 0; i < 16; i += 2) stu[(db * 8 + (i >> 1)) * 64 + lane] = pk2(A.o[db][i] * g1, A.o[db][i + 1] * g1);
    }
    f32x16 out[4];
    {
        AttnAcc A; attn_init(A);
        attn_run(A, ql, KWIN, VWINT, twin, slope2, t0, [&](int kt, int kvl) { const int dist = qpos - (kt * 32 + kvl); return dist >= 0 && dist < 512; },
                 [&](int kt) { return kt < tau && kt > tau - 16; }, lane);
        const float g2 = GATES[(size_t)row * 40 + head * 3 + 2] * attn_inv(A);
        LDS_WAIT();
#pragma unroll
        for (int db = 0; db < 4; ++db)
#pragma unroll
            for (int i = 0; i < 16; i += 2) { const unsigned w = stu[(db * 8 + (i >> 1)) * 64 + lane]; out[db][i] = bflo(w) + A.o[db][i] * g2; out[db][i + 1] = bfhi(w) + A.o[db][i + 1] * g2; }
    }
    const bf16* oc = (const bf16*)(a.ws + WS_OCMP) + (size_t)row * TOK + head * HD;
    bf16* orow = (bf16*)(a.ws + WS_CAT) + (size_t)row * D + head * HD;
#pragma unroll
    for (int db = 0; db < 4; ++db)
#pragma unroll
        for (int c = 0; c < 4; ++c) {
            const int d = 32 * db + 8 * c + 4 * h;
            const u32x2 w = *(const u32x2*)(oc + d);
            u32x2 o; o.x = pk2(out[db][4 * c] + bflo(w.x), out[db][4 * c + 1] + bfhi(w.x)); o.y = pk2(out[db][4 * c + 2] + bflo(w.y), out[db][4 * c + 3] + bfhi(w.y));
            *(u32x2*)(orow + d) = o;
        }
}

constexpr int SCLD = 1040;
template <int NQ, class KP, class VP, class BF>
DI void wg_attend(LAS float* Qs, LAS float* SC, LAS float* RED, int nkeys, const KP& kptr, const VP& vptr, const BF& bias, int tid) {
    const int wave = tid >> 6, lane = tid & 63;
    {
        const int ks = tid >> 3, sub = tid & 7;
        for (int n0 = 0; n0 < nkeys; n0 += 128) {
            f32x4 k4[2][4]; int nn[2]; bool act[2];
#pragma unroll
            for (int u = 0; u < 2; ++u) { nn[u] = n0 + 64 * u + ks; act[u] = nn[u] < nkeys; const float* kp = kptr(act[u] ? nn[u] : nkeys - 1);
#pragma unroll
                for (int i = 0; i < 4; ++i) k4[u][i] = *(const f32x4*)(kp + 4 * sub + 32 * i); }
#pragma unroll
            for (int u = 0; u < 2; ++u) {
                float part[NQ];
#pragma unroll
                for (int j = 0; j < NQ; ++j) part[j] = 0.f;
#pragma unroll
                for (int i = 0; i < 4; ++i)
#pragma unroll
                    for (int j = 0; j < NQ; ++j) { const f32x4 q4 = *(const LAS f32x4*)(Qs + j * 128 + 4 * sub + 32 * i); part[j] += (k4[u][i][0] * q4[0] + k4[u][i][1] * q4[1]) + (k4[u][i][2] * q4[2] + k4[u][i][3] * q4[3]); }
#pragma unroll
                for (int j = 0; j < NQ; ++j) { float p = part[j]; p += __shfl_xor(p, 1); p += __shfl_xor(p, 2); p += __shfl_xor(p, 4);
                    if (sub == 0 && act[u]) { const float bb = bias(j, nn[u]); SC[j * SCLD + nn[u]] = bb > -1e29f ? p * SCALE2 + bb : -1e30f; } }
            }
        }
    }
    __syncthreads();
    for (int j = wave; j < NQ; j += NWAVES) {
        float m = -1e30f;
        for (int n = lane; n < nkeys; n += 64) m = fmaxf(m, SC[j * SCLD + n]);
        m = wave_max(m);
        float l = 0.f;
        for (int n = lane; n < nkeys; n += 64) { const float s = SC[j * SCLD + n]; const float p = s > -1e29f ? __builtin_amdgcn_exp2f(s - m) : 0.f; SC[j * SCLD + n] = p; l += p; }
        l = wave_sum(l);
        const float inv = l > 0.f ? 1.f / l : 0.f;
        for (int n = lane; n < nkeys; n += 64) SC[j * SCLD + n] *= inv;
    }
    __syncthreads();
    {
        const int part = tid >> 5, dq = tid & 31;
        f32x4 acc[NQ];
#pragma unroll
        for (int j = 0; j < NQ; ++j) acc[j] = (f32x4){0.f, 0.f, 0.f, 0.f};
        for (int n0 = part; n0 < nkeys; n0 += 128) {
            f32x4 v4[8];
#pragma unroll
            for (int u = 0; u < 8; ++u) { const int n = n0 + 16 * u; v4[u] = *(const f32x4*)(vptr(n < nkeys ? n : nkeys - 1) + 4 * dq); }
#pragma unroll
            for (int u = 0; u < 8; ++u) { const int n = n0 + 16 * u;
                if (n < nkeys) {
#pragma unroll
                    for (int j = 0; j < NQ; ++j) acc[j] += SC[j * SCLD + n] * v4[u]; } }
        }
#pragma unroll
        for (int j = 0; j < NQ; ++j) *(LAS f32x4*)(RED + ((part * NQ + j) * 128 + 4 * dq)) = acc[j];
    }
    __syncthreads();
    for (int o = tid; o < NQ * 128; o += NTHR) {
        float s = 0.f;
#pragma unroll
        for (int p = 1; p < 16; ++p) s += RED[p * NQ * 128 + o];
        RED[o] += s;
    }
    __syncthreads();
}
constexpr int SN_Q = 0, SN_SC = 768, SN_RED = SN_SC + 6 * SCLD, SN_IMP = SN_RED + 16 * 6 * 128, SN_PS = SN_IMP + 520, SN_IDX = SN_PS + 136;
static_assert((SN_IDX + 64) * 4 <= RING_BYTES, "sample NSA LDS map");

DI void sn_load_q(ArgsRef a, LAS float* Qs, int srow, int g, int tid) {
    const bf16* QB = (const bf16*)(a.ws + WS_QB) + (size_t)(MPR + srow) * TOK + g * HPG * HD;
    for (int o = tid; o < HPG * HD; o += NTHR) Qs[o] = bf2f(QB[o]);
}
DI void sn_cmp_item(ArgsRef a, LAS unsigned char* lds, int it, int tid) {
    const int b = it >> 3, g = (it >> 2) & 1, t = it & 3, srow = b * 4 + t, qpos = PAST + t;
    LAS float* L = (LAS float*)lds; LAS float* Qs = L + SN_Q; LAS float* SC = L + SN_SC; LAS float* RED = L + SN_RED; LAS float* IMP = L + SN_IMP; LAS float* PS = L + SN_PS;
    __syncthreads();
    sn_load_q(a, Qs, srow, g, tid);
    __syncthreads();
    const float* kc = (const float*)(a.ws + WS_KCS) + (size_t)(b * 2 + g) * 512 * 128; const float* vc = (const float*)(a.ws + WS_VCS) + (size_t)(b * 2 + g) * 512 * 128;
    wg_attend<HPG>(Qs, SC, RED, NCS, [&](int n) { return kc + (size_t)n * 128; }, [&](int n) { return vc + (size_t)n * 128; },
                   [&](int j, int n) { const int kp = 16 * n + 31; return kp <= qpos ? -alibi_slope2(g * HPG + j) * (float)(qpos - kp) : -1e30f; }, tid);
    const float* GATES = (const float*)(a.ws + WS_GATES) + (size_t)(MPR + srow) * 40;
    float* SOC = (float*)(a.ws + WS_SOC) + (size_t)srow * TOK + g * HPG * HD;
    for (int o = tid; o < HPG * HD; o += NTHR) SOC[o] = RED[o] * GATES[(g * HPG + (o >> 7)) * 3 + 0];
    for (int n = tid; n < 520; n += NTHR) { float s = 0.f; if (n < NCS) { for (int j = 0; j < HPG; ++j) s += SC[j * SCLD + n]; } IMP[n] = s; }
    __syncthreads();
    if (tid < NSS) { const int j = tid; float s = 0.f;
        for (int n = 4 * j - 1; n <= 4 * j + 3; ++n) if (n >= 0 && n < NCS) s += IMP[n];
        const bool forced = (j == 0) || (j == NSS - 1) || (j == NSS - 2);
        PS[j] = s + (forced ? 1e4f : 0.f); }
    __syncthreads();
    if (tid < NSS) { const float me = PS[tid]; int rank = 0;
        for (int k = 0; k < NSS; ++k) { const float o = PS[k]; rank += (o > me || (o == me && k < tid)) ? 1 : 0; }
        if (rank < 16) ((int*)(a.ws + WS_SIDX))[(size_t)(srow * 2 + g) * 16 + rank] = tid; }
}
DI void sn_selwin_item(ArgsRef a, LAS unsigned char* lds, int it, int tid) {
    const int b = it >> 3, g = (it >> 2) & 1, t = it & 3, srow = b * 4 + t, qpos = PAST + t;
    LAS float* L = (LAS float*)lds; LAS float* Qs = L + SN_Q; LAS float* SC = L + SN_SC; LAS float* RED = L + SN_RED; LAS int* IDX = (LAS int*)(L + SN_IDX);
    __syncthreads();
    sn_load_q(a, Qs, srow, g, tid);
    if (tid < 16) { const int blk = ((const int*)(a.ws + WS_SIDX))[(size_t)(srow * 2 + g) * 16 + tid]; IDX[tid] = blk;
        IDX[16 + tid] = blk < 128 ? ((const int*)a.in[I_PT])[b * NPAGE + (blk >> 1)] : 0; }
    __syncthreads();
    const float* ckv = a.in[I_CKV]; const float* nkv = a.out + O_KVS + (size_t)(b * 4) * 1024;
    auto selrow = [&](int n, int kind) -> const float* {
        const int sb = n >> 6, s = n & 63, blk = IDX[sb];
        if (blk < 128) return ckv + ((size_t)IDX[16 + sb] * PAGE + (blk & 1) * 64 + s) * 1024 + kind * 256 + g * 128;
        return nkv + (size_t)(s < 4 ? s : 3) * 1024 + kind * 256 + g * 128;
    };
    wg_attend<HPG>(Qs, SC, RED, 1024, [&](int n) { return selrow(n, 2); }, [&](int n) { return selrow(n, 3); },
                   [&](int j, int n) { const int kp = IDX[n >> 6] * 64 + (n & 63); return kp <= qpos ? -alibi_slope2(g * HPG + j) * (float)(qpos - kp) : -1e30f; }, tid);
    const float* GATES = (const float*)(a.ws + WS_GATES) + (size_t)(MPR + srow) * 40;
    float acc[2];
    { const float* SOC = (const float*)(a.ws + WS_SOC) + (size_t)srow * TOK + g * HPG * HD;
      for (int q = 0; q < 2; ++q) { const int o = tid + q * NTHR; acc[q] = o < HPG * HD ? SOC[o] + RED[o] * GATES[(g * HPG + (o >> 7)) * 3 + 1] : 0.f; } }
    __syncthreads();
    const float* cw = a.in[I_CWIN] + (size_t)b * 512 * 512; const float* nw = a.out + O_WS + (size_t)(b * 4) * 512;
    auto winrow = [&](int n, int kind) -> const float* { return n < 512 ? cw + (size_t)n * 512 + kind * 256 + g * 128 : nw + (size_t)(n - 512) * 512 + kind * 256 + g * 128; };
    wg_attend<HPG>(Qs, SC, RED, 516, [&](int n) { return winrow(n, 0); }, [&](int n) { return winrow(n, 1); },
                   [&](int j, int n) { const int dist = qpos - (PAST - 512 + n); return (dist >= 0 && dist < 512) ? -alibi_slope2(g * HPG + j) * (float)dist : -1e30f; }, tid);
    bf16* CAT = (bf16*)(a.ws + WS_CAT) + (size_t)(MPR + srow) * D + g * HPG * HD;
    for (int q = 0; q < 2; ++q) { const int o = tid + q * NTHR; if (o < HPG * HD) CAT[o] = f2bf(acc[q] + RED[o] * GATES[(g * HPG + (o >> 7)) * 3 + 2]); }
}

constexpr int SM_O = 0, SM_Q = RING_BYTES + 2048, SM_ML = SM_Q + 8192, SM_LIST = SM_ML + 2048, SM_MEMB = SM_LIST + 256, SM_UB = SM_MEMB + 544, SM_PG = SM_UB + 32;
static_assert(SM_PG + 256 <= LDS_BYTES && MISC_OFF + 256 <= RING_BYTES + 2048, "sample NSA (MFMA) LDS map");
DI void sn_selwin_mfma(ArgsRef a, LAS unsigned char* lds, int bg, int tid) {
    const int wave = __builtin_amdgcn_readfirstlane(tid >> 6), lane = tid & 63, r = lane & 31, h = lane >> 5;
    const int b = bg >> 1, g = bg & 1, t = r >> 3, js = r & 7, j = js < HPG ? js : HPG - 1, head = g * HPG + j, srow = b * 4 + t, qpos = PAST + t;
    LAS bf16x8* ql = (LAS bf16x8*)(lds + SM_Q); LAS int* LIST = (LAS int*)(lds + SM_LIST); LAS unsigned* MEMB = (LAS unsigned*)(lds + SM_MEMB); LAS unsigned* UB = (LAS unsigned*)(lds + SM_UB);
    LAS int* PG = (LAS int*)(lds + SM_PG); LAS float* ML = (LAS float*)(lds + SM_ML); LAS float* OB = (LAS float*)(lds + SM_O);
    __syncthreads();
    if (wave == 0) LIST[lane] = ((const int*)(a.ws + WS_SIDX))[(size_t)((b * 4 + (lane >> 4)) * 2 + g) * 16 + (lane & 15)];
    if (wave == 1) PG[lane] = ((const int*)a.in[I_PT])[b * NPAGE + lane];
    if (wave == 2) { bf16x8 qf[8]; load_qf(qf, (const bf16*)(a.ws + WS_QB) + (size_t)(MPR + srow) * TOK + head * HD, h);
#pragma unroll
        for (int ks = 0; ks < 8; ++ks) ql[ks * 64 + lane] = qf[ks]; }
    __syncthreads();
    if (tid < 136) { unsigned m = 0u; for (int e = 0; e < 64; ++e) m |= (LIST[e] == tid) ? (1u << (e >> 4)) : 0u; MEMB[tid] = m; }
    __syncthreads();
    if (tid < 8) { unsigned u = 0u; for (int e = 0; e < 32; ++e) { const int blk = 32 * tid + e; u |= (blk < 136 && MEMB[blk] != 0u) ? (1u << e) : 0u; } UB[tid] = u; }
    __syncthreads();
    const float slope2 = alibi_slope2(head);
    auto run_tile = [&](AttnAcc& A, const float* kb, const float* vb, int stride, int nvalid, int pos0, bool member, int maxdist) {
        asm volatile("" : "+s"(stride), "+s"(nvalid) :: "memory");
        {
            LAS unsigned* vl = (LAS unsigned*)(lds + wave * 16384);
            const float* vbl = vb + (unsigned)(h * stride + 4 * r);
            const int lastpair = (nvalid >> 1) - 1;
#pragma unroll
            for (int i = 0; i < 16; ++i) { const int i2 = i < lastpair ? i : lastpair;
                __builtin_amdgcn_global_load_lds((const unsigned*)(vbl + (size_t)(2 * i2 * stride)), vl + i * 256, 16, 0, 0); }
        }
        f32x16 s = zero16();
        { const int kr = r < nvalid ? r : nvalid - 1; const float* kp = kb + (unsigned)(kr * stride + 8 * h);
#pragma unroll
          for (int hk = 0; hk < 2; ++hk) {
              f32x4 kq[4][2];
#pragma unroll
              for (int ks = 0; ks < 4; ++ks) { kq[ks][0] = *(const f32x4*)(kp + 64 * hk + 16 * ks); kq[ks][1] = *(const f32x4*)(kp + 64 * hk + 16 * ks + 4); }
              bf16x8 kf[4];
#pragma unroll
              for (int ks = 0; ks < 4; ++ks) { u32x4 w; w.x = pk2(kq[ks][0][0], kq[ks][0][1]); w.y = pk2(kq[ks][0][2], kq[ks][0][3]); w.z = pk2(kq[ks][1][0], kq[ks][1][1]); w.w = pk2(kq[ks][1][2], kq[ks][1][3]);
                  kf[ks] = __builtin_bit_cast(bf16x8, w); }
              __builtin_amdgcn_sched_barrier(0);
#pragma unroll
              for (int ks = 0; ks < 4; ++ks) s = MFMA32(kf[ks], ql[(4 * hk + ks) * 64 + lane], s);
          } }
        float mt = -1e30f;
#pragma unroll
        for (int i = 0; i < 16; ++i) { const int key = crow(i, h), dist = qpos - (pos0 + key);
            float v = fmaf(s[i], SCALE2, -slope2 * (float)dist);
            v = (member && dist >= 0 && dist < maxdist && key < nvalid) ? v : -1e30f; s[i] = v; mt = fmaxf(mt, v); }
        mt = fmaxf(mt, __shfl_xor(mt, 32));
        float mn = A.m;
        if (__any(mt > A.m + 8.f)) { mn = fmaxf(A.m, mt); const float alpha = __builtin_amdgcn_exp2f(A.m - mn); A.m = mn; A.l *= alpha;
#pragma unroll
            for (int db = 0; db < 4; ++db) A.o[db] *= alpha; }
        float ls = 0.f;
#pragma unroll
        for (int i = 0; i < 16; ++i) { const float p = s[i] > -1e29f ? __builtin_amdgcn_exp2f(s[i] - mn) : 0.f; s[i] = p; ls += p; }
        A.l += ls;
        asm volatile("s_waitcnt vmcnt(0)" ::: "memory");
        { const LAS float* vr = (const LAS float*)(lds + wave * 16384) + 4 * h * 128 + r;
#pragma unroll
          for (int st = 0; st < 2; ++st) { const bf16x8 pf = packp(s, st);
#pragma unroll
            for (int db = 0; db < 4; ++db) { float x[8];
#pragma unroll
                for (int jj = 0; jj < 8; ++jj) x[jj] = vr[(16 * st + 8 * (jj >> 2) + (jj & 3)) * 128 + 32 * db];
                u32x4 w; w.x = pk2(x[0], x[1]); w.y = pk2(x[2], x[3]); w.z = pk2(x[4], x[5]); w.w = pk2(x[6], x[7]);
                A.o[db] = MFMA32(__builtin_bit_cast(bf16x8, w), pf, A.o[db]); } } }
        asm volatile("s_waitcnt lgkmcnt(0)" ::: "memory");
    };
    auto merge = [&](AttnAcc& A, float (&res)[8]) {
        __syncthreads();
        if (wave >= 4) { LAS float* o = OB + (wave - 4) * 4096 + lane; ML[(wave - 4) * 128 + lane] = A.m; ML[(wave - 4) * 128 + 64 + lane] = A.l;
#pragma unroll
            for (int db = 0; db < 4; ++db)
#pragma unroll
                for (int i = 0; i < 16; ++i) o[(db * 16 + i) * 64] = A.o[db][i]; }
        __syncthreads();
        if (wave < 4) { const LAS float* o = OB + wave * 4096 + lane; const float mb = ML[wave * 128 + lane], lb = ML[wave * 128 + 64 + lane];
            const float M = fmaxf(A.m, mb), sa = __builtin_amdgcn_exp2f(A.m - M), sb = __builtin_amdgcn_exp2f(mb - M);
            A.m = M; A.l = A.l * sa + lb * sb;
#pragma unroll
            for (int db = 0; db < 4; ++db)
#pragma unroll
                for (int i = 0; i < 16; ++i) A.o[db][i] = A.o[db][i] * sa + o[(db * 16 + i) * 64] * sb; }
        __syncthreads();
        if (wave < 4) { LAS float* o = OB + wave * 4096 + lane; ML[wave * 128 + lane] = A.m; ML[wave * 128 + 64 + lane] = A.l;
#pragma unroll
            for (int db = 0; db < 4; ++db)
#pragma unroll
                for (int i = 0; i < 16; ++i) o[(db * 16 + i) * 64] = A.o[db][i]; }
        __syncthreads();
        { float M = -1e30f, sc[4], L = 0.f;
#pragma unroll
          for (int w2 = 0; w2 < 4; ++w2) M = fmaxf(M, ML[w2 * 128 + lane]);
#pragma unroll
          for (int w2 = 0; w2 < 4; ++w2) { sc[w2] = __builtin_amdgcn_exp2f(ML[w2 * 128 + lane] - M); L += ML[w2 * 128 + 64 + lane] * sc[w2]; }
          L += __shfl_xor(L, 32);
          const float inv = L > 0.f ? 1.f / L : 0.f;
          const int base = ((wave >> 1) * 16 + 8 * (wave & 1)) * 64 + lane;
#pragma unroll
          for (int e = 0; e < 8; ++e) { float o = 0.f;
#pragma unroll
              for (int w2 = 0; w2 < 4; ++w2) o += OB[w2 * 4096 + base + e * 64] * sc[w2];
              res[e] = o * inv; } }
        __syncthreads();
    };
    {
        AttnAcc A; attn_init(A);
        const float* ckv = a.in[I_CKV]; const float* nkv = a.out + O_KVS + (size_t)(b * 4) * 1024 + 512 + g * 128;
        int cnt = 0;
        for (int w5 = 0; w5 < 5; ++w5) {
            unsigned bits = __builtin_amdgcn_readfirstlane(UB[w5]);
            while (bits) {
                const int blk = 32 * w5 + __builtin_ctz(bits); bits &= bits - 1u;
                const bool member = (MEMB[blk] >> t) & 1u;
                const int page = __builtin_amdgcn_readfirstlane(PG[blk < 128 ? blk >> 1 : 0]);
                const int nt = blk < 128 ? 2 : 1;
#pragma unroll 1
                for (int hf = 0; hf < nt; ++hf, ++cnt) if ((cnt & 7) == wave) {
                    const float* kb = blk < 128 ? ckv + ((size_t)page * PAGE + (blk & 1) * 64 + hf * 32) * 1024 + 512 + g * 128 : nkv;
                    run_tile(A, kb, kb + 256, 1024, blk < 128 ? 32 : 4, blk * 64 + hf * 32, member, 1 << 30);
                }
            }
        }
        float rsel[8];
        merge(A, rsel);
        if (js < HPG) {
            const float g1 = ((const float*)(a.ws + WS_GATES))[(size_t)(MPR + srow) * 40 + head * 3 + 1];
            float* soc = (float*)(a.ws + WS_SOC) + (size_t)srow * TOK + head * HD + 32 * (wave >> 1) + 16 * (wave & 1) + 4 * h;
#pragma unroll
            for (int q = 0; q < 2; ++q) { f32x4 c = *(const f32x4*)(soc + 8 * q);
#pragma unroll
                for (int e = 0; e < 4; ++e) c[e] += rsel[4 * q + e] * g1;
                *(f32x4*)(soc + 8 * q) = c; }
        }
    }
    {
        float rwin[8];
        AttnAcc A; attn_init(A);
        const float* cw = a.in[I_CWIN] + (size_t)b * 512 * 512 + g * 128; const float* nw = a.out + O_WS + (size_t)(b * 4) * 512 + g * 128;
#pragma unroll 1
        for (int wt = 7 - wave; wt < 17; wt += 8) {
            const float* kb = wt < 16 ? cw + (size_t)(32 * wt) * 512 : nw;
            run_tile(A, kb, kb + 256, 512, wt < 16 ? 32 : 4, PAST - 512 + 32 * wt, true, 512);
        }
        merge(A, rwin);
        if (js < HPG) {
            const float* GATES = (const float*)(a.ws + WS_GATES) + (size_t)(MPR + srow) * 40 + head * 3;
            const float g2 = GATES[2];
            const int d0 = 32 * (wave >> 1) + 16 * (wave & 1) + 4 * h;
            const float* soc = (const float*)(a.ws + WS_SOC) + (size_t)srow * TOK + head * HD + d0;
            bf16* cat = (bf16*)(a.ws + WS_CAT) + (size_t)(MPR + srow) * D + head * HD + d0;
#pragma unroll
            for (int q = 0; q < 2; ++q) { const f32x4 c = *(const f32x4*)(soc + 8 * q);
                u32x2 w; w.x = pk2(c[0] + rwin[4 * q] * g2, c[1] + rwin[4 * q + 1] * g2);
                w.y = pk2(c[2] + rwin[4 * q + 2] * g2, c[3] + rwin[4 * q + 3] * g2);
                *(u32x2*)(cat + 8 * q) = w; }
        }
    }
    __syncthreads();
}

constexpr int CW_Q13 = 4000;
constexpr int CW_BAR = 4096;
static_assert((CW_BAR + XCD_BAR_WORDS) * 4 <= (int)CTL_BYTES, "control block");

#define GEMM_CALL(FN, fnobj, Aoff, Boff, Mrows, Ncols, Kdim, cperm) do { \
    pg8::Gemm g_{(const pg8::bf16_t*)(a.ws + (Aoff)), (const pg8::bf16_t*)(a.ws + (Boff)), (Mrows), (Ncols), (Kdim)}; \
    pg8::StaticOrder S_; S_.init((Mrows), (Ncols), G, (cperm)); \
    EpiFn<FN> E_{fnobj}; \
    pg8::gemm_phase<EpiFn<FN>, pg8::StaticOrder, true, true>(lds, g_, S_, E_); } while (0)

__global__ void __launch_bounds__(NTHR, 2) yoco_fwd(Args a_) {
    extern __shared__ __attribute__((aligned(16))) unsigned char lds_raw[];
    LAS unsigned char* lds = (LAS unsigned char*)lds_raw;
    const int tid0 = threadIdx.x, wave0 = __builtin_amdgcn_readfirstlane(tid0 >> 6);
    const int G = gridDim.x, bx = blockIdx.x, ngw = G * NWAVES;
    volatile LAS unsigned* MISC = (volatile LAS unsigned*)(lds + MISC_OFF);
    for (int u = tid0; u < (LDS_BYTES - RING_BYTES) / 4; u += NTHR) ((LAS unsigned*)(lds + RING_BYTES))[u] = 0u;
    __syncthreads();
    XcdBarrier bar = xcd_barrier_post((unsigned*)(a_.ws + WS_CTL) + CW_BAR, MISC + 8);
#define PH ArgsRef a = *phase_args(); float* out = a.out; (void)out; int tid = tid0, wave = wave0; asm volatile("" : "+v"(tid)); asm volatile("" : "+s"(wave)); const int lane = tid & 63, gw = bx * NWAVES + wave; (void)lane; (void)gw;

    { PH wg_transpose_run(a, lds, bx, TL_A0 + (TL_END - TL_LATE1), G, [](int t) { return t < TL_A0 ? t : t - TL_A0 + TL_LATE1; }, tid); }
    { PH p0_prologue(a, lds, gw, ngw, wave, lane); }
    xcd_barrier(bar);
    { PH for (int it = bx; it < 256; it += G) cmpgemm_direct(a, lds, it, tid); }

    { PH
        FnA fa{(bf16*)(a.ws + WS_QA), (float*)(a.ws + WS_FA), (bf16*)(a.ws + WS_VA), (bf16*)(a.ws + WS_OGA), (bf16*)(a.ws + WS_MEMQ), (const float*)(a.ws + WS_LB)};
        EpiA ea{(bf16*)(a.ws + WS_QP), (bf16*)(a.ws + WS_KP), (bf16*)(a.ws + WS_KT), (bf16*)(a.ws + WS_VF), (float*)(a.ws + WS_DV), (bf16*)(a.ws + WS_OGA), (bf16*)(a.ws + WS_MEMQ), (const float*)(a.ws + WS_LB), fa};
        { pg8::Gemm g_{(const pg8::bf16_t*)(a.ws + WS_XN), (const pg8::bf16_t*)(a.ws + WS_BTA), MPAD, NA, 2048};
          pg8::StaticOrder S_; S_.init(MPAD, NA, G, bx);
          pg8::gemm_phase<EpiA, pg8::StaticOrder, true, true>(lds, g_, S_, ea); }
    }
    { PH
        FnM fm{out, (bf16*)(a.ws + WS_MK), (bf16*)(a.ws + WS_MVT)};
        GEMM_CALL(FnM, fm, WS_MEMPB, WS_BTM, 2048, 2048, 2048, (bx + 64) % G);
    }
    xcd_barrier(bar);

    { PH
        const bool split = G > 96;
        if (!split || bx < 96) { for (int k = bx; k < BP * NH; k += (split ? 96 : G)) hgrn_mfma_item(a, lds, k, tid); }
        if (!split || bx >= 96) {
            const int w2 = split ? bx - 96 : bx, nw = split ? G - 96 : G;
            for (int k = w2; k < BS * NH; k += nw) hgrn_sample_item(a, lds, k / NH, k % NH, tid);
            for (int it = w2; it < 256 + BS * MEMH; it += nw) memattn_wg(a, 0, it, lds, tid);
        }
    }
    __syncthreads();
    { PH
        constexpr int NREC = TL_LATE0 + 96;
        auto idm = [](int t) { return t; };
        if (G > 96) { if (bx < 96) wg_transpose_run(a, lds, TL_LATE0 + bx, NREC, 96, idm, tid);
                      else wg_transpose_run(a, lds, NREC + (bx - 96), TL_LATE1, G - 96, idm, tid); }
        else wg_transpose_run(a, lds, TL_LATE0 + bx, TL_LATE1, G, idm, tid);
    }
    xcd_barrier(bar);

    { PH FnO fo{(bf16*)(a.ws + WS_OB), D}; GEMM_CALL(FnO, fo, WS_CAT, WS_BTO0, MPR, D, 2048, bx);
      skinny_gemm<8>(fo, (const bf16*)(a.ws + WS_CAT) + (size_t)MPR * 2048, (const bf16*)(a.ws + WS_BTO0), D, 2048, lds, bx, G, tid); }
    xcd_barrier(bar);
    { PH normpass<true, false>(a, a.in[I_NG] + 1 * D, gw, ngw, lane); }
    xcd_barrier(bar);
    { PH EpiF1 ef{(bf16*)(a.ws + WS_HID), (float*)(a.ws + WS_FIX), (float*)(a.ws + WS_HALO), out, a.in[I_WCONV] + (size_t)0 * 3 * FF, a.in[I_BCONV] + (size_t)0 * FF, 0};
      { pg8::Gemm g_{(const pg8::bf16_t*)(a.ws + WS_XN), (const pg8::bf16_t*)(a.ws + WS_BTF10), MPR, FF2, 2048}; pg8::StaticOrder S_; S_.init(MPR, FF2, G, bx);
        pg8::gemm_phase<EpiF1, pg8::StaticOrder, true, true>(lds, g_, S_, ef); }
      FnF1 ff{(bf16*)(a.ws + WS_AB), out, 0};
      skinny_gemm<8>(ff, (const bf16*)(a.ws + WS_XN) + (size_t)MPR * 2048, (const bf16*)(a.ws + WS_BTF10), FF2, 2048, lds, bx, G, tid); }
    xcd_barrier(bar);
    { PH ffn_fixup(a, 0, bx * NTHR + tid, G * NTHR); gating_pass(a, 0, bx * NTHR + tid, G * NTHR); }
    xcd_barrier(bar);
    { PH FnO fo{(bf16*)(a.ws + WS_OB), D}; GEMM_CALL(FnO, fo, WS_HID, WS_BTF20, MPR, D, FF, bx);
      skinny_gemm<8>(fo, (const bf16*)(a.ws + WS_HID) + (size_t)MPR * FF, (const bf16*)(a.ws + WS_BTF20), D, FF, lds, bx, G, tid); }
    xcd_barrier(bar);
    { PH normpass<false, false>(a, a.in[I_NG] + 3 * D, gw, ngw, lane); }
    xcd_barrier(bar);

    { PH
        FnB fb{(bf16*)(a.ws + WS_QB), (bf16*)(a.ws + WS_MEMQ), (float*)(a.ws + WS_GATES), out, (bf16*)(a.ws + WS_KCMP), (bf16*)(a.ws + WS_VCMP),
               (bf16*)(a.ws + WS_KSEL), (bf16*)(a.ws + WS_VSELT), (bf16*)(a.ws + WS_KWIN), (bf16*)(a.ws + WS_VWINT)};
        GEMM_CALL(FnB, fb, WS_XN, WS_BTB, MPAD, NBM, 2048, bx);
    }
    xcd_barrier(bar);

    { PH FnC fk{(float*)(a.ws + WS_PPP), 256};
      skinny_gemm<8>(fk, (const bf16*)(a.ws + WS_KCMP), (const bf16*)(a.ws + WS_BTC), 256, 2048, lds, bx, G, tid, 64, 0); }
    { PH FnC fv{(float*)(a.ws + WS_PPP) + (size_t)2048 * 256, 256};
      skinny_gemm<8>(fv, (const bf16*)(a.ws + WS_VCMP), (const bf16*)(a.ws + WS_BTC) + (size_t)256 * 2048, 256, 2048, lds, (bx + G / 2) % G, G, tid, 64, 0); }
    { PH for (int it = bx; it < 256 + BS * MEMH; it += G) memattn_wg(a, 1, it, lds, tid); }
    { PH for (int it = 128 + gw; it < 128 + 2048; it += ngw) cmp2_item(a, it, lane); }
    xcd_barrier(bar);
    { PH for (int it = gw; it < 128; it += ngw) cmp2_item(a, it, lane); }
    xcd_barrier(bar);
    { PH for (int w = bx; w < 128; w += G) nsa_cmp_wg(a, lds, w, tid); }
    { PH for (int w = (bx + G - 128 % G) % G; w < 128; w += G) { sn_cmp_item(a, lds, 2 * w, tid); sn_cmp_item(a, lds, 2 * w + 1, tid); } }
    xcd_barrier(bar);
    { PH for (int it = bx; it < BS * 2; it += G) sn_selwin_mfma(a, lds, it, tid); }
    __syncthreads();
    { PH
        LAS unsigned* TK = (LAS unsigned*)(lds + RING_BYTES + 1024);
        unsigned* qctr = (unsigned*)(a.ws + WS_CTL) + CW_Q13;
        int grp = bx, par = 0;
        while (grp < 6144 / NWAVES) {
            unsigned nx = 0u;
            if (tid == 0) nx = atomicAdd(qctr, 1u);
            nsa_selwin_item(a, grp * NWAVES + wave, (LAS float*)(lds + wave * 16384), lane);
            if (tid == 0) TK[par] = nx;
            __syncthreads();
            grp = G + (int)TK[par]; par ^= 1;
        }
    }
    xcd_barrier(bar);

    { PH FnO fo{(bf16*)(a.ws + WS_OB), D}; GEMM_CALL(FnO, fo, WS_CAT, WS_BTO1, MPR, D, 2048, bx);
      skinny_gemm<8>(fo, (const bf16*)(a.ws + WS_CAT) + (size_t)MPR * 2048, (const bf16*)(a.ws + WS_BTO1), D, 2048, lds, bx, G, tid); }
    xcd_barrier(bar);
    { PH normpass<false, false>(a, a.in[I_NG] + 5 * D, gw, ngw, lane); }
    xcd_barrier(bar);
    { PH EpiF1 ef{(bf16*)(a.ws + WS_HID), (float*)(a.ws + WS_FIX), (float*)(a.ws + WS_HALO), out, a.in[I_WCONV] + (size_t)1 * 3 * FF, a.in[I_BCONV] + (size_t)1 * FF, 1};
      { pg8::Gemm g_{(const pg8::bf16_t*)(a.ws + WS_XN), (const pg8::bf16_t*)(a.ws + WS_BTF11), MPR, FF2, 2048}; pg8::StaticOrder S_; S_.init(MPR, FF2, G, bx);
        pg8::gemm_phase<EpiF1, pg8::StaticOrder, true, true>(lds, g_, S_, ef); }
      FnF1 ff{(bf16*)(a.ws + WS_AB), out, 1};
      skinny_gemm<8>(ff, (const bf16*)(a.ws + WS_XN) + (size_t)MPR * 2048, (const bf16*)(a.ws + WS_BTF11), FF2, 2048, lds, bx, G, tid); }
    xcd_barrier(bar);
    { PH ffn_fixup(a, 1, bx * NTHR + tid, G * NTHR); gating_pass(a, 1, bx * NTHR + tid, G * NTHR); }
    xcd_barrier(bar);
    { PH FnO fo{(bf16*)(a.ws + WS_OB), D}; GEMM_CALL(FnO, fo, WS_HID, WS_BTF21, MPR, D, FF, bx);
      skinny_gemm<8>(fo, (const bf16*)(a.ws + WS_HID) + (size_t)MPR * FF, (const bf16*)(a.ws + WS_BTF21), D, FF, lds, bx, G, tid); }
    xcd_barrier(bar);
    { PH normpass<false, true>(a, a.in[I_NG] + 7 * D, gw, ngw, lane); }
}

extern "C" void kernel_launch(void* const* d_in, const int* in_sizes, int n_in, void* d_out, int out_size, void* d_ws, size_t ws_size, hipStream_t stream) {
    static int grid = 0;
    if (grid == 0) {
        if (n_in != 25 || out_size != (int)O_END || ws_size < WS_END) { fprintf(stderr, "kernel_launch: unexpected shapes (n_in %d out %d ws %zu, need ws %zu)\n", n_in, out_size, ws_size, (size_t)WS_END); grid = -1; return; }
        int dev = 0, cus = 0, per_cu = 0;
        if (hipGetDevice(&dev) != hipSuccess || hipDeviceGetAttribute(&cus, hipDeviceAttributeMultiprocessorCount, dev) != hipSuccess) { grid = -1; return; }
        if (hipFuncSetAttribute((const void*)yoco_fwd, hipFuncAttributeMaxDynamicSharedMemorySize, LDS_BYTES) != hipSuccess) { fprintf(stderr, "kernel_launch: hipFuncSetAttribute failed\n"); grid = -1; return; }
        if (hipOccupancyMaxActiveBlocksPerMultiprocessor(&per_cu, (const void*)yoco_fwd, NTHR, LDS_BYTES) != hipSuccess || per_cu < 1)
            fprintf(stderr, "kernel_launch: note: occupancy query reports %d workgroups per CU\n", per_cu);
        (void)hipGetLastError();
        grid = cus;
    }
    if (grid < 0) return;
    if (hipMemsetAsync((char*)d_ws + WS_CTL + (size_t)CW_Q13 * 4, 0, (size_t)(CW_BAR - CW_Q13 + XCD_BAR_WORDS) * 4, stream) != hipSuccess) { fprintf(stderr, "kernel_launch: memset failed\n"); return; }
    Args a{};
    for (int i = 0; i < 25; ++i) a.in[i] = (const float*)d_in[i];
    a.out = (float*)d_out; a.ws = (unsigned char*)d_ws;
    hipLaunchKernelGGL(yoco_fwd, dim3(grid), dim3(NTHR), LDS_BYTES, stream, a);
    const hipError_t le = hipPeekAtLastError();
    if (le != hipSuccess) fprintf(stderr, "kernel_launch: launch failed: %s\n", hipGetErrorName(le));
}
```

```cpp
#include <hip/hip_runtime.h>
#include <cstdio>
#include <cstdint>

#define DI __device__ __forceinline__
#define GAS __attribute__((address_space(1)))
#define LAS __attribute__((address_space(3)))
typedef unsigned short bf16;
typedef short bf16x8 __attribute__((ext_vector_type(8)));
typedef short s16x4 __attribute__((ext_vector_type(4)));
typedef float f32x2 __attribute__((ext_vector_type(2)));
typedef float f32x4 __attribute__((ext_vector_type(4)));
typedef float f32x16 __attribute__((ext_vector_type(16)));
typedef unsigned u32x2 __attribute__((ext_vector_type(2)));
typedef unsigned u32x4 __attribute__((ext_vector_type(4)));
typedef __bf16 hbf2 __attribute__((ext_vector_type(2)));

constexpr int D = 2048, BP = 8, TP = 2048, BS = 32, TS = 4, PAST = 8192, PAGE = 128, NPAGE = PAST / PAGE;
constexpr int MPR = BP * TP;
constexpr int MSR = BS * TS;
constexpr int MR = MPR + MSR;
constexpr int MPAD = 16640;
constexpr int TOK = 1536, MEMW = 512, HD = 128, NH = 12, GB = 2, HPG = 6, MEMH = 4, MEML = 256;
constexpr int NA = 4 * TOK + MEMW;
constexpr int NBM = 3840;
constexpr int FF = 5632, FF2 = 2 * FF;
constexpr int NCP = 127, NCS = 511, NSP = 32, NSS = 129;
constexpr float EPS = 1e-6f;
constexpr float LOG2E = 1.4426950408889634f;
constexpr float SCALE2 = 0.08838834764831845f * LOG2E;

constexpr size_t O_YP = 0;
constexpr size_t O_YS = O_YP + (size_t)MPR * D;
constexpr size_t O_HP = O_YS + (size_t)MSR * D;
constexpr size_t O_HS = O_HP + (size_t)BP * NH * HD * HD;
constexpr size_t O_CP = O_HS + (size_t)BS * NH * HD * HD;
constexpr size_t O_CS = O_CP + (size_t)2 * BP * 2 * FF;
constexpr size_t O_MP = O_CS + (size_t)2 * BS * 2 * FF;
constexpr size_t O_KVP = O_MP + (size_t)2 * BP * MEML * 1024;
constexpr size_t O_KVS = O_KVP + (size_t)MPR * 1024;
constexpr size_t O_WP = O_KVS + (size_t)MSR * 1024;
constexpr size_t O_WS = O_WP + (size_t)BP * 512 * 512;
constexpr size_t O_END = O_WS + (size_t)MSR * 512;
static_assert(O_END == 65847296, "d_out size");

constexpr size_t alup(size_t x) { return (x + 4095) & ~(size_t)4095; }
constexpr size_t WS_CTL = 0, CTL_BYTES = 1u << 20;
constexpr size_t WS_BTA = CTL_BYTES;
constexpr size_t WS_BTO0 = WS_BTA + alup((size_t)NA * D * 2);
constexpr size_t WS_BTO1 = WS_BTO0 + alup((size_t)D * D * 2);
constexpr size_t WS_BTF10 = WS_BTO1 + alup((size_t)D * D * 2);
constexpr size_t WS_BTF11 = WS_BTF10 + alup((size_t)FF2 * D * 2);
constexpr size_t WS_BTF20 = WS_BTF11 + alup((size_t)FF2 * D * 2);
constexpr size_t WS_BTF21 = WS_BTF20 + alup((size_t)D * FF * 2);
constexpr size_t WS_BTB = WS_BTF21 + alup((size_t)D * FF * 2);
constexpr size_t WS_BTM = WS_BTB + alup((size_t)NBM * D * 2);
constexpr size_t WS_BTC = WS_BTM + alup((size_t)D * D * 2);
constexpr size_t WS_LB = WS_BTC + alup((size_t)2 * 256 * 2048 * 2);
constexpr size_t WS_PRE0 = WS_LB + alup(1536 * 4);
constexpr size_t WS_XN = WS_PRE0 + alup(256 * 4);
constexpr size_t WS_MEMPB = WS_XN + alup((size_t)MPAD * D * 2);
constexpr size_t WS_QA = WS_MEMPB + alup((size_t)2048 * D * 2);
constexpr size_t WS_FA = WS_QA + alup((size_t)MPAD * TOK * 2);
constexpr size_t WS_VA = WS_FA + alup((size_t)MPAD * TOK * 4);
constexpr size_t WS_OGA = WS_VA + alup((size_t)MPAD * TOK * 2);
constexpr size_t WS_MEMQ = WS_OGA + alup((size_t)MPAD * TOK * 2);
constexpr size_t WS_ORAW = WS_MEMQ + alup((size_t)MPAD * MEMW * 2);
constexpr size_t WS_CAT = WS_ORAW + alup((size_t)MPAD * TOK * 4);
constexpr size_t WS_OB = WS_CAT + alup((size_t)MPAD * D * 2);
constexpr size_t WS_H = WS_OB + alup((size_t)MPAD * D * 2);
constexpr size_t WS_AB = WS_H + alup((size_t)MPAD * D * 4);
constexpr size_t WS_HID = WS_AB + alup((size_t)MPAD * FF2 * 2);
constexpr size_t WS_QB = WS_HID + alup((size_t)MPAD * FF * 2);
constexpr size_t WS_GATES = WS_QB + alup((size_t)MPAD * TOK * 2);
constexpr size_t KVB = (size_t)BP * GB * TP * HD * 2;
constexpr size_t WS_KCMP = WS_GATES + alup((size_t)MPAD * 40 * 4);
constexpr size_t WS_VCMP = WS_KCMP + alup(KVB);
constexpr size_t WS_KSEL = WS_VCMP + alup(KVB);
constexpr size_t WS_VSELT = WS_KSEL + alup(KVB);
constexpr size_t WS_KWIN = WS_VSELT + alup(KVB);
constexpr size_t WS_VWINT = WS_KWIN + alup(KVB);
constexpr size_t WS_CAK = WS_VWINT + alup(KVB);
constexpr size_t WS_CAV = WS_CAK + alup((size_t)32768 * 2048 * 2);
constexpr size_t WS_PPP = WS_CAV + alup((size_t)32768 * 2048 * 2);
constexpr size_t WS_PPS = WS_PPP + alup((size_t)2 * 2048 * 256 * 4);
constexpr size_t WS_KC = WS_PPS + alup((size_t)2 * 32768 * 256 * 4);
constexpr size_t WS_VCT = WS_KC + alup((size_t)16 * 128 * 128 * 2);
constexpr size_t WS_KCS = WS_VCT + alup((size_t)16 * 128 * 128 * 2);
constexpr size_t WS_VCS = WS_KCS + alup((size_t)64 * 512 * 128 * 4);
constexpr size_t WS_MK = WS_VCS + alup((size_t)64 * 512 * 128 * 4);
constexpr size_t WS_MVT = WS_MK + alup((size_t)2 * 40 * 4 * 256 * 128 * 2);
constexpr size_t WS_OCMP = WS_MVT + alup((size_t)2 * 40 * 4 * 256 * 128 * 2);
constexpr size_t WS_SELM = WS_OCMP + alup((size_t)MPAD * TOK * 2);
constexpr size_t WS_SOC = WS_SELM + alup((size_t)MPR * 2 * 4);
constexpr size_t WS_SIDX = WS_SOC + alup((size_t)MSR * TOK * 4);
constexpr size_t WS_DV = WS_SIDX + alup((size_t)MSR * 2 * 16 * 4);
constexpr size_t WS_FIX = WS_DV + alup((size_t)96 * 64 * 256 * 4);
constexpr size_t WS_HALO = WS_FIX + alup((size_t)256 * 2 * 2 * FF * 4);
constexpr size_t WS_W2T = WS_HALO + alup((size_t)256 * 2 * FF * 4);
constexpr size_t WS_END = WS_W2T + alup((size_t)2 * 128 * 128 * 2);
constexpr size_t WS_QP = WS_QA, WS_KP = WS_FA, WS_KT = WS_FA + (size_t)MPR * TOK * 2, WS_VF = WS_VA;

constexpr int NWAVES = 8, NTHR = 512;
constexpr int LDS_BYTES = 147456;
constexpr int RING_BYTES = 131072;
constexpr int MISC_OFF = RING_BYTES + 320;

DI unsigned pk2(float lo, float hi) { hbf2 v = __builtin_convertvector((f32x2){lo, hi}, hbf2); return __builtin_bit_cast(unsigned, v); }
DI bf16 f2bf(float f) { return (bf16)(pk2(f, 0.f) & 0xffffu); }
DI float bf2f(bf16 v) { return __uint_as_float((unsigned)v << 16); }
DI float bflo(unsigned w) { return __uint_as_float(w << 16); }
DI float bfhi(unsigned w) { return __uint_as_float(w & 0xffff0000u); }
DI float sigm(float x) { return __builtin_amdgcn_rcpf(1.f + __builtin_amdgcn_exp2f(-LOG2E * x)); }
DI float gelu_t(float x) { const float z = 1.5957691216f * (x + 0.044715f * x * x * x); return x * sigm(z); }
DI float wave_sum(float v) {
#pragma unroll
    for (int o = 1; o < 64; o <<= 1) v += __shfl_xor(v, o);
    return v;
}
DI float wave_max(float v) {
#pragma unroll
    for (int o = 1; o < 64; o <<= 1) v = fmaxf(v, __shfl_xor(v, o));
    return v;
}
#define LDS_WAIT() asm volatile("s_waitcnt lgkmcnt(0)" ::: "memory")
#define VM_WAIT() asm volatile("s_waitcnt vmcnt(0)" ::: "memory")
DI int kf_off(int r, int d) { return (((d >> 4) * 64 + r + 32 * ((d >> 3) & 1)) << 3) + (d & 7); }
DI int vf_off(int kvl, int d) { return ((((kvl >> 4) * 4 + (d >> 5)) * 64 + (d & 31) + 32 * ((kvl >> 2) & 1)) << 3) + ((((kvl >> 3) & 1) << 2) | (kvl & 3)); }
namespace pg8 {
#define PG8_LAS __attribute__((address_space(3)))
typedef unsigned short bf16_t;
typedef short bf16x8 __attribute__((ext_vector_type(8)));
typedef float f32x4 __attribute__((ext_vector_type(4)));
typedef unsigned u32x4 __attribute__((ext_vector_type(4)));
constexpr int BM = 256, BK = 64, HALF = 128, HTB = HALF * BK * 2  , STAGE_BYTES = 8 * HTB, NXCD = 8, WGM = 8;

__host__ __device__ __forceinline__ int lds_byte(int r, int c) { const int st = (r >> 4) * 2 + (c >> 5), rr = r & 15, cc = c & 31, ob = rr * 64 + cc * 2; return st * 1024 + (ob ^ (((ob >> 9) & 1) << 5)); }
__host__ __device__ __forceinline__ void stage_rc(int b, int& R, int& C) { const int st = b / 1024, sb = b % 1024, swz = sb ^ (((sb >> 9) & 1) << 5); R = (st >> 1) * 16 + swz / 64; C = (st & 1) * 32 + (swz % 64) / 2; }
__host__ __device__ __forceinline__ int perm32(int rho) { const int n = rho >> 4, i = rho & 15; return 8 * (i >> 2) + 4 * n + (i & 3); }

struct Unit { int pm, pn; };
struct Gemm { const bf16_t* A; const bf16_t* Bt; int M, N, K; };

struct StaticOrder {
    int nM, nN, nwg, G, c;
    __host__ __device__ void init(int M, int N, int G_, int c_) { nM = M / BM; nN = N / BM; nwg = nM * nN; G = G_; c = c_; }
    __host__ __device__ __forceinline__ bool next(int i, Unit& u) const {
        const long L = (long)i * G + c; if (L >= nwg) return false;
        int wgid = (int)L; { const int q = nwg / NXCD, r = nwg % NXCD, xcd = wgid % NXCD, off = wgid / NXCD; wgid = (xcd < r ? xcd * (q + 1) : r * (q + 1) + (xcd - r) * q) + off; }
        const int nig = WGM * nN, gid = wgid / nig, fm = gid * WGM, gsz = (nM - fm) < WGM ? (nM - fm) : WGM;
        u.pm = fm + ((wgid % nig) % gsz); u.pn = (wgid % nig) / gsz; return true;
    }
    __device__ __forceinline__ void a_ready(const Unit&) const {}
    __device__ __forceinline__ void done(const Unit&) const {}
};

template <class Epi, class Sched, bool ALIGN_EPI = false, bool SP2 = false>
__device__ __forceinline__ void gemm_phase(PG8_LAS unsigned char* lds, const Gemm g, const Sched& S, const Epi& E) {
    const int tid = threadIdx.x, wid = __builtin_amdgcn_readfirstlane(tid >> 6), lane = tid & 63, wr = wid >> 2, wc = wid & 3, fr = lane & 15, fq = lane >> 4;
    const int K = g.K, nt = K / BK;
    unsigned voffA[2], voffB[2];
#pragma unroll
    for (int i = 0; i < 2; ++i) { int R, C; stage_rc(tid * 16 + i * 8192, R, C); const int Rb = Epi::PERM ? ((R & ~31) + perm32(R & 31)) : R;
        voffA[i] = (unsigned)(R * K + C) * 2u; voffB[i] = (unsigned)(Rb * K + C) * 2u; }
    const size_t kstep = (size_t)(BK * 2);
    const size_t hstep = (size_t)HALF * K * 2;
    const size_t tstep = 2 * hstep;
    const unsigned ldsw = (unsigned)wid * 1024u;
    const int aoff = lds_byte(wr * 64 + fr, fq * 8), boff = lds_byte(wc * 32 + fr, fq * 8);
#define PG8_SA(b, h) (((b) * 2 + (h)) * HTB)
#define PG8_SB(b, h) ((4 + (b) * 2 + (h)) * HTB)
#define PG8_STAGE(bufoff, gbase, voff) do { _Pragma("unroll") for (int _i = 0; _i < 2; ++_i) \
        __builtin_amdgcn_global_load_lds((const unsigned*)((const char*)(gbase) + (voff)[_i]), (PG8_LAS unsigned*)(lds + (bufoff) + ldsw + _i * 8192), 16, 0, 0); } while (0)
#define PG8_LDA(dst, b, h) do { _Pragma("unroll") for (int m = 0; m < 4; ++m) _Pragma("unroll") for (int k = 0; k < 2; ++k) dst[m][k] = *(const PG8_LAS bf16x8*)(lds + PG8_SA(b, h) + aoff + m * 2048 + k * 1024); } while (0)
#define PG8_LDB(dst, b, h) do { _Pragma("unroll") for (int n = 0; n < 2; ++n) _Pragma("unroll") for (int k = 0; k < 2; ++k) dst[n][k] = *(const PG8_LAS bf16x8*)(lds + PG8_SB(b, h) + boff + n * 2048 + k * 1024); } while (0)
#define PG8_MMA(ai, bj, At, Bt) do { __builtin_amdgcn_s_setprio(1); _Pragma("unroll") for (int m = 0; m < 4; ++m) _Pragma("unroll") for (int n = 0; n < 2; ++n) _Pragma("unroll") for (int k = 0; k < 2; ++k) \
        acc[ai][bj][m][n] = __builtin_amdgcn_mfma_f32_16x16x32_bf16(Bt[n][k], At[m][k], acc[ai][bj][m][n], 0, 0, 0); __builtin_amdgcn_s_setprio(0); } while (0)
#define PG8_WAIT_V(n) asm volatile("s_waitcnt vmcnt(" #n ")" ::: "memory")
#define PG8_WAIT_L(n) asm volatile("s_waitcnt lgkmcnt(" #n ")" ::: "memory")
#define PG8_BAR __builtin_amdgcn_s_barrier()
#define PG8_SCHED __builtin_amdgcn_sched_barrier(0)
    Unit cur, nxt; int ui = 0;
    if (!S.next(0, cur)) return;
    f32x4 acc[2][2][4][2];
#pragma unroll
    for (int a = 0; a < 2; ++a)
#pragma unroll
        for (int b = 0; b < 2; ++b)
#pragma unroll
            for (int m = 0; m < 4; ++m)
#pragma unroll
                for (int n = 0; n < 2; ++n) acc[a][b][m][n] = (f32x4){0.f, 0.f, 0.f, 0.f};
    bf16x8 At[4][2], B0[2][2], B1[2][2];
    const char* cA = (const char*)g.A + (size_t)cur.pm * tstep; const char* cB = (const char*)g.Bt + (size_t)cur.pn * tstep;
    S.a_ready(cur);
    if constexpr (SP2) {
        PG8_STAGE(PG8_SB(0, 0), cB, voffB); PG8_STAGE(PG8_SB(0, 1), cB + hstep, voffB); PG8_STAGE(PG8_SA(0, 0), cA, voffA); PG8_STAGE(PG8_SA(0, 1), cA + hstep, voffA);
        if (wr == 1) PG8_BAR;
        PG8_WAIT_V(2); PG8_BAR;
        PG8_STAGE(PG8_SB(1, 0), cB + kstep, voffB); PG8_STAGE(PG8_SA(1, 0), cA + kstep, voffA); PG8_STAGE(PG8_SB(1, 1), cB + hstep + kstep, voffB);
        PG8_WAIT_V(6); PG8_BAR;
    } else {
        PG8_STAGE(PG8_SB(0, 0), cB, voffB); PG8_STAGE(PG8_SA(0, 0), cA, voffA); PG8_STAGE(PG8_SB(0, 1), cB + hstep, voffB); PG8_STAGE(PG8_SA(0, 1), cA + hstep, voffA);
        if (wr == 1) PG8_BAR;
        PG8_WAIT_V(4); PG8_BAR;
        PG8_STAGE(PG8_SB(1, 0), cB + kstep, voffB); PG8_STAGE(PG8_SA(1, 0), cA + kstep, voffA); PG8_STAGE(PG8_SB(1, 1), cB + hstep + kstep, voffB);
        PG8_WAIT_V(6); PG8_BAR;
    }
    for (;;) {
        const bool has_next = S.next(ui + 1, nxt);
        const char* nA = has_next ? (const char*)g.A + (size_t)nxt.pm * tstep : cA; const char* nB = has_next ? (const char*)g.Bt + (size_t)nxt.pn * tstep : cB;
        for (int t = 0; t < nt; t += 2) {
            const bool last = (t == nt - 2);
            const char* a1 = cA + (size_t)(t + 1) * kstep;
            const char* a2 = last ? nA : cA + (size_t)(t + 2) * kstep; const char* b2 = last ? nB : cB + (size_t)(t + 2) * kstep;
            const char* a3 = a2 + kstep; const char* b3 = b2 + kstep;
            if (last && has_next) S.a_ready(nxt);
            if constexpr (SP2) {
            PG8_LDB(B0, 0, 0); PG8_LDB(B1, 0, 1); PG8_SCHED; PG8_LDA(At, 0, 0); PG8_STAGE(PG8_SA(1, 1), a1 + hstep, voffA);
            PG8_WAIT_V(8); PG8_WAIT_L(0); PG8_BAR; PG8_MMA(0, 0, At, B0); PG8_MMA(0, 1, At, B1); PG8_BAR; PG8_SCHED;
            PG8_LDA(At, 0, 1); PG8_STAGE(PG8_SB(0, 0), b2, voffB); PG8_STAGE(PG8_SB(0, 1), b2 + hstep, voffB); PG8_STAGE(PG8_SA(0, 0), a2, voffA);
            PG8_WAIT_V(8); PG8_WAIT_L(0); PG8_BAR; PG8_MMA(1, 0, At, B0); PG8_MMA(1, 1, At, B1); PG8_BAR; PG8_SCHED;
            PG8_LDB(B0, 1, 0); PG8_LDB(B1, 1, 1); PG8_SCHED; PG8_LDA(At, 1, 0); PG8_STAGE(PG8_SA(0, 1), a2 + hstep, voffA);
            PG8_WAIT_V(8); PG8_WAIT_L(0); PG8_BAR; PG8_MMA(0, 0, At, B0); PG8_MMA(0, 1, At, B1); PG8_BAR; PG8_SCHED;
            PG8_LDA(At, 1, 1); PG8_STAGE(PG8_SB(1, 0), b3, voffB); PG8_STAGE(PG8_SB(1, 1), b3 + hstep, voffB); PG8_STAGE(PG8_SA(1, 0), a3, voffA);
            PG8_WAIT_V(8); PG8_WAIT_L(0); PG8_BAR; PG8_MMA(1, 0, At, B0); PG8_MMA(1, 1, At, B1); PG8_BAR; PG8_SCHED;
            } else {
            PG8_LDB(B0, 0, 0); PG8_SCHED; PG8_LDA(At, 0, 0); PG8_STAGE(PG8_SA(1, 1), a1 + hstep, voffA);
            PG8_WAIT_L(8); PG8_BAR; PG8_WAIT_L(0); PG8_MMA(0, 0, At, B0); PG8_BAR; PG8_SCHED;
            PG8_LDB(B1, 0, 1); PG8_STAGE(PG8_SB(0, 0), b2, voffB);
            PG8_BAR; PG8_WAIT_L(0); PG8_MMA(0, 1, At, B1); PG8_BAR;
            PG8_LDA(At, 0, 1); PG8_STAGE(PG8_SA(0, 0), a2, voffA);
            PG8_BAR; PG8_WAIT_L(0); PG8_MMA(1, 0, At, B0); PG8_BAR; PG8_SCHED;
            PG8_STAGE(PG8_SB(0, 1), b2 + hstep, voffB);
            PG8_WAIT_V(6); PG8_BAR; PG8_MMA(1, 1, At, B1); PG8_BAR;
            PG8_LDB(B0, 1, 0); PG8_SCHED; PG8_LDA(At, 1, 0); PG8_STAGE(PG8_SA(0, 1), a2 + hstep, voffA);
            PG8_WAIT_L(8); PG8_BAR; PG8_WAIT_L(0); PG8_MMA(0, 0, At, B0); PG8_BAR; PG8_SCHED;
            PG8_LDB(B1, 1, 1); PG8_STAGE(PG8_SB(1, 0), b3, voffB);
            PG8_BAR; PG8_WAIT_L(0); PG8_MMA(0, 1, At, B1); PG8_BAR;
            PG8_LDA(At, 1, 1); PG8_STAGE(PG8_SA(1, 0), a3, voffA);
            PG8_BAR; PG8_WAIT_L(0); PG8_MMA(1, 0, At, B0); PG8_BAR; PG8_SCHED;
            PG8_STAGE(PG8_SB(1, 1), b3 + hstep, voffB);
            PG8_WAIT_V(6); PG8_BAR; PG8_MMA(1, 1, At, B1); PG8_BAR;
            }
        }
        if constexpr (ALIGN_EPI) { if (wr == 0) PG8_BAR; }
        if constexpr (!Epi::AFTER_DRAIN) { E(acc, cur, wr, wc, fr, fq); S.done(cur); }
        if (!has_next) break;
#pragma unroll
        for (int a = 0; a < 2; ++a)
#pragma unroll
            for (int b = 0; b < 2; ++b)
#pragma unroll
                for (int m = 0; m < 4; ++m)
#pragma unroll
                    for (int n = 0; n < 2; ++n) acc[a][b][m][n] = (f32x4){0.f, 0.f, 0.f, 0.f};
        cur = nxt; cA = nA; cB = nB; ++ui;
        if constexpr (ALIGN_EPI) { if (wr == 1) PG8_BAR; }
    }
    PG8_WAIT_V(0);
    if constexpr (!ALIGN_EPI) { if (wr == 0) PG8_BAR; }
    PG8_BAR;
    if constexpr (Epi::AFTER_DRAIN) { E.fused(acc, cur, wr, wc, fr, fq, lds, wid, lane); S.done(cur); }
#undef PG8_SA
#undef PG8_SB
#undef PG8_STAGE
#undef PG8_LDA
#undef PG8_LDB
#undef PG8_MMA
#undef PG8_WAIT_V
#undef PG8_WAIT_L
#undef PG8_BAR
#undef PG8_SCHED
}
}
#define XB_TMO      128
#define XB_XCNT(j)  (256  + 64 * (j))
#define XB_XSUB(j)  (1280 + 64 * (j))
#define XB_XGEN(j)  (2304 + 64 * (j))
#define XB_TOP      3328
#define XB_TOPGEN   3392
#define XCD_BAR_WORDS 3456
#define XB_SPIN_CAP (1u << 18)

__device__ __forceinline__ unsigned xb_ld(unsigned* p)              { return __hip_atomic_load(p, __ATOMIC_RELAXED, __HIP_MEMORY_SCOPE_AGENT); }
__device__ __forceinline__ unsigned xb_add(unsigned* p, unsigned v) { return __hip_atomic_fetch_add(p, v, __ATOMIC_RELAXED, __HIP_MEMORY_SCOPE_AGENT); }
__device__ __forceinline__ unsigned xb_xcc_id() { return (unsigned)__builtin_amdgcn_s_getreg((3 << 11) | 20) & 0xFu; }
#define XB_SPIN(cond, bar) do { unsigned _sp = 0; while (cond) { __builtin_amdgcn_s_sleep(1); \
    if ((++_sp & 255u) == 0u) { if (xb_ld(&(bar)[XB_TMO])) break; if (_sp > XB_SPIN_CAP) { atomicAdd(&(bar)[XB_TMO], 1u); break; } } } } while (0)

struct XcdBarrier {
    unsigned* bar; unsigned x;
    volatile LAS unsigned* st;
};

__device__ __forceinline__ XcdBarrier xcd_barrier_post(unsigned* bar, volatile LAS unsigned* st) {
    XcdBarrier b; b.bar = bar; b.x = xb_xcc_id(); b.st = st;
    if (threadIdx.x == 0) (void)xb_add(&bar[XB_XCNT(b.x)], 1u);
    return b;
}
__device__ __forceinline__ void xcd_barrier_complete(unsigned* bar, unsigned x, unsigned& nloc, unsigned& nx) {
    const unsigned G = gridDim.x * gridDim.y * gridDim.z;
    unsigned sum, cnt, mine, sp = 0u;
    for (;;) {
        sum = 0u; cnt = 0u; mine = 0u;
#pragma unroll
        for (unsigned j = 0; j < 16; ++j) { const unsigned c = xb_ld(&bar[XB_XCNT(j)]); sum += c; cnt += (c > 0u) ? 1u : 0u; mine = (j == x) ? c : mine; }
        if (sum == G) break;
        __builtin_amdgcn_s_sleep(1);
        if ((++sp & 255u) == 0u) { if (xb_ld(&bar[XB_TMO])) break; if (sp > XB_SPIN_CAP) { atomicAdd(&bar[XB_TMO], 1u); break; } }
    }
    nloc = mine > 0u ? mine : 1u; nx = cnt > 0u ? cnt : 1u;
}

__device__ __forceinline__ void xcd_barrier(const XcdBarrier& b) {
    asm volatile("s_waitcnt vmcnt(0)" ::: "memory");
    __syncthreads();
    if (threadIdx.x == 0) {
        unsigned* bar = b.bar;
        __builtin_amdgcn_s_waitcnt(0);
        unsigned nloc = b.st[0], nx = b.st[1];
        if (nloc == 0u) { xcd_barrier_complete(bar, b.x, nloc, nx); b.st[0] = nloc; b.st[1] = nx; }
        const unsigned old = xb_add(&bar[XB_XSUB(b.x)], 1u);
        const unsigned gen = old / nloc;
        if (old + 1u == (gen + 1u) * nloc) {
            __builtin_amdgcn_fence(__ATOMIC_RELEASE, "agent");
            asm volatile("s_waitcnt vmcnt(0)" ::: "memory");
            const unsigned og = xb_add(&bar[XB_TOP], 1u);
            const unsigned tg = og / nx;
            if (og + 1u == (tg + 1u) * nx) xb_add(&bar[XB_TOPGEN], 1u);
            else XB_SPIN(xb_ld(&bar[XB_TOPGEN]) == tg, bar);
            __builtin_amdgcn_fence(__ATOMIC_ACQUIRE, "agent");
            xb_add(&bar[XB_XGEN(b.x)], 1u);
            asm volatile("s_waitcnt vmcnt(0)" ::: "memory");
        } else {
            XB_SPIN(xb_ld(&bar[XB_XGEN(b.x)]) == gen, bar);
            __builtin_amdgcn_fence(__ATOMIC_ACQUIRE, "agent");
            asm volatile("s_waitcnt vmcnt(0)" ::: "memory");
        }
    }
    __syncthreads();
}

template <class F> struct EpiFn {
    static constexpr bool PERM = true, AFTER_DRAIN = false;
    F f;
    DI void operator()(const f32x4 (&acc)[2][2][4][2], const pg8::Unit& u, int wr, int wc, int fr, int fq) const {
        const int row0 = u.pm * 256 + wr * 64 + fr, col0 = u.pn * 256 + wc * 32 + 8 * fq;
        const int kind = f.kind(u.pn);
#pragma unroll
        for (int ai = 0; ai < 2; ++ai)
#pragma unroll
            for (int m = 0; m < 4; ++m)
#pragma unroll
                for (int bj = 0; bj < 2; ++bj) f(kind, row0 + ai * 128 + m * 16, col0 + bj * 128, acc[ai][bj][m][0], acc[ai][bj][m][1]);
    }
};
DI u32x4 pack8(f32x4 a, f32x4 b) { u32x4 w; w.x = pk2(a[0], a[1]); w.y = pk2(a[2], a[3]); w.z = pk2(b[0], b[1]); w.w = pk2(b[2], b[3]); return w; }
DI void st8f(float* p, f32x4 a, f32x4 b) { *(f32x4*)p = a; *(f32x4*)(p + 4) = b; }

struct FnA {
    bf16* qa; float* fa; bf16* va; bf16* oga; bf16* memq; const float* lb;
    DI int kind(int pn) const { return pn < 12 ? 0 : pn < 18 ? 2 : pn < 24 ? 3 : 4; }
    DI void operator()(int kind, int row, int col, f32x4 v0, f32x4 v1) const {
        if (kind == 0) {
            const int ch = (col >> 8) * HD + (col & 127);
            if (((col >> 7) & 1) == 0) {
#pragma unroll
                for (int e = 0; e < 4; ++e) { v0[e] = v0[e] * sigm(v0[e]); v1[e] = v1[e] * sigm(v1[e]); }
                *(u32x4*)(qa + (size_t)row * TOK + ch) = pack8(v0, v1);
            } else {
                const f32x4 l0 = *(const f32x4*)(lb + ch), l1 = *(const f32x4*)(lb + ch + 4);
#pragma unroll
                for (int e = 0; e < 4; ++e) { v0[e] = l0[e] + (1.f - l0[e]) * sigm(v0[e]); v1[e] = l1[e] + (1.f - l1[e]) * sigm(v1[e]); }
                st8f(fa + (size_t)row * TOK + ch, v0, v1);
            }
        } else if (kind == 2) {
            *(u32x4*)(va + (size_t)row * TOK + (col - 2 * TOK)) = pack8(v0, v1);
        } else if (kind == 3) {
#pragma unroll
            for (int e = 0; e < 4; ++e) { v0[e] = sigm(v0[e]); v1[e] = sigm(v1[e]); }
            *(u32x4*)(oga + (size_t)row * TOK + (col - 3 * TOK)) = pack8(v0, v1);
        } else {
            *(u32x4*)(memq + (size_t)row * MEMW + (col - 4 * TOK)) = pack8(v0, v1);
        }
    }
};
template <int CTRL> DI float dpp_mov0(float x) { return __builtin_bit_cast(float, __builtin_amdgcn_update_dpp(0, __builtin_bit_cast(int, x), CTRL, 0xf, 0xf, false)); }
DI float row_scan16(float x) { x += dpp_mov0<0x111>(x); x += dpp_mov0<0x112>(x); x += dpp_mov0<0x114>(x); x += dpp_mov0<0x118>(x); return x; }
struct EpiA {
    static constexpr bool PERM = true, AFTER_DRAIN = false;
    bf16* qp; bf16* kp; bf16* kt; bf16* vf; float* dv; bf16* oga; bf16* memq; const float* lb; FnA fs;
    DI void operator()(const f32x4 (&acc)[2][2][4][2], const pg8::Unit& u, int wr, int wc, int fr, int fq) const {
        const int pn = u.pn;
        if (u.pm >= MPR / 256) {
            const int row0 = u.pm * 256 + wr * 64 + fr, col0 = pn * 256 + wc * 32 + 8 * fq, kind = fs.kind(pn);
#pragma unroll
            for (int ai = 0; ai < 2; ++ai)
#pragma unroll
                for (int m = 0; m < 4; ++m)
#pragma unroll
                    for (int bj = 0; bj < 2; ++bj) fs(kind, row0 + ai * 128 + m * 16, col0 + bj * 128, acc[ai][bj][m][0], acc[ai][bj][m][1]);
        } else if (pn < 12) {
            const int k0 = 32 * wc + 8 * fq;
            const f32x4 l0 = *(const f32x4*)(lb + pn * HD + k0), l1 = *(const f32x4*)(lb + pn * HD + k0 + 4);
#pragma unroll
            for (int ai = 0; ai < 2; ++ai)
#pragma unroll
                for (int mp = 0; mp < 2; ++mp) {
                    const int grow0 = u.pm * 256 + ai * 128 + wr * 64 + mp * 32, bh = (grow0 >> 11) * NH + pn, c = (grow0 & (TP - 1)) >> 5;
                    const size_t cb = ((size_t)bh * 64 + c) * 4096;
                    const size_t rowoff = (size_t)(wc * 2 + ((fq >> 1) & 1)) * 512 + (fq & 1) * 4;
#pragma unroll
                    for (int eh = 0; eh < 2; ++eh) {
                        float q1[2][4], k1[2][4], k2[2][4];
#pragma unroll
                        for (int e4 = 0; e4 < 4; ++e4) {
                            const float lbv = eh ? l1[e4] : l0[e4];
                            float qv[2], kk[2], sc[2];
#pragma unroll
                            for (int mo = 0; mo < 2; ++mo) {
                                const float uq = acc[ai][0][2 * mp + mo][eh][e4], uf = acc[ai][1][2 * mp + mo][eh][e4];
                                qv[mo] = uq * sigm(uq);
                                const float f = lbv + (1.f - lbv) * sigm(uf);
                                kk[mo] = 1.f - f;
                                sc[mo] = row_scan16(__builtin_amdgcn_logf(f));
                            }
                            const float tot0 = __shfl(sc[0], 15, 16), tot1 = __shfl(sc[1], 15, 16);
                            const float b0 = sc[0], b1 = tot0 + sc[1], r = tot0, b31 = tot0 + tot1;
                            q1[0][e4] = qv[0] * __builtin_amdgcn_exp2f(b0 - r); q1[1][e4] = qv[1] * __builtin_amdgcn_exp2f(b1 - r);
                            k1[0][e4] = kk[0] * __builtin_amdgcn_exp2f(r - b0); k1[1][e4] = kk[1] * __builtin_amdgcn_exp2f(r - b1);
                            k2[0][e4] = kk[0] * __builtin_amdgcn_exp2f(b31 - b0); k2[1][e4] = kk[1] * __builtin_amdgcn_exp2f(b31 - b1);
                            if (fr == 0) { float* dp = dv + ((size_t)bh * 64 + c) * 256 + k0 + 4 * eh + e4; dp[0] = __builtin_amdgcn_exp2f(b31); dp[128] = __builtin_amdgcn_exp2f(r); }
                        }
#pragma unroll
                        for (int mo = 0; mo < 2; ++mo) {
                            const int tt = 16 * mo + fr;
                            const size_t o = cb + rowoff + (size_t)(tt + 32 * eh) * 8;
                            u32x2 w; w.x = pk2(q1[mo][0], q1[mo][1]); w.y = pk2(q1[mo][2], q1[mo][3]); *(u32x2*)(qp + o) = w;
                            w.x = pk2(k1[mo][0], k1[mo][1]); w.y = pk2(k1[mo][2], k1[mo][3]); *(u32x2*)(kp + o) = w;
                            bf16* tp = kt + cb + vf_off(tt, k0 + 4 * eh);
#pragma unroll
                            for (int e4 = 0; e4 < 4; ++e4) tp[e4 * 8] = f2bf(k2[mo][e4]);
                        }
                    }
                }
        } else {
            const int row0 = u.pm * 256 + wr * 64 + fr, col0 = pn * 256 + wc * 32 + 8 * fq;
#pragma unroll
            for (int ai = 0; ai < 2; ++ai)
#pragma unroll
                for (int m = 0; m < 4; ++m)
#pragma unroll
                    for (int bj = 0; bj < 2; ++bj) {
                        const int row = row0 + ai * 128 + m * 16, col = col0 + bj * 128; f32x4 v0 = acc[ai][bj][m][0], v1 = acc[ai][bj][m][1];
                        if (pn < 18) {
                            const int hv = (col - 2 * TOK) >> 7, vd = col & 127, t = row & (TP - 1);
                            bf16* p = vf + ((size_t)((row >> 11) * NH + hv) * 64 + (t >> 5)) * 4096 + vf_off(t & 31, vd);
#pragma unroll
                            for (int e = 0; e < 4; ++e) { p[e * 8] = f2bf(v0[e]); p[(e + 4) * 8] = f2bf(v1[e]); }
                        } else if (pn < 24) {
#pragma unroll
                            for (int e = 0; e < 4; ++e) { v0[e] = sigm(v0[e]); v1[e] = sigm(v1[e]); }
                            *(u32x4*)(oga + (size_t)row * TOK + (col - 3 * TOK)) = pack8(v0, v1);
                        } else {
                            *(u32x4*)(memq + (size_t)row * MEMW + (col - 4 * TOK)) = pack8(v0, v1);
                        }
                    }
        }
    }
};
struct FnM {
    float* out; bf16* mk; bf16* mvt;
    DI int kind(int pn) const { return (pn & 3) >> 1; }
    DI void operator()(int kind, int row, int col, f32x4 v0, f32x4 v1) const {
        const int b = row >> 8, m = row & 255, l = col >> 10, c = col & 1023, h = (c >> 7) & 3, d = c & 127;
        st8f(out + O_MP + ((size_t)((l * BP + b) * MEML + m)) * 1024 + c, v0, v1);
        const size_t hb = ((size_t)((l * 40 + b) * 4 + h)) * MEML * HD + (size_t)(m >> 5) * 4096;
        if (kind == 0) {
            *(u32x4*)(mk + hb + kf_off(m & 31, d)) = pack8(v0, v1);
        } else {
            bf16* p = mvt + hb + vf_off(m & 31, d);
#pragma unroll
            for (int e = 0; e < 4; ++e) { p[e * 8] = f2bf(v0[e]); p[(e + 4) * 8] = f2bf(v1[e]); }
        }
    }
};
struct FnC {
    float* o; int ld;
    DI int kind(int) const { return 0; }
    DI void operator()(int, int row, int col, f32x4 v0, f32x4 v1) const { st8f(o + (size_t)row * ld + col, v0, v1); }
};
struct FnO {
    bf16* o; int ld;
    DI int kind(int) const { return 0; }
    DI void operator()(int, int row, int col, f32x4 v0, f32x4 v1) const { *(u32x4*)(o + (size_t)row * ld + col) = pack8(v0, v1); }
};
struct FnF1 {
    bf16* ab; float* out; int layer;
    DI int kind(int) const { return 0; }
    DI void operator()(int, int row, int col, f32x4 v0, f32x4 v1) const {
        const int half = (col >> 7) & 1, n = (col >> 8) * 128 + (col & 127);
        *(u32x4*)(ab + (size_t)row * FF2 + half * FF + n) = pack8(v0, v1);
        if (half == 0 && row >= MPR && row < MR) { const int rs = row - MPR, t = rs & 3; if (t >= 2) st8f(out + O_CS + ((size_t)((layer * BS + (rs >> 2)) * 2 + (t - 2))) * FF + n, v0, v1); }
    }
};
template <int CTRL> DI float dpp_ror(float x) { return __builtin_bit_cast(float, __builtin_amdgcn_update_dpp(0, __builtin_bit_cast(int, x), CTRL, 0xf, 0xf, false)); }
struct EpiF1 {
    static constexpr bool PERM = true, AFTER_DRAIN = false;
    bf16* hid; float* fix; float* halo; float* out; const float* wconv; const float* bconv; int layer;
    DI void operator()(const f32x4 (&acc)[2][2][4][2], const pg8::Unit& u, int wr, int wc, int fr, int fq) const {
        const int n0 = u.pn * 128 + wc * 32 + 8 * fq;
        f32x4 w0[2], w1[2], w2[2], bb[2];
#pragma unroll
        for (int eh = 0; eh < 2; ++eh) { w0[eh] = *(const f32x4*)(wconv + n0 + 4 * eh); w1[eh] = *(const f32x4*)(wconv + FF + n0 + 4 * eh); w2[eh] = *(const f32x4*)(wconv + 2 * FF + n0 + 4 * eh); bb[eh] = *(const f32x4*)(bconv + n0 + 4 * eh); }
#pragma unroll
        for (int ai = 0; ai < 2; ++ai) {
            const int rowb = u.pm * 256 + ai * 128 + wr * 64, blk = rowb >> 6;
            f32x4 p1[2] = {(f32x4){0.f, 0.f, 0.f, 0.f}, (f32x4){0.f, 0.f, 0.f, 0.f}}, p2[2] = {(f32x4){0.f, 0.f, 0.f, 0.f}, (f32x4){0.f, 0.f, 0.f, 0.f}};
#pragma unroll
            for (int m = 0; m < 4; ++m) {
                const int row = rowb + m * 16 + fr;
                f32x4 h[2];
#pragma unroll
                for (int eh = 0; eh < 2; ++eh) {
                    f32x4 c1, c2;
#pragma unroll
                    for (int e = 0; e < 4; ++e) { const float av = acc[ai][0][m][eh][e]; c1[e] = dpp_ror<0x121>(av); c2[e] = dpp_ror<0x122>(av); }
#pragma unroll
                    for (int e = 0; e < 4; ++e) {
                        const float e1 = fr >= 1 ? c1[e] : p1[eh][e], e0 = fr >= 2 ? c2[e] : p2[eh][e];
                        const float cc = bb[eh][e] + w0[eh][e] * e0 + w1[eh][e] * e1 + w2[eh][e] * acc[ai][0][m][eh][e];
                        h[eh][e] = gelu_t(cc) * acc[ai][1][m][eh][e];
                    }
                    p1[eh] = c1; p2[eh] = c2;
                }
                if (m == 0 && fr < 2) {
                    float* fp = fix + ((size_t)(blk * 2 + fr) * 2) * FF + n0;
                    st8f(fp, acc[ai][0][0][0], acc[ai][0][0][1]); st8f(fp + FF, acc[ai][1][0][0], acc[ai][1][0][1]);
                } else {
                    *(u32x4*)(hid + (size_t)row * FF + n0) = pack8(h[0], h[1]);
                }
                if (m == 3 && fr >= 14) {
                    st8f(halo + ((size_t)(blk * 2 + (fr - 14))) * FF + n0, acc[ai][0][3][0], acc[ai][0][3][1]);
                    const int t = row & (TP - 1);
                    if (t >= TP - 2) st8f(out + O_CP + ((size_t)((layer * BP + (row >> 11)) * 2 + (t - (TP - 2)))) * FF + n0, acc[ai][0][3][0], acc[ai][0][3][1]);
                }
            }
        }
    }
};
struct FnB {
    bf16* qb; bf16* memq; float* gates; float* out; bf16* kcmp; bf16* vcmp; bf16* ksel; bf16* vselt; bf16* kwin; bf16* vwint;
    DI int kind(int pn) const { return pn < 6 ? 0 : pn < 8 ? 1 : pn < 14 ? 2 + (pn - 8) : 8; }
    DI void operator()(int kind, int row, int col, f32x4 v0, f32x4 v1) const {
        if (kind == 0) { *(u32x4*)(qb + (size_t)row * TOK + col) = pack8(v0, v1); }
        else if (kind == 1) { *(u32x4*)(memq + (size_t)row * MEMW + (col - TOK)) = pack8(v0, v1); }
        else if (kind == 8) {
            const int c = col - 3584;
            if (c < 36) {
#pragma unroll
                for (int e = 0; e < 4; ++e) { v0[e] = sigm(v0[e]); v1[e] = sigm(v1[e]); }
                st8f(gates + (size_t)row * 40 + c, v0, v1);
            }
        } else {
            const int kk = kind - 2, cp = col - 2048, g = (col >> 7) & 1, d = col & 127;
            if (row < MPR) {
                const int b = row >> 11, t = row & (TP - 1);
                if (kk < 4) st8f(out + O_KVP + (size_t)row * 1024 + cp, v0, v1);
                else if (t >= TP - 512) st8f(out + O_WP + ((size_t)(b * 512 + (t - (TP - 512)))) * 512 + (cp - 1024), v0, v1);
                const size_t gb = (size_t)(b * GB + g) * TP * HD;
                if (kk == 3 || kk == 5) {
                    bf16* p = (kk == 3 ? vselt : vwint) + gb + (size_t)(t >> 5) * 4096 + vf_off(t & 31, d);
#pragma unroll
                    for (int e = 0; e < 4; ++e) { p[e * 8] = f2bf(v0[e]); p[(e + 4) * 8] = f2bf(v1[e]); }
                } else if (kk < 2) {
                    *(u32x4*)((kk == 0 ? kcmp : vcmp) + gb + (size_t)t * HD + d) = pack8(v0, v1);
                } else {
                    *(u32x4*)((kk == 2 ? ksel : kwin) + gb + (size_t)(t >> 5) * 4096 + kf_off(t & 31, d)) = pack8(v0, v1);
                }
            } else if (row < MR) {
                const int rs = row - MPR;
                if (kk < 4) st8f(out + O_KVS + (size_t)rs * 1024 + cp, v0, v1);
                else st8f(out + O_WS + (size_t)rs * 512 + (cp - 1024), v0, v1);
            }
        }
    }
};

struct Args { const float* in[25]; float* out; unsigned char* ws; };
typedef const __attribute__((address_space(4))) Args& ArgsRef;
DI const __attribute__((address_space(4))) Args* phase_args() { const __attribute__((address_space(4))) Args* p = (const __attribute__((address_space(4))) Args*)__builtin_amdgcn_kernarg_segment_ptr(); asm volatile("" : "+s"(p)); return p; }
enum { I_XP = 0, I_XS, I_MEMP, I_HST, I_CCONV, I_CMEM, I_CKV, I_CWIN, I_PT, I_NG, I_WINA, I_LBL, I_HGN, I_WINB, I_WO, I_WMKV, I_KVN, I_WKVB, I_CPOS, I_WC1, I_WC2, I_WF1, I_WCONV, I_BCONV, I_WF2 };

struct SegD { int in_idx, src_off, ldw, col0, nvalid, ncols, gain_idx, gain_off, row0, K; unsigned long long dst; };
static constexpr SegD k_segs[17] = {
    {I_WINA, 0, NA, 0, NA, NA, I_NG, 0, 0, 2048, WS_BTA},
    {I_WO, 0, D, 0, D, D, -1, 0, 0, 2048, WS_BTO0},
    {I_WO, D * D, D, 0, D, D, -1, 0, 0, 2048, WS_BTO1},
    {I_WF1, 0, FF2, 0, FF2, FF2, I_NG, 2 * D, 0, 2048, WS_BTF10},
    {I_WF1, D * FF2, FF2, 0, FF2, FF2, I_NG, 6 * D, 0, 2048, WS_BTF11},
    {I_WF2, 0, D, 0, D, D, -1, 0, 0, FF, WS_BTF20},
    {I_WF2, FF * D, D, 0, D, D, -1, 0, 0, FF, WS_BTF21},
    {I_WINB, 0, 2084, 0, 1536, 1536, I_NG, 4 * D, 0, 2048, WS_BTB},
    {I_WINB, 0, 2084, 1572, 512, 512, I_NG, 4 * D, 1536, 2048, WS_BTB},
    {I_WINB, 0, 2084, 1536, 36, 256, I_NG, 4 * D, 3584, 2048, WS_BTB},
    {I_WKVB, 0, 1536, 0, 1536, 1536, I_KVN, 0, 2048, 2048, WS_BTB},
    {I_WMKV, 0, 1024, 0, 1024, 1024, -1, 0, 0, 2048, WS_BTM},
    {I_WMKV, D * 1024, 1024, 0, 1024, 1024, -1, 0, 1024, 2048, WS_BTM},
    {I_WC1, 0, 128, 0, 128, 128, -1, 0, 0, 2048, WS_BTC},
    {I_WC1, 2048 * 128, 128, 0, 128, 128, -1, 0, 128, 2048, WS_BTC},
    {I_WC1, 4096 * 128, 128, 0, 128, 128, -1, 0, 0, 2048, WS_BTC + (size_t)256 * 2048 * 2},
    {I_WC1, 4096 * 128 + 2048 * 128, 128, 0, 128, 128, -1, 0, 128, 2048, WS_BTC + (size_t)256 * 2048 * 2},
};
static constexpr int k_tl_end[17] = { 832, 1088, 1344, 2752, 4160, 4864, 5568, 5760, 5824, 5856, 6048, 6176, 6304, 6336, 6368, 6400, 6432 };
constexpr int TL_A0 = 832, TL_LATE0 = 832, TL_LATE1 = 6048, TL_END = 6432;
struct TrTile { bf16* dst; int k0, n0, row0, K, ncols; f32x4 v[8]; float gk[8]; };
DI void tr_load(ArgsRef a, int tile, TrTile& T, int tid) {
    int s = 0, base = 0;
#pragma unroll
    for (int i = 0; i < 16; ++i) { const bool ge = tile >= k_tl_end[i]; s += ge ? 1 : 0; base = ge ? k_tl_end[i] : base; }
    SegD sd = k_segs[0];
#pragma unroll
    for (int i = 1; i < 17; ++i) if (s == i) sd = k_segs[i];
    const int r = tile - base, ncb = (sd.ncols + 255) >> 8, kb = r / ncb, nb = r - kb * ncb, k0 = 64 * kb, n0 = 256 * nb;
    const float* W = a.in[sd.in_idx] + sd.src_off;
    const float* gain = sd.gain_idx >= 0 ? a.in[sd.gain_idx] + sd.gain_off : nullptr;
    T.dst = (bf16*)(a.ws + sd.dst); T.k0 = k0; T.n0 = n0; T.row0 = sd.row0; T.K = sd.K; T.ncols = sd.ncols;
    const int ilv = (s == 0) ? TOK : (s == 3 || s == 4) ? FF : 0;
#pragma unroll
    for (int i = 0; i < 8; ++i) {
        const int idx = i * NTHR + tid, kk = idx >> 6, c4 = (idx & 63) * 4, n = n0 + c4, g128 = n & ~127;
        const int scol = (ilv && (s != 0 || g128 < 2 * TOK)) ? ((g128 >> 7) & 1) * ilv + (g128 >> 8) * 128 + (n & 127) : n;
        const float* src = W + (size_t)(k0 + kk) * sd.ldw + sd.col0 + scol;
        if (n + 3 < sd.nvalid) T.v[i] = *(const f32x4*)src;
        else { for (int e = 0; e < 4; ++e) T.v[i][e] = (n + e < sd.nvalid) ? src[e] : 0.f; }
        T.gk[i] = gain ? gain[k0 + kk] : 1.f;
    }
}
constexpr int TR_LD = 260, TR_BUF = 64 * TR_LD * 2;
DI void tr_write(const TrTile& T, LAS unsigned char* buf, int tid) {
#pragma unroll
    for (int i = 0; i < 8; ++i) {
        const int idx = i * NTHR + tid, kk = idx >> 6, c4 = (idx & 63) * 4; const float g = T.gk[i];
        u32x2 w; w.x = pk2(T.v[i][0] * g, T.v[i][1] * g); w.y = pk2(T.v[i][2] * g, T.v[i][3] * g);
        *(LAS u32x2*)(buf + (kk * TR_LD + c4) * 2) = w;
    }
}
DI void tr_store(const TrTile& T, const LAS unsigned char* buf, int tid) {
    const LAS bf16* B = (const LAS bf16*)buf;
#pragma unroll
    for (int j = 0; j < 4; ++j) {
        const int id = j * NTHR + tid, n = id >> 3, c = id & 7;
        if (T.n0 + n < T.ncols) {
            const LAS bf16* sp = B + (8 * c) * TR_LD + n;
            u32x4 o; o.x = (unsigned)sp[0] | ((unsigned)sp[TR_LD] << 16); o.y = (unsigned)sp[2 * TR_LD] | ((unsigned)sp[3 * TR_LD] << 16);
            o.z = (unsigned)sp[4 * TR_LD] | ((unsigned)sp[5 * TR_LD] << 16); o.w = (unsigned)sp[6 * TR_LD] | ((unsigned)sp[7 * TR_LD] << 16);
            *(u32x4*)(T.dst + (size_t)(T.row0 + T.n0 + n) * T.K + T.k0 + 8 * c) = o;
        }
    }
}
#define TR_BAR() asm volatile("s_waitcnt lgkmcnt(0)\n\ts_barrier" ::: "memory")
template <class MAP>
DI void wg_transpose_run(ArgsRef a, LAS unsigned char* lds, int first, int last, int step, const MAP& map, int tid) {
    if (first >= last) return;
    __syncthreads();
    TrTile T; tr_load(a, map(first), T, tid);
    int par = 0;
    for (int t = first; t < last; t += step) {
        LAS unsigned char* buf = lds + par * TR_BUF;
        tr_write(T, buf, tid);
        const TrTile Tc = T;
        if (t + step < last) tr_load(a, map(t + step), T, tid);
        TR_BAR();
        tr_store(Tc, buf, tid);
        par ^= 1;
    }
    __syncthreads();
}
template <bool NORM> DI void row_to_bf16(const float* xrow, bf16* orow, int lane) {
    const f32x4* xr = (const f32x4*)xrow + lane;
    f32x4 v[8]; float s = 0.f;
#pragma unroll
    for (int j = 0; j < 8; ++j) { v[j] = xr[64 * j]; s += (v[j][0] * v[j][0] + v[j][1] * v[j][1]) + (v[j][2] * v[j][2] + v[j][3] * v[j][3]); }
    float rs = 1.f;
    if (NORM) rs = rsqrtf(wave_sum(s) * (1.f / D) + EPS);
    u32x2* o8 = (u32x2*)orow + lane;
#pragma unroll
    for (int j = 0; j < 8; ++j) { u32x2 w; w.x = pk2(v[j][0] * rs, v[j][1] * rs); w.y = pk2(v[j][2] * rs, v[j][3] * rs); o8[64 * j] = w; }
}
DI void p0_prologue(ArgsRef a, LAS unsigned char* lds, int gw, int ngw, int wave, int lane) {
    bf16* XN = (bf16*)(a.ws + WS_XN);
    for (int m = gw; m < MR; m += ngw) {
        const float* src = m < MPR ? a.in[I_XP] + (size_t)m * D : a.in[I_XS] + (size_t)(m - MPR) * D;
        row_to_bf16<true>(src, XN + (size_t)m * D, lane);
    }
    bf16* MB = (bf16*)(a.ws + WS_MEMPB);
    for (int m = gw; m < BP * MEML; m += ngw) row_to_bf16<false>(a.in[I_MEMP] + (size_t)m * D, MB + (size_t)m * D, lane);
    bf16* MK = (bf16*)(a.ws + WS_MK); bf16* MVT = (bf16*)(a.ws + WS_MVT);
    for (int rr = gw; rr < 2 * BS * MEML; rr += ngw) {
        const int l = rr / (BS * MEML), b = (rr / MEML) % BS, m = rr % MEML;
        const float* src = a.in[I_CMEM] + (size_t)rr * 1024;
#pragma unroll
        for (int j = 0; j < 4; ++j) {
            const int idx = 4 * lane + 256 * j, h = (idx >> 7) & 3, d = idx & 127;
            const f32x4 v = *(const f32x4*)(src + idx);
            const size_t hb = ((size_t)((l * 40 + 8 + b) * 4 + h)) * MEML * HD + (size_t)(m >> 5) * 4096;
            if (j < 2) { u32x2 w; w.x = pk2(v[0], v[1]); w.y = pk2(v[2], v[3]); *(u32x2*)(MK + hb + kf_off(m & 31, d)) = w; }
            else { bf16* p = MVT + hb + vf_off(m & 31, d);
#pragma unroll
                for (int e = 0; e < 4; ++e) p[e * 8] = f2bf(v[e]); }
        }
    }
    for (int idx = gw * 64 + lane; idx < 2 * 128 * 128; idx += ngw * 64) { const int kv = idx >> 14, d = (idx >> 7) & 127, hh = idx & 127; ((bf16*)(a.ws + WS_W2T))[idx] = f2bf(a.in[I_WC2][(size_t)kv * 16384 + hh * 128 + d]); }
    if (gw < 24) { const int c = gw * 64 + lane; const float* ll = a.in[I_LBL]; ((float*)(a.ws + WS_LB))[c] = 1.f / (1.f + __expf(ll[TOK + c] - ll[c])); }
    for (int it = gw; it < 256; it += ngw) {
        const int kv = it >> 7, h = it & 127; const float* pe = a.in[I_CPOS] + kv * 4096; const float* w1 = a.in[I_WC1] + (size_t)kv * 4096 * 128 + h;
        float s = 0.f;
        for (int i = 0; i < 64; ++i) { const int n = lane + 64 * i; s += pe[n] * w1[(size_t)n * 128]; }
        s = wave_sum(s);
        if (lane == 0) ((float*)(a.ws + WS_PRE0))[it] = s;
    }
}


#define MFMA32(a, b, c) __builtin_amdgcn_mfma_f32_32x32x16_bf16((a), (b), (c), 0, 0, 0)
DI int crow(int i, int h) { return (i & 3) + 8 * (i >> 2) + 4 * h; }
DI f32x16 zero16() { f32x16 z; for (int i = 0; i < 16; ++i) z[i] = 0.f; return z; }
DI bf16x8 packp(const f32x16& s, int st) {
    u32x4 p; p.x = pk2(s[8 * st + 0], s[8 * st + 1]); p.y = pk2(s[8 * st + 2], s[8 * st + 3]); p.z = pk2(s[8 * st + 4], s[8 * st + 5]); p.w = pk2(s[8 * st + 6], s[8 * st + 7]);
    return __builtin_bit_cast(bf16x8, p);
}
struct AttnAcc { f32x16 o[4]; float m, l; };
DI void attn_init(AttnAcc& A) { for (int i = 0; i < 4; ++i) A.o[i] = zero16(); A.m = -1e30f; A.l = 0.f; }
DI void load_qf(bf16x8 (&qf)[8], const bf16* qrow, int h) {
#pragma unroll
    for (int ks = 0; ks < 8; ++ks) qf[ks] = *(const bf16x8*)(qrow + 16 * ks + 8 * h);
}
DI f32x16 qk_tile(const bf16x8 (&qf)[8], const bf16* Kt, int lane) {
    f32x16 s = zero16();
    const bf16x8* kp = (const bf16x8*)Kt + lane;
#pragma unroll
    for (int ks = 0; ks < 8; ++ks) s = MFMA32(kp[ks * 64], qf[ks], s);
    return s;
}
DI f32x16 qk_tile_l(const LAS bf16x8* ql, const bf16* Kt, int lane) {
    f32x16 s = zero16();
    const bf16x8* kp = (const bf16x8*)Kt + lane;
#pragma unroll
    for (int ks = 0; ks < 8; ++ks) s = MFMA32(kp[ks * 64], ql[ks * 64 + lane], s);
    return s;
}
DI void pv_tile(f32x16 (&o)[4], const f32x16& p, const bf16* Vt, int lane) {
    const bf16x8* vp = (const bf16x8*)Vt + lane;
#pragma unroll
    for (int st = 0; st < 2; ++st) {
        const bf16x8 pf = packp(p, st);
#pragma unroll
        for (int db = 0; db < 4; ++db) o[db] = MFMA32(vp[(st * 4 + db) * 64], pf, o[db]);
    }
}
template <class VF>
DI void attn_step(AttnAcc& A, f32x16 s, const bf16* Vt, float slope2, float kp0, float kps, const VF& valid, int lane) {
    const int h = lane >> 5;
    float mt = -1e30f;
#pragma unroll
    for (int i = 0; i < 16; ++i) {
        const int kvl = crow(i, h);
        float v = s[i] * SCALE2 + slope2 * (kp0 + kps * (float)kvl);
        v = valid(kvl) ? v : -1e30f;
        s[i] = v; mt = fmaxf(mt, v);
    }
    mt = fmaxf(mt, __shfl_xor(mt, 32));
    const float mn = fmaxf(A.m, mt), alpha = __builtin_amdgcn_exp2f(A.m - mn);
    A.m = mn;
    float ls = 0.f;
#pragma unroll
    for (int i = 0; i < 16; ++i) { const float p = s[i] > -1e29f ? __builtin_amdgcn_exp2f(s[i] - mn) : 0.f; s[i] = p; ls += p; }
    A.l = A.l * alpha + ls;
#pragma unroll
    for (int db = 0; db < 4; ++db) A.o[db] *= alpha;
    pv_tile(A.o, s, Vt, lane);
}
DI void load8(bf16x8 (&f)[8], const bf16* tile, int lane) {
    const bf16x8* p = (const bf16x8*)tile + lane;
#pragma unroll
    for (int i = 0; i < 8; ++i) f[i] = p[i * 64];
}
template <class VF, class FF>
DI void attn_run(AttnAcc& A, const LAS bf16x8* ql, const bf16* Kb, const bf16* Vb, unsigned long long tmask, float slope2, int t0, const VF& validf, const FF& fullf, int lane) {
    if (tmask == 0ull) return;
    const int h = lane >> 5;
    int kt = __builtin_ctzll(tmask); tmask &= tmask - 1ull;
    bf16x8 kf[8]; load8(kf, Kb + (size_t)kt * 4096, lane);
    for (;;) {
        const bf16x8* vp = (const bf16x8*)(Vb + (size_t)kt * 4096) + lane;
        bf16x8 va[4], vb[4];
#pragma unroll
        for (int db = 0; db < 4; ++db) va[db] = vp[db * 64];
#pragma unroll
        for (int db = 0; db < 4; ++db) vb[db] = vp[(4 + db) * 64];
        __builtin_amdgcn_sched_barrier(0);
        const LAS bf16x8* q2 = ql + lane; asm volatile("" : "+v"(q2));
        f32x16 s = zero16();
#pragma unroll
        for (int ks = 0; ks < 8; ++ks) s = MFMA32(kf[ks], q2[ks * 64], s);
        const bool more = tmask != 0ull; int kn = kt;
        const float kb0 = slope2 * (float)(kt * 32 - t0 + 4 * h);
        const bool full = fullf(kt);
        float mt = -1e30f;
        if (full) {
#pragma unroll
            for (int i = 0; i < 16; ++i) { const float v = fmaf(s[i], SCALE2, fmaf(slope2, (float)((i & 3) + 8 * (i >> 2)), kb0)); s[i] = v; mt = fmaxf(mt, v); }
        } else {
#pragma unroll
            for (int i = 0; i < 16; ++i) { float v = fmaf(s[i], SCALE2, fmaf(slope2, (float)((i & 3) + 8 * (i >> 2)), kb0)); v = validf(kt, crow(i, h)) ? v : -1e30f; s[i] = v; mt = fmaxf(mt, v); }
        }
        if (more) { kn = __builtin_ctzll(tmask); tmask &= tmask - 1ull; load8(kf, Kb + (size_t)kn * 4096, lane); }
        __builtin_amdgcn_sched_barrier(0);
        mt = fmaxf(mt, __shfl_xor(mt, 32));
        float mn = A.m;
        if (__any(mt > A.m + 8.f)) {
            mn = fmaxf(A.m, mt);
            const float alpha = __builtin_amdgcn_exp2f(A.m - mn);
            A.m = mn; A.l *= alpha;
#pragma unroll
            for (int db = 0; db < 4; ++db) A.o[db] *= alpha;
        }
        float ls = 0.f;
        if (full) {
#pragma unroll
            for (int i = 0; i < 16; ++i) { const float p = __builtin_amdgcn_exp2f(s[i] - mn); s[i] = p; ls += p; }
        } else {
#pragma unroll
            for (int i = 0; i < 16; ++i) { const float p = s[i] > -1e29f ? __builtin_amdgcn_exp2f(s[i] - mn) : 0.f; s[i] = p; ls += p; }
        }
        A.l += ls;
        { const bf16x8 pf = packp(s, 0);
#pragma unroll
          for (int db = 0; db < 4; ++db) A.o[db] = MFMA32(va[db], pf, A.o[db]); }
        { const bf16x8 pf = packp(s, 1);
#pragma unroll
          for (int db = 0; db < 4; ++db) A.o[db] = MFMA32(vb[db], pf, A.o[db]); }
        if (!more) break;
        kt = kn;
    }
}
DI float attn_inv(const AttnAcc& A) { const float lt = A.l + __shfl_xor(A.l, 32); return lt > 0.f ? 1.f / lt : 0.f; }
DI void store_ot(bf16* orow, const f32x16 (&o)[4], int h) {
#pragma unroll
    for (int db = 0; db < 4; ++db)
#pragma unroll
        for (int c = 0; c < 4; ++c) {
            u32x2 w; w.x = pk2(o[db][4 * c], o[db][4 * c + 1]); w.y = pk2(o[db][4 * c + 2], o[db][4 * c + 3]);
            *(u32x2*)(orow + 32 * db + 8 * c + 4 * h) = w;
        }
}

DI void memattn_item(ArgsRef a, int layer, int it, LAS float* wreg, int lane) {
    const int r = lane & 31, h = lane >> 5;
    int bq, hd, row, nvalid;
    if (it < BP * MEMH * 64) { bq = it >> 8; hd = (it >> 6) & 3; const int tau = it & 63; row = bq * TP + tau * 32 + r; nvalid = 32; }
    else { const int j = it - BP * MEMH * 64; const int bs = j >> 2; hd = j & 3; bq = 8 + bs; row = MPR + bs * 4 + (r < 4 ? r : 3); nvalid = 4; }
    const bf16* MEMQ = (const bf16*)(a.ws + WS_MEMQ);
    const bf16* K = (const bf16*)(a.ws + WS_MK) + ((size_t)((layer * 40 + bq) * 4 + hd)) * MEML * HD;
    const bf16* VT = (const bf16*)(a.ws + WS_MVT) + ((size_t)((layer * 40 + bq) * 4 + hd)) * HD * MEML;
    LAS bf16x8* ql = (LAS bf16x8*)(wreg + 2048);
    { bf16x8 qf[8]; load_qf(qf, MEMQ + (size_t)row * MEMW + hd * HD, h);
#pragma unroll
      for (int ks = 0; ks < 8; ++ks) ql[ks * 64 + lane] = qf[ks]; }
    LDS_WAIT(); asm volatile("" ::: "memory");
    AttnAcc A; attn_init(A);
    attn_run(A, ql, K, VT, 0xffull, 0.f, 0, [](int, int) { return true; }, [](int) { return true; }, lane);
    const float inv = attn_inv(A);
#pragma unroll
    for (int db = 0; db < 4; ++db) A.o[db] *= inv;
    if (r < nvalid) store_ot((bf16*)(a.ws + WS_CAT) + (size_t)row * D + TOK + hd * HD, A.o, h);
    LDS_WAIT(); asm volatile("" ::: "memory");
}

DI void memattn_wg(ArgsRef a, int layer, int item, LAS unsigned char* lds, int tid) {
    const int wave = __builtin_amdgcn_readfirstlane(tid >> 6), lane = tid & 63, r = lane & 31, h = lane >> 5;
    int bq, hd, row, nvalid; bool active;
    if (item < 256) { bq = item >> 5; hd = (item >> 3) & 3; const int tau = (item & 7) * 8 + wave; row = bq * TP + tau * 32 + r; nvalid = 32; active = true; }
    else { const int j = item - 256; const int bs = j >> 2; hd = j & 3; bq = 8 + bs; row = MPR + bs * 4 + (r < 4 ? r : 3); nvalid = 4; active = wave == 0; }
    const bf16* MEMQ = (const bf16*)(a.ws + WS_MEMQ);
    const bf16* K = (const bf16*)(a.ws + WS_MK) + ((size_t)((layer * 40 + bq) * 4 + hd)) * MEML * HD;
    const bf16* VT = (const bf16*)(a.ws + WS_MVT) + ((size_t)((layer * 40 + bq) * 4 + hd)) * HD * MEML;
    __syncthreads();
    { const u32x4* kc = (const u32x4*)K; const u32x4* vc = (const u32x4*)VT;
      u32x4 tk[8], tv[8];
#pragma unroll
      for (int j = 0; j < 8; ++j) { tk[j] = kc[j * NTHR + tid]; tv[j] = vc[j * NTHR + tid]; }
#pragma unroll
      for (int j = 0; j < 8; ++j) { ((LAS u32x4*)lds)[j * NTHR + tid] = tk[j]; ((LAS u32x4*)(lds + 65536))[j * NTHR + tid] = tv[j]; } }
    bf16x8 qf[8]; load_qf(qf, MEMQ + (size_t)row * MEMW + hd * HD, h);
    __syncthreads();
    if (active) {
        const LAS bf16x8* KL = (const LAS bf16x8*)lds + lane; const LAS bf16x8* VL = (const LAS bf16x8*)(lds + 65536) + lane;
        AttnAcc A; attn_init(A);
#pragma unroll 1
        for (int kt = 0; kt < 8; ++kt) {
            f32x16 s = zero16();
#pragma unroll
            for (int ks = 0; ks < 8; ++ks) s = MFMA32(KL[(kt * 8 + ks) * 64], qf[ks], s);
            float mt = -1e30f;
#pragma unroll
            for (int i = 0; i < 16; ++i) { s[i] *= SCALE2; mt = fmaxf(mt, s[i]); }
            mt = fmaxf(mt, __shfl_xor(mt, 32));
            float mn = A.m;
            if (__any(mt > A.m + 8.f)) { mn = fmaxf(A.m, mt); const float alpha = __builtin_amdgcn_exp2f(A.m - mn); A.m = mn; A.l *= alpha;
#pragma unroll
                for (int db = 0; db < 4; ++db) A.o[db] *= alpha; }
            float ls = 0.f;
#pragma unroll
            for (int i = 0; i < 16; ++i) { const float p = __builtin_amdgcn_exp2f(s[i] - mn); s[i] = p; ls += p; }
            A.l += ls;
#pragma unroll
            for (int st = 0; st < 2; ++st) { const bf16x8 pf = packp(s, st);
#pragma unroll
                for (int db = 0; db < 4; ++db) A.o[db] = MFMA32(VL[(kt * 8 + st * 4 + db) * 64], pf, A.o[db]); }
        }
        const float inv = attn_inv(A);
#pragma unroll
        for (int db = 0; db < 4; ++db) A.o[db] *= inv;
        if (r < nvalid) store_ot((bf16*)(a.ws + WS_CAT) + (size_t)row * D + TOK + hd * HD, A.o, h);
    }
    __syncthreads();
}

DI void cmp1_item(ArgsRef a, int it, int lane) {
    const int r = lane & 31, h = lane >> 5;
    const int kv = it >> 9, mt = (it >> 3) & 63, nt = it & 7;
    const bf16* Ap = (const bf16*)(a.ws + (kv ? WS_VCMP : WS_KCMP)) + (size_t)(32 * mt + r) * 2048 + 8 * h;
    const bf16* Bp = (const bf16*)(a.ws + WS_BTC) + (size_t)kv * 256 * 2048 + (size_t)(32 * nt + r) * 2048 + 8 * h;
    f32x16 c = zero16();
#pragma unroll 8
    for (int ks = 0; ks < 128; ++ks) { const bf16x8 af = *(const bf16x8*)(Ap + 16 * ks), bfr = *(const bf16x8*)(Bp + 16 * ks); c = MFMA32(af, bfr, c); }
    float* P = (float*)(a.ws + WS_PPP) + (size_t)kv * 2048 * 256;
#pragma unroll
    for (int i = 0; i < 16; ++i) P[(size_t)(32 * mt + crow(i, h)) * 256 + 32 * nt + r] = c[i];
}
DI void cmp2_item(ArgsRef a, int it, int lane) {
    const int r = lane & 31, h = lane >> 5;
    const bool prompt = it < 128; int kv, bg, blk, nI; const float* PP;
    if (prompt) { kv = it >> 6; bg = (it >> 2) & 15; blk = it & 3; nI = 128; PP = (const float*)(a.ws + WS_PPP) + (size_t)kv * 2048 * 256; }
    else { const int j = it - 128; kv = j >> 10; bg = (j >> 4) & 63; blk = j & 15; nI = 512; PP = (const float*)(a.ws + WS_PPS) + (size_t)kv * 32768 * 256; }
    const int irow = 32 * blk + r, ic = irow < nI - 1 ? irow : nI - 2;
    const float* p0r = PP + ((size_t)bg * nI + ic) * 256 + 8 * h; const float* p1r = p0r + 256 + 128; const float* c0r = (const float*)(a.ws + WS_PRE0) + kv * 128 + 8 * h;
    bf16x8 af[8];
#pragma unroll
    for (int ks = 0; ks < 8; ++ks) {
        const f32x4 x0 = *(const f32x4*)(p0r + 16 * ks), x1 = *(const f32x4*)(p0r + 16 * ks + 4), y0 = *(const f32x4*)(p1r + 16 * ks), y1 = *(const f32x4*)(p1r + 16 * ks + 4);
        const f32x4 z0 = *(const f32x4*)(c0r + 16 * ks), z1 = *(const f32x4*)(c0r + 16 * ks + 4);
        u32x4 w; w.x = pk2(gelu_t(x0[0] + y0[0] + z0[0]), gelu_t(x0[1] + y0[1] + z0[1])); w.y = pk2(gelu_t(x0[2] + y0[2] + z0[2]), gelu_t(x0[3] + y0[3] + z0[3]));
        w.z = pk2(gelu_t(x1[0] + y1[0] + z1[0]), gelu_t(x1[1] + y1[1] + z1[1])); w.w = pk2(gelu_t(x1[2] + y1[2] + z1[2]), gelu_t(x1[3] + y1[3] + z1[3]));
        af[ks] = __builtin_bit_cast(bf16x8, w);
    }
    const bf16* W2T = (const bf16*)(a.ws + WS_W2T) + (size_t)kv * 16384;
#pragma unroll
    for (int nb = 0; nb < 4; ++nb) {
        const bf16* bp = W2T + (size_t)(32 * nb + r) * 128 + 8 * h;
        f32x16 c = zero16();
#pragma unroll
        for (int ks = 0; ks < 8; ++ks) c = MFMA32(af[ks], *(const bf16x8*)(bp + 16 * ks), c);
        const int d = 32 * nb + r;
#pragma unroll
        for (int i = 0; i < 16; ++i) {
            const int ir = 32 * blk + crow(i, h);
            if (prompt) {
                const float v = ir < NCP ? c[i] : 0.f;
                if (kv == 0) ((bf16*)(a.ws + WS_KC))[(size_t)bg * 16384 + (size_t)(ir >> 5) * 4096 + kf_off(ir & 31, d)] = f2bf(v);
                else ((bf16*)(a.ws + WS_VCT))[(size_t)bg * 16384 + (size_t)(ir >> 5) * 4096 + vf_off(ir & 31, d)] = f2bf(v);
            } else if (ir < NCS) {
                ((float*)(a.ws + (kv ? WS_VCS : WS_KCS)))[((size_t)bg * 512 + ir) * 128 + d] = c[i];
            }
        }
    }
}
template <int KS, class FN>
DI void skinny_gemm(const FN& f, const bf16* A, const bf16* Bt, int N, int K, LAS unsigned char* lds, int bx, int G, int tid, int MT = 4, int orow0 = MPR) {
    constexpr int TPW = NWAVES / KS;
    const int wave = tid >> 6, lane = tid & 63, r = lane & 31, h = lane >> 5;
    const int ntiles = MT * (N >> 5), kw = K / KS, tl = wave / KS, ksub = wave % KS;
    LAS float* red = (LAS float*)lds;
    for (int step = bx; step * TPW < ntiles; step += G) {
        const int tile = step * TPW + tl, tcl = tile < ntiles ? tile : ntiles - 1, mt = tcl % MT, nt = tcl / MT;
        const bf16* Ap = A + (size_t)(32 * mt + r) * K + ksub * kw + 8 * h;
        const bf16* Bp = Bt + (size_t)(32 * nt + r) * K + ksub * kw + 8 * h;
        f32x16 c = zero16();
        for (int k0 = 0; k0 < (kw >> 4); k0 += 16) {
            bf16x8 af[16], bfr[16];
#pragma unroll
            for (int u = 0; u < 16; ++u) { const int ks = k0 + u < (kw >> 4) ? k0 + u : (kw >> 4) - 1; af[u] = *(const bf16x8*)(Ap + 16 * ks); bfr[u] = *(const bf16x8*)(Bp + 16 * ks); }
#pragma unroll
            for (int u = 0; u < 16; ++u) if (k0 + u < (kw >> 4)) c = MFMA32(af[u], bfr[u], c);
        }
        __syncthreads();
#pragma unroll
        for (int i = 0; i < 16; ++i) red[(wave * 16 + i) * 64 + lane] = c[i];
        __syncthreads();
        for (int q = tid; q < TPW * 128; q += NTHR) {
            const int tq = q >> 7, t7 = q & 127, tile2 = step * TPW + tq;
            if (tile2 < ntiles) {
                const int row = t7 >> 2, cg = (t7 & 3) * 8, hh = (row >> 2) & 1, ii = (row & 3) + 4 * (row >> 3);
                float v[8];
#pragma unroll
                for (int e = 0; e < 8; ++e) { float s = 0.f;
#pragma unroll
                    for (int w = 0; w < KS; ++w) s += red[((tq * KS + w) * 16 + ii) * 64 + cg + e + 32 * hh];
                    v[e] = s; }
                const int mt2 = tile2 % MT, nt2 = tile2 / MT;
                f(f.kind((32 * nt2) >> 8), orow0 + 32 * mt2 + row, 32 * nt2 + cg, (f32x4){v[0], v[1], v[2], v[3]}, (f32x4){v[4], v[5], v[6], v[7]});
            }
        }
    }
    __syncthreads();
}


DI void cmpgemm_direct(ArgsRef a, LAS unsigned char* lds, int item, int tid) {
    const int wave = __builtin_amdgcn_readfirstlane(tid >> 6), lane = tid & 63, r = lane & 31, h = lane >> 5;
    const int kv = item >> 7, blk = item & 127;
    const int R = blk * 256 + wave * 32 + r, b = R >> 10, g = (R >> 9) & 1, cc = R & 511;
    const int page = ((const int*)a.in[I_PT])[b * NPAGE + (cc >> 3)];
    const float* ab = a.in[I_CKV] + ((size_t)page * PAGE + (cc & 7) * 16) * 1024 + kv * 256 + g * 128 + 8 * h;
    const bf16* bs = (const bf16*)(a.ws + WS_BTC) + (size_t)kv * 256 * 2048 + (size_t)(32 * (tid >> 6) + r) * 2048 + 8 * h;
    f32x16 acc[8];
#pragma unroll
    for (int nb = 0; nb < 8; ++nb) acc[nb] = zero16();
    f32x4 ac[4][2], an[4][2]; u32x4 bn[4];
    auto lda = [&](f32x4 (&A)[4][2], int t) {
#pragma unroll
        for (int q = 0; q < 4; ++q) { const int k0 = 64 * t + 16 * q; const float* p = ab + (size_t)(k0 >> 7) * 1024 + (k0 & 127); A[q][0] = *(const f32x4*)p; A[q][1] = *(const f32x4*)(p + 4); }
    };
    auto ldb = [&](int t) {
#pragma unroll
        for (int q = 0; q < 4; ++q) bn[q] = *(const u32x4*)(bs + 64 * t + 16 * q);
    };
    auto stb = [&](int t) {
        LAS u32x4* B = (LAS u32x4*)(lds + (t & 1) * 32768);
#pragma unroll
        for (int q = 0; q < 4; ++q) B[(q * 8 + wave) * 64 + lane] = bn[q];
    };
    __syncthreads();
    lda(ac, 0); ldb(0); stb(0);
    TR_BAR();
    for (int t = 0; t < 32; ++t) {
        if (t + 1 < 32) { lda(an, t + 1); ldb(t + 1); }
        const LAS bf16x8* B = (const LAS bf16x8*)(lds + (t & 1) * 32768) + lane;
#pragma unroll
        for (int q = 0; q < 4; ++q) {
            u32x4 w; w.x = pk2(ac[q][0][0], ac[q][0][1]); w.y = pk2(ac[q][0][2], ac[q][0][3]); w.z = pk2(ac[q][1][0], ac[q][1][1]); w.w = pk2(ac[q][1][2], ac[q][1][3]);
            const bf16x8 af = __builtin_bit_cast(bf16x8, w);
#pragma unroll
            for (int nb = 0; nb < 8; ++nb) acc[nb] = MFMA32(af, B[(q * 8 + nb) * 64], acc[nb]);
        }
        if (t + 1 < 32) { stb(t + 1);
#pragma unroll
            for (int q = 0; q < 4; ++q) { ac[q][0] = an[q][0]; ac[q][1] = an[q][1]; } }
        TR_BAR();
    }
    float* P = (float*)(a.ws + WS_PPS) + (size_t)kv * 32768 * 256 + (size_t)(blk * 256 + wave * 32) * 256;
#pragma unroll
    for (int nb = 0; nb < 8; ++nb)
#pragma unroll
        for (int i = 0; i < 16; ++i) P[(size_t)crow(i, h) * 256 + 32 * nb + r] = acc[nb][i];
    __syncthreads();
}

DI void hgrn_sample_item(ArgsRef a, LAS unsigned char* lds, int bs, int hh, int tid) {
    const int wave = tid >> 6, lane = tid & 63, vloc = lane & 15, kg = lane >> 4, v = wave * 16 + vloc;
    const bf16* QA = (const bf16*)(a.ws + WS_QA); const float* FA = (const float*)(a.ws + WS_FA); const bf16* VA = (const bf16*)(a.ws + WS_VA);
    const float* s0 = a.in[I_HST] + ((size_t)(bs * NH + hh) * HD + kg * 32) * HD + v;
    float S[32];
#pragma unroll
    for (int i = 0; i < 32; ++i) S[i] = s0[(size_t)i * HD];
    LAS float* OS = (LAS float*)lds;
#pragma unroll 1
    for (int tp = 0; tp < TS; tp += 2) {
        u32x4 qw[2][4]; f32x4 fw[2][8]; float vv[2];
#pragma unroll
        for (int u = 0; u < 2; ++u) {
            const size_t ro = (size_t)(MPR + bs * TS + tp + u) * TOK + hh * HD;
#pragma unroll
            for (int j = 0; j < 4; ++j) qw[u][j] = *(const u32x4*)(QA + ro + kg * 32 + 8 * j);
#pragma unroll
            for (int j = 0; j < 8; ++j) fw[u][j] = *(const f32x4*)(FA + ro + kg * 32 + 4 * j);
            vv[u] = bf2f(VA[ro + v]);
        }
#pragma unroll
        for (int u = 0; u < 2; ++u) {
            float acc = 0.f;
#pragma unroll
            for (int j = 0; j < 8; ++j) {
                const unsigned w0 = qw[u][j >> 1][(j & 1) * 2], w1 = qw[u][j >> 1][(j & 1) * 2 + 1];
                const float q4[4] = {bflo(w0), bfhi(w0), bflo(w1), bfhi(w1)};
#pragma unroll
                for (int e = 0; e < 4; ++e) { const float f = fw[u][j][e]; const int i = 4 * j + e; S[i] = f * S[i] + (1.f - f) * vv[u]; acc += S[i] * q4[e]; }
            }
            acc += __shfl_xor(acc, 16); acc += __shfl_xor(acc, 32);
            if (kg == 0) OS[(tp + u) * HD + v] = acc;
        }
    }
    float* so = a.out + O_HS + ((size_t)(bs * NH + hh) * HD + kg * 32) * HD + v;
#pragma unroll
    for (int i = 0; i < 32; ++i) so[(size_t)i * HD] = S[i];
    __syncthreads();
    if (wave < TS) {
        const int row = MPR + bs * TS + wave;
        const f32x2 o = *(const LAS f32x2*)(OS + wave * HD + 2 * lane);
        const float rs = rsqrtf(wave_sum(o[0] * o[0] + o[1] * o[1]) * (1.f / HD) + EPS);
        const f32x2 gn = *(const f32x2*)(a.in[I_HGN] + hh * HD + 2 * lane);
        const unsigned og = *(const unsigned*)((const bf16*)(a.ws + WS_OGA) + (size_t)row * TOK + hh * HD + 2 * lane);
        *(unsigned*)((bf16*)(a.ws + WS_CAT) + (size_t)row * D + hh * HD + 2 * lane) = pk2(o[0] * rs * gn[0] * bflo(og), o[1] * rs * gn[1] * bfhi(og));
    }
    __syncthreads();
}

constexpr int HG_BUF = 33792;
constexpr int HG_SSQ = 3 * HG_BUF;
#define HG_BAR() asm volatile("s_waitcnt lgkmcnt(0)\n\ts_barrier" ::: "memory")
DI void hgrn_mfma_item(ArgsRef a, LAS unsigned char* lds, int bh, int tid) {
    const int wave = __builtin_amdgcn_readfirstlane(tid >> 6), lane = tid & 63, r = lane & 31, hh = lane >> 5;
    const int b = bh / NH, h = bh - b * NH;
    const size_t img = (size_t)bh * 64 * 4096;
    __syncthreads();
    if (wave >= 4) {
        const int lw = wave - 4;
        const bf16* src[4] = {(const bf16*)(a.ws + WS_QP) + img, (const bf16*)(a.ws + WS_KP) + img, (const bf16*)(a.ws + WS_KT) + img, (const bf16*)(a.ws + WS_VF) + img};
        const float* dvs = (const float*)(a.ws + WS_DV) + (size_t)bh * 64 * 256;
        u32x4 R0[9], R1[9];
        auto gl = [&](u32x4 (&R)[9], int c) {
            c = c < 64 ? c : 63;
#pragma unroll
            for (int j = 0; j < 8; ++j) R[j] = *(const u32x4*)(src[j >> 1] + (size_t)c * 4096 + (size_t)(((j & 1) * 256 + lw * 64 + lane) * 8));
            R[8] = *(const u32x4*)(dvs + (size_t)c * 256 + lane * 4);
        };
        auto lw_ = [&](const u32x4 (&R)[9], int c) {
            LAS unsigned char* bufp = lds + (c % 3) * HG_BUF;
#pragma unroll
            for (int j = 0; j < 8; ++j) *(LAS u32x4*)(bufp + (j >> 1) * 8192 + ((j & 1) * 256 + lw * 64 + lane) * 16) = R[j];
            if (lw == 0) *(LAS u32x4*)(bufp + 32768 + lane * 16) = R[8];
        };
        gl(R0, 0); gl(R1, 1);
        lw_(R0, 0); gl(R0, 2);
        HG_BAR();
        for (int c = 0; c < 64; c += 2) {
            lw_(R1, c + 1); gl(R1, c + 3);
            HG_BAR();
            if (c + 2 < 64) lw_(R0, c + 2);
            gl(R0, c + 4);
            HG_BAR();
        }
    } else {
        const int vb = wave;
        f32x16 S[4]; for (int kb = 0; kb < 4; ++kb) S[kb] = zero16();
        f32x16 Oprev = zero16(); u32x2 ogp[4] = {};
        float gn[16];
#pragma unroll
        for (int i = 0; i < 16; ++i) gn[i] = a.in[I_HGN][h * HD + 32 * vb + crow(i, hh)];
        LAS float* SSQ = (LAS float*)(lds + HG_SSQ);
        const bf16* OGA = (const bf16*)(a.ws + WS_OGA); bf16* CAT = (bf16*)(a.ws + WS_CAT);
        auto finish = [&](int cp) {
            const LAS float* sq = SSQ + (cp & 1) * 128;
            const float ss = (sq[r] + sq[32 + r]) + (sq[64 + r] + sq[96 + r]);
            const float rs = rsqrtf(ss * (1.f / HD) + EPS);
            bf16* orow = CAT + (size_t)(b * TP + cp * 32 + r) * D + h * HD + 32 * vb + 4 * hh;
#pragma unroll
            for (int c4 = 0; c4 < 4; ++c4) {
                const u32x2 g = ogp[c4];
                u32x2 w; w.x = pk2(Oprev[4 * c4] * rs * gn[4 * c4] * bflo(g.x), Oprev[4 * c4 + 1] * rs * gn[4 * c4 + 1] * bfhi(g.x));
                w.y = pk2(Oprev[4 * c4 + 2] * rs * gn[4 * c4 + 2] * bflo(g.y), Oprev[4 * c4 + 3] * rs * gn[4 * c4 + 3] * bfhi(g.y));
                *(u32x2*)(orow + 8 * c4) = w;
            }
        };
        HG_BAR();
        for (int c = 0; c < 64; ++c) {
            const LAS unsigned char* bufp = lds + (c % 3) * HG_BUF;
            const LAS bf16x8* QF = (const LAS bf16x8*)bufp + lane; const LAS bf16x8* KF = (const LAS bf16x8*)(bufp + 8192) + lane;
            const LAS bf16x8* TF = (const LAS bf16x8*)(bufp + 16384) + lane; const LAS bf16x8* VF = (const LAS bf16x8*)(bufp + 24576) + lane;
            const LAS float* dvec = (const LAS float*)(bufp + 32768);
            if (c > 0) finish(c - 1);
            { const bf16* ogr = OGA + (size_t)(b * TP + c * 32 + r) * TOK + h * HD + 32 * vb + 4 * hh;
#pragma unroll
              for (int c4 = 0; c4 < 4; ++c4) ogp[c4] = *(const u32x2*)(ogr + 8 * c4); }
            f32x16 X = zero16();
#pragma unroll
            for (int f = 0; f < 8; ++f) X = MFMA32(KF[f * 64], QF[f * 64], X);
#pragma unroll
            for (int i = 0; i < 16; ++i) X[i] = crow(i, hh) <= r ? X[i] : 0.f;
            const bf16x8 v0 = VF[(0 * 4 + vb) * 64], v1 = VF[(1 * 4 + vb) * 64];
            f32x16 O = zero16();
            O = MFMA32(v0, packp(X, 0), O); O = MFMA32(v1, packp(X, 1), O);
#pragma unroll
            for (int kb = 0; kb < 4; ++kb) {
                f32x16 T;
#pragma unroll
                for (int c4 = 0; c4 < 4; ++c4) { const f32x4 e1 = *(const LAS f32x4*)(dvec + 128 + 32 * kb + 8 * c4 + 4 * hh);
#pragma unroll
                    for (int e = 0; e < 4; ++e) T[4 * c4 + e] = S[kb][4 * c4 + e] * e1[e]; }
                O = MFMA32(packp(T, 0), QF[(kb * 2 + 0) * 64], O); O = MFMA32(packp(T, 1), QF[(kb * 2 + 1) * 64], O);
            }
            { float q = 0.f;
#pragma unroll
              for (int i = 0; i < 16; ++i) q += O[i] * O[i];
              q += __shfl_xor(q, 32);
              if (hh == 0) SSQ[(c & 1) * 128 + vb * 32 + r] = q; }
            Oprev = O;
#pragma unroll
            for (int kb = 0; kb < 4; ++kb) {
                f32x16 U = zero16();
                U = MFMA32(TF[(0 * 4 + kb) * 64], v0, U); U = MFMA32(TF[(1 * 4 + kb) * 64], v1, U);
#pragma unroll
                for (int c4 = 0; c4 < 4; ++c4) { const f32x4 dd = *(const LAS f32x4*)(dvec + 32 * kb + 8 * c4 + 4 * hh);
#pragma unroll
                    for (int e = 0; e < 4; ++e) S[kb][4 * c4 + e] = S[kb][4 * c4 + e] * dd[e] + U[4 * c4 + e]; }
            }
            HG_BAR();
        }
        finish(63);
        float* so = a.out + O_HP + (size_t)bh * HD * HD + 32 * vb + r;
#pragma unroll
        for (int kb = 0; kb < 4; ++kb)
#pragma unroll
            for (int i = 0; i < 16; ++i) so[(size_t)(32 * kb + crow(i, hh)) * HD] = S[kb][i];
    }
    __syncthreads();
}

template <bool FIRST, bool LAST>
DI void normpass(ArgsRef a, const float* gain, int gw, int ngw, int lane) {
    const bf16* OB = (const bf16*)(a.ws + WS_OB); bf16* H = (bf16*)(a.ws + WS_H); bf16* XN = (bf16*)(a.ws + WS_XN);
    f32x4 g4[8];
#pragma unroll
    for (int j = 0; j < 8; ++j) g4[j] = ((const f32x4*)gain)[lane + 64 * j];
    u32x2 ow[8], own[8]; f32x4 hf[8], hfn[8]; u32x2 hw[8], hwn[8];
    auto ldrow = [&](int m, u32x2 (&o_)[8], f32x4 (&hf_)[8], u32x2 (&hw_)[8]) {
        const u32x2* orow = (const u32x2*)(OB + (size_t)m * D) + lane;
#pragma unroll
        for (int j = 0; j < 8; ++j) o_[j] = orow[64 * j];
        if (FIRST) { const float* hrow = m < MPR ? a.in[I_XP] + (size_t)m * D : a.in[I_XS] + (size_t)(m - MPR) * D;
#pragma unroll
            for (int j = 0; j < 8; ++j) hf_[j] = ((const f32x4*)hrow)[lane + 64 * j]; }
        else { const u32x2* hrow = (const u32x2*)(H + (size_t)m * D) + lane;
#pragma unroll
            for (int j = 0; j < 8; ++j) hw_[j] = hrow[64 * j]; }
    };
    if (gw < MR) ldrow(gw, ow, hf, hw);
    for (int m = gw; m < MR; m += ngw) {
        if (m + ngw < MR) ldrow(m + ngw, own, hfn, hwn);
        f32x4 o[8], hv[8]; float ss = 0.f;
#pragma unroll
        for (int j = 0; j < 8; ++j) { hv[j] = FIRST ? hf[j] : (f32x4){bflo(hw[j].x), bfhi(hw[j].x), bflo(hw[j].y), bfhi(hw[j].y)};
            o[j] = (f32x4){bflo(ow[j].x), bfhi(ow[j].x), bflo(ow[j].y), bfhi(ow[j].y)};
            ss += (o[j][0] * o[j][0] + o[j][1] * o[j][1]) + (o[j][2] * o[j][2] + o[j][3] * o[j][3]); }
        const float rs = rsqrtf(wave_sum(ss) * (1.f / D) + EPS);
        float s2 = 0.f;
#pragma unroll
        for (int j = 0; j < 8; ++j) { hv[j] = hv[j] + o[j] * rs * g4[j]; s2 += (hv[j][0] * hv[j][0] + hv[j][1] * hv[j][1]) + (hv[j][2] * hv[j][2] + hv[j][3] * hv[j][3]); }
        if (LAST) {
            float* y = m < MPR ? a.out + O_YP + (size_t)m * D : a.out + O_YS + (size_t)(m - MPR) * D;
#pragma unroll
            for (int j = 0; j < 8; ++j) ((f32x4*)y)[lane + 64 * j] = hv[j];
        } else {
            const float r2 = rsqrtf(wave_sum(s2) * (1.f / D) + EPS);
            u32x2* xo = (u32x2*)(XN + (size_t)m * D) + lane;
#pragma unroll
            for (int j = 0; j < 8; ++j) { u32x2 hw; hw.x = pk2(hv[j][0], hv[j][1]); hw.y = pk2(hv[j][2], hv[j][3]); ((u32x2*)(H + (size_t)m * D))[lane + 64 * j] = hw;
                u32x2 w; w.x = pk2(hv[j][0] * r2, hv[j][1] * r2); w.y = pk2(hv[j][2] * r2, hv[j][3] * r2); xo[64 * j] = w; }
        }
#pragma unroll
        for (int j = 0; j < 8; ++j) { ow[j] = own[j]; if (FIRST) hf[j] = hfn[j]; else hw[j] = hwn[j]; }
    }
}

DI f32x4 cvlo(u32x4 w) { return (f32x4){bflo(w.x), bfhi(w.x), bflo(w.y), bfhi(w.y)}; }
DI f32x4 cvhi(u32x4 w) { return (f32x4){bflo(w.z), bfhi(w.z), bflo(w.w), bfhi(w.w)}; }
DI void ffn_fixup(ArgsRef a, int layer, int gtid, int nthr) {
    const float* FIX = (const float*)(a.ws + WS_FIX); const float* HALO = (const float*)(a.ws + WS_HALO); bf16* HID = (bf16*)(a.ws + WS_HID);
    const float* wc = a.in[I_WCONV] + (size_t)layer * 3 * FF; const float* bc = a.in[I_BCONV] + (size_t)layer * FF;
    constexpr int C8 = FF / 8;
    for (int it = gtid; it < 512 * C8; it += nthr) {
        const int ri = it / C8, c8 = (it - ri * C8) * 8, blk = ri >> 1, i = ri & 1, row = blk * 64 + i, t = row & (TP - 1);
        const float* fp = FIX + ((size_t)ri * 2) * FF + c8;
        f32x4 cl = *(const f32x4*)(bc + c8), ch = *(const f32x4*)(bc + c8 + 4);
        cl += *(const f32x4*)(wc + 2 * FF + c8) * *(const f32x4*)fp; ch += *(const f32x4*)(wc + 2 * FF + c8 + 4) * *(const f32x4*)(fp + 4);
        if (t >= 1) { const float* p1 = i == 0 ? HALO + ((size_t)((blk - 1) * 2 + 1)) * FF + c8 : FIX + ((size_t)(blk * 2) * 2) * FF + c8;
            cl += *(const f32x4*)(wc + FF + c8) * *(const f32x4*)p1; ch += *(const f32x4*)(wc + FF + c8 + 4) * *(const f32x4*)(p1 + 4); }
        if (t >= 2) { const float* p0 = HALO + ((size_t)((blk - 1) * 2 + i)) * FF + c8;
            cl += *(const f32x4*)(wc + c8) * *(const f32x4*)p0; ch += *(const f32x4*)(wc + c8 + 4) * *(const f32x4*)(p0 + 4); }
        const f32x4 gl = *(const f32x4*)(fp + FF), gh = *(const f32x4*)(fp + FF + 4);
#pragma unroll
        for (int e = 0; e < 4; ++e) { cl[e] = gelu_t(cl[e]) * gl[e]; ch[e] = gelu_t(ch[e]) * gh[e]; }
        *(u32x4*)(HID + (size_t)row * FF + c8) = pack8(cl, ch);
    }
}
DI void gating_pass(ArgsRef a, int layer, int gtid, int nthr) {
    const bf16* AB = (const bf16*)(a.ws + WS_AB); bf16* HID = (bf16*)(a.ws + WS_HID);
    const float* wc = a.in[I_WCONV] + (size_t)layer * 3 * FF; const float* bc = a.in[I_BCONV] + (size_t)layer * FF;
    constexpr int C8 = FF / 8;
    for (int it = gtid; it < MSR * C8; it += nthr) {
        const int row = MPR + it / C8, c8 = (it % C8) * 8;
        const bool prm = row < MPR; const int t = prm ? (row & (TP - 1)) : ((row - MPR) & 3);
        const bf16* ar = AB + (size_t)row * FF2 + c8;
        const u32x4 wa = *(const u32x4*)ar, wb = *(const u32x4*)(ar + FF);
        f32x4 e2l = cvlo(wa), e2h = cvhi(wa), e1l, e1h, e0l, e0h;
        const float* cb = prm ? nullptr : a.in[I_CCONV] + ((size_t)(layer * BS + ((row - MPR) >> 2)) * 2) * FF + c8;
        if (t >= 1) { const u32x4 w = *(const u32x4*)(ar - FF2); e1l = cvlo(w); e1h = cvhi(w); }
        else if (prm) { e1l = (f32x4){0.f, 0.f, 0.f, 0.f}; e1h = e1l; }
        else { e1l = *(const f32x4*)(cb + FF); e1h = *(const f32x4*)(cb + FF + 4); }
        if (t >= 2) { const u32x4 w = *(const u32x4*)(ar - 2 * FF2); e0l = cvlo(w); e0h = cvhi(w); }
        else if (prm) { e0l = (f32x4){0.f, 0.f, 0.f, 0.f}; e0h = e0l; }
        else { e0l = *(const f32x4*)(cb + (size_t)t * FF); e0h = *(const f32x4*)(cb + (size_t)t * FF + 4); }
        const f32x4 w0l = *(const f32x4*)(wc + c8), w0h = *(const f32x4*)(wc + c8 + 4), w1l = *(const f32x4*)(wc + FF + c8), w1h = *(const f32x4*)(wc + FF + c8 + 4);
        const f32x4 w2l = *(const f32x4*)(wc + 2 * FF + c8), w2h = *(const f32x4*)(wc + 2 * FF + c8 + 4), bl = *(const f32x4*)(bc + c8), bh = *(const f32x4*)(bc + c8 + 4);
        f32x4 cl = bl + w0l * e0l + w1l * e1l + w2l * e2l, ch = bh + w0h * e0h + w1h * e1h + w2h * e2h;
        const f32x4 gbl = cvlo(wb), gbh = cvhi(wb);
#pragma unroll
        for (int e = 0; e < 4; ++e) { cl[e] = gelu_t(cl[e]) * gbl[e]; ch[e] = gelu_t(ch[e]) * gbh[e]; }
        *(u32x4*)(HID + (size_t)row * FF + c8) = pack8(cl, ch);
    }
}

DI float alibi_slope2(int head) { return exp2f(-8.f * (float)(head + 1) / 12.f) * LOG2E; }

DI void nsa_cmp_wg(ArgsRef a, LAS unsigned char* lds, int p, int tid) {
    const int wave = __builtin_amdgcn_readfirstlane(tid >> 6), lane = tid & 63;
    const int r = lane & 31, h = lane >> 5;
    const int bg = p >> 3, jq = (p & 7) * 4 + (wave & 3), tau = wave < 4 ? 63 - jq : jq, ntile = (tau >> 4) + 1, b = bg >> 1, g = bg & 1, t0 = tau * 32, row = b * TP + t0 + r, qpos = t0 + r;
    const bf16* QB = (const bf16*)(a.ws + WS_QB); const float* GATES = (const float*)(a.ws + WS_GATES);
    bf16* OCMP = (bf16*)(a.ws + WS_OCMP);
    __syncthreads();
    { const u32x4* kc = (const u32x4*)((const bf16*)(a.ws + WS_KC) + (size_t)bg * 16384); const u32x4* vc = (const u32x4*)((const bf16*)(a.ws + WS_VCT) + (size_t)bg * 16384);
      u32x4 tk[4], tv[4];
#pragma unroll
      for (int j = 0; j < 4; ++j) { tk[j] = kc[j * NTHR + tid]; tv[j] = vc[j * NTHR + tid]; }
#pragma unroll
      for (int j = 0; j < 4; ++j) { ((LAS u32x4*)lds)[j * NTHR + tid] = tk[j]; ((LAS u32x4*)(lds + 32768))[j * NTHR + tid] = tv[j]; } }
    __syncthreads();
    const LAS bf16x8* KL = (const LAS bf16x8*)lds + lane; const LAS bf16x8* VL = (const LAS bf16x8*)(lds + 32768) + lane;
    LAS float* CL = (LAS float*)(lds + 65536 + wave * 8192);
    for (int u = ntile * 512 + lane; u < 2048; u += 64) CL[u] = 0.f;
    for (int hr = 0; hr < HPG; ++hr) {
        const int head = g * HPG + hr; const float slope2 = alibi_slope2(head);
        bf16x8 qf[8]; load_qf(qf, QB + (size_t)row * TOK + head * HD, h);
        float m = -1e30f, l = 0.f;
#pragma unroll 1
        for (int kt = 0; kt < ntile; ++kt) {
            f32x16 s = zero16();
#pragma unroll
            for (int ks = 0; ks < 8; ++ks) s = MFMA32(KL[(kt * 8 + ks) * 64], qf[ks], s);
            float mt = -1e30f;
#pragma unroll
            for (int i = 0; i < 16; ++i) {
                const int n = 32 * kt + crow(i, h), kp = 16 * n + 31;
                float v = s[i] * SCALE2 + slope2 * (float)(kp - t0);
                v = (n < NCP && kp <= qpos) ? v : -1e30f;
                s[i] = v; mt = fmaxf(mt, v);
            }
            mt = fmaxf(mt, __shfl_xor(mt, 32));
            const float mn = fmaxf(m, mt); float ls = 0.f;
#pragma unroll
            for (int i = 0; i < 16; ++i) ls += s[i] > -1e29f ? __builtin_amdgcn_exp2f(s[i] - mn) : 0.f;
            l = l * __builtin_amdgcn_exp2f(m - mn) + ls; m = mn;
        }
        l += __shfl_xor(l, 32);
        const float inv = l > 0.f ? 1.f / l : 0.f;
        f32x16 o[4];
#pragma unroll
        for (int db = 0; db < 4; ++db) o[db] = zero16();
#pragma unroll 1
        for (int kt = 0; kt < ntile; ++kt) {
            f32x16 s = zero16();
#pragma unroll
            for (int ks = 0; ks < 8; ++ks) s = MFMA32(KL[(kt * 8 + ks) * 64], qf[ks], s);
#pragma unroll
            for (int i = 0; i < 16; ++i) {
                const int n = 32 * kt + crow(i, h), kp = 16 * n + 31;
                const float v = s[i] * SCALE2 + slope2 * (float)(kp - t0);
                s[i] = (n < NCP && kp <= qpos) ? __builtin_amdgcn_exp2f(v - m) * inv : 0.f;
            }
#pragma unroll
            for (int c = 0; c < 4; ++c) {
                const float co = (s[4 * c] + s[4 * c + 1]) + (s[4 * c + 2] + s[4 * c + 3]), la = s[4 * c + 3];
                LAS float* cp = CL + ((kt * 4 + c) * 2) * 64 + lane;
                if (hr == 0) { cp[0] = co; cp[64] = la; } else { cp[0] += co; cp[64] += la; }
            }
#pragma unroll
            for (int st = 0; st < 2; ++st) { const bf16x8 pf = packp(s, st);
#pragma unroll
                for (int db = 0; db < 4; ++db) o[db] = MFMA32(VL[(kt * 8 + st * 4 + db) * 64], pf, o[db]); }
        }
        const float g0 = GATES[(size_t)row * 40 + head * 3 + 0];
#pragma unroll
        for (int db = 0; db < 4; ++db) o[db] *= g0;
        store_ot(OCMP + (size_t)row * TOK + head * HD, o, h);
    }
    LDS_WAIT(); asm volatile("" ::: "memory");
    float core[16], last[16];
#pragma unroll
    for (int idx = 0; idx < 16; ++idx) {
        core[idx] = CL[(idx * 2) * 64 + lane]; last[idx] = CL[(idx * 2 + 1) * 64 + lane];
    }
    LDS_WAIT(); asm volatile("" ::: "memory");
    const int cur = qpos >> 6;
    float sc[16], osc[16];
#pragma unroll
    for (int idx = 0; idx < 16; ++idx) {
        const float x = __shfl_xor(last[idx], 32);
        float xp = 0.f; if (idx > 0) xp = __shfl_xor(last[idx > 0 ? idx - 1 : 0], 32);
        const float prev = h ? x : xp;
        const int j = 2 * idx + h;
        const bool valid = j <= cur, forced = (j == 0) || (j == cur) || (j == cur - 1);
        sc[idx] = valid ? (core[idx] + prev) + (forced ? 1e4f : 0.f) : -1e30f;
    }
#pragma unroll
    for (int idx = 0; idx < 16; ++idx) osc[idx] = __shfl_xor(sc[idx], 32);
    unsigned mask = 0u;
#pragma unroll
    for (int idx = 0; idx < 16; ++idx) {
        const int j = 2 * idx + h; const float me = sc[idx]; int rank = 0;
#pragma unroll
        for (int k = 0; k < 16; ++k) {
            const int j1 = 2 * k + h, j2 = 2 * k + 1 - h;
            rank += (sc[k] > me || (sc[k] == me && j1 < j)) ? 1 : 0;
            rank += (osc[k] > me || (osc[k] == me && j2 < j)) ? 1 : 0;
        }
        if (rank < 16 && j <= cur) mask |= 1u << j;
    }
    mask |= __shfl_xor(mask, 32);
    if (h == 0) ((unsigned*)(a.ws + WS_SELM))[(size_t)row * 2 + g] = mask;
}

DI void nsa_selwin_item(ArgsRef a, int it, LAS float* stash, int lane) {
    const int r = lane & 31, h = lane >> 5;
    const int hr = it % HPG, bg = (it / HPG) & 15, tau = 63 - it / (HPG * 16);
    const int b = bg >> 1, g = bg & 1, head = g * HPG + hr, t0 = tau * 32, row = b * TP + t0 + r, qpos = t0 + r;
    const float slope2 = alibi_slope2(head);
    const bf16* QB = (const bf16*)(a.ws + WS_QB); const float* GATES = (const float*)(a.ws + WS_GATES);
    const size_t kvo = (size_t)bg * TP * HD;
    const bf16* KSEL = (const bf16*)(a.ws + WS_KSEL) + kvo; const bf16* VSELT = (const bf16*)(a.ws + WS_VSELT) + kvo;
    const bf16* KWIN = (const bf16*)(a.ws + WS_KWIN) + kvo; const bf16* VWINT = (const bf16*)(a.ws + WS_VWINT) + kvo;
    LAS bf16x8* ql = (LAS bf16x8*)(stash + 2048);
    { bf16x8 qf[8]; load_qf(qf, QB + (size_t)row * TOK + head * HD, h);
#pragma unroll
      for (int ks = 0; ks < 8; ++ks) ql[ks * 64 + lane] = qf[ks]; }
    LDS_WAIT(); asm volatile("" ::: "memory");
    LAS unsigned* stu = (LAS unsigned*)stash;
    const unsigned selm = ((const unsigned*)(a.ws + WS_SELM))[(size_t)row * 2 + g];
    unsigned um = selm;
#pragma unroll
    for (int o = 1; o < 64; o <<= 1) um |= __shfl_xor(um, o);
    um = __builtin_amdgcn_readfirstlane(um);
    unsigned long long x = um;
    x = (x | (x << 16)) & 0x0000FFFF0000FFFFull; x = (x | (x << 8)) & 0x00FF00FF00FF00FFull; x = (x | (x << 4)) & 0x0F0F0F0F0F0F0F0Full;
    x = (x | (x << 2)) & 0x3333333333333333ull; x = (x | (x << 1)) & 0x5555555555555555ull;
    const unsigned long long causal = tau >= 63 ? ~0ull : ((1ull << (tau + 1)) - 1ull);
    const unsigned long long tsel = (x | (x << 1)) & causal;
    const int wlo = tau > 16 ? tau - 16 : 0;
    const unsigned long long twin = causal & ~((1ull << wlo) - 1ull);
    {
        AttnAcc A; attn_init(A);
        attn_run(A, ql, KSEL, VSELT, tsel, slope2, t0, [&](int kt, int kvl) { return ((selm >> (kt >> 1)) & 1u) && (kt * 32 + kvl <= qpos); },
                 [&](int kt) { return kt < tau && __all((selm >> (kt >> 1)) & 1u); }, lane);
        const float g1 = GATES[(size_t)row * 40 + head * 3 + 1] * attn_inv(A);
#pragma unroll
        for (int db = 0; db < 4; ++db)
#pragma unroll
            for (int i = 0; i < 16; i += 2) stu[(db * 8 + (i >> 1)) * 64 + lane] = pk2(A.o[db][i] * g1, A.o[db][i + 1] * g1);
    }
    f32x16 out[4];
    {
        AttnAcc A; attn_init(A);
        attn_run(A, ql, KWIN, VWINT, twin, slope2, t0, [&](int kt, int kvl) { const int dist = qpos - (kt * 32 + kvl); return dist >= 0 && dist < 512; },
                 [&](int kt) { return kt < tau && kt > tau - 16; }, lane);
        const float g2 = GATES[(size_t)row * 40 + head * 3 + 2] * attn_inv(A);
        LDS_WAIT();
#pragma unroll
        for (int db = 0; db < 4; ++db)
#pragma unroll
            for (int i = 0; i < 16; i += 2) { const unsigned w = stu[(db * 8 + (i >> 1)) * 64 + lane]; out[db][i] = bflo(w) + A.o[db][i] * g2; out[db][i + 1] = bfhi(w) + A.o[db][i + 1] * g2; }
    }
    const bf16* oc = (const bf16*)(a.ws + WS_OCMP) + (size_t)row * TOK + head * HD;
    bf16* orow = (bf16*)(a.ws + WS_CAT) + (size_t)row * D + head * HD;
#pragma unroll
    for (int db = 0; db < 4; ++db)
#pragma unroll
        for (int c = 0; c < 4; ++c) {
            const int d = 32 * db + 8 * c + 4 * h;
            const u32x2 w = *(const u32x2*)(oc + d);
            u32x2 o; o.x = pk2(out[db][4 * c] + bflo(w.x), out[db][4 * c + 1] + bfhi(w.x)); o.y = pk2(out[db][4 * c + 2] + bflo(w.y), out[db][4 * c + 3] + bfhi(w.y));
            *(u32x2*)(orow + d) = o;
        }
}

constexpr int SCLD = 1040;
template <int NQ, class KP, class VP, class BF>
DI void wg_attend(LAS float* Qs, LAS float* SC, LAS float* RED, int nkeys, const KP& kptr, const VP& vptr, const BF& bias, int tid) {
    const int wave = tid >> 6, lane = tid & 63;
    {
        const int ks = tid >> 3, sub = tid & 7;
        for (int n0 = 0; n0 < nkeys; n0 += 128) {
            f32x4 k4[2][4]; int nn[2]; bool act[2];
#pragma unroll
            for (int u = 0; u < 2; ++u) { nn[u] = n0 + 64 * u + ks; act[u] = nn[u] < nkeys; const float* kp = kptr(act[u] ? nn[u] : nkeys - 1);
#pragma unroll
                for (int i = 0; i < 4; ++i) k4[u][i] = *(const f32x4*)(kp + 4 * sub + 32 * i); }
#pragma unroll
            for (int u = 0; u < 2; ++u) {
                float part[NQ];
#pragma unroll
                for (int j = 0; j < NQ; ++j) part[j] = 0.f;
#pragma unroll
                for (int i = 0; i < 4; ++i)
#pragma unroll
                    for (int j = 0; j < NQ; ++j) { const f32x4 q4 = *(const LAS f32x4*)(Qs + j * 128 + 4 * sub + 32 * i); part[j] += (k4[u][i][0] * q4[0] + k4[u][i][1] * q4[1]) + (k4[u][i][2] * q4[2] + k4[u][i][3] * q4[3]); }
#pragma unroll
                for (int j = 0; j < NQ; ++j) { float p = part[j]; p += __shfl_xor(p, 1); p += __shfl_xor(p, 2); p += __shfl_xor(p, 4);
                    if (sub == 0 && act[u]) { const float bb = bias(j, nn[u]); SC[j * SCLD + nn[u]] = bb > -1e29f ? p * SCALE2 + bb : -1e30f; } }
            }
        }
    }
    __syncthreads();
    for (int j = wave; j < NQ; j += NWAVES) {
        float m = -1e30f;
        for (int n = lane; n < nkeys; n += 64) m = fmaxf(m, SC[j * SCLD + n]);
        m = wave_max(m);
        float l = 0.f;
        for (int n = lane; n < nkeys; n += 64) { const float s = SC[j * SCLD + n]; const float p = s > -1e29f ? __builtin_amdgcn_exp2f(s - m) : 0.f; SC[j * SCLD + n] = p; l += p; }
        l = wave_sum(l);
        const float inv = l > 0.f ? 1.f / l : 0.f;
        for (int n = lane; n < nkeys; n += 64) SC[j * SCLD + n] *= inv;
    }
    __syncthreads();
    {
        const int part = tid >> 5, dq = tid & 31;
        f32x4 acc[NQ];
#pragma unroll
        for (int j = 0; j < NQ; ++j) acc[j] = (f32x4){0.f, 0.f, 0.f, 0.f};
        for (int n0 = part; n0 < nkeys; n0 += 128) {
            f32x4 v4[8];
#pragma unroll
            for (int u = 0; u < 8; ++u) { const int n = n0 + 16 * u; v4[u] = *(const f32x4*)(vptr(n < nkeys ? n : nkeys - 1) + 4 * dq); }
#pragma unroll
            for (int u = 0; u < 8; ++u) { const int n = n0 + 16 * u;
                if (n < nkeys) {
#pragma unroll
                    for (int j = 0; j < NQ; ++j) acc[j] += SC[j * SCLD + n] * v4[u]; } }
        }
#pragma unroll
        for (int j = 0; j < NQ; ++j) *(LAS f32x4*)(RED + ((part * NQ + j) * 128 + 4 * dq)) = acc[j];
    }
    __syncthreads();
    for (int o = tid; o < NQ * 128; o += NTHR) {
        float s = 0.f;
#pragma unroll
        for (int p = 1; p < 16; ++p) s += RED[p * NQ * 128 + o];
        RED[o] += s;
    }
    __syncthreads();
}
constexpr int SN_Q = 0, SN_SC = 768, SN_RED = SN_SC + 6 * SCLD, SN_IMP = SN_RED + 16 * 6 * 128, SN_PS = SN_IMP + 520, SN_IDX = SN_PS + 136;
static_assert((SN_IDX + 64) * 4 <= RING_BYTES, "sample NSA LDS map");

DI void sn_load_q(ArgsRef a, LAS float* Qs, int srow, int g, int tid) {
    const bf16* QB = (const bf16*)(a.ws + WS_QB) + (size_t)(MPR + srow) * TOK + g * HPG * HD;
    for (int o = tid; o < HPG * HD; o += NTHR) Qs[o] = bf2f(QB[o]);
}
DI void sn_cmp_item(ArgsRef a, LAS unsigned char* lds, int it, int tid) {
    const int b = it >> 3, g = (it >> 2) & 1, t = it & 3, srow = b * 4 + t, qpos = PAST + t;
    LAS float* L = (LAS float*)lds; LAS float* Qs = L + SN_Q; LAS float* SC = L + SN_SC; LAS float* RED = L + SN_RED; LAS float* IMP = L + SN_IMP; LAS float* PS = L + SN_PS;
    __syncthreads();
    sn_load_q(a, Qs, srow, g, tid);
    __syncthreads();
    const float* kc = (const float*)(a.ws + WS_KCS) + (size_t)(b * 2 + g) * 512 * 128; const float* vc = (const float*)(a.ws + WS_VCS) + (size_t)(b * 2 + g) * 512 * 128;
    wg_attend<HPG>(Qs, SC, RED, NCS, [&](int n) { return kc + (size_t)n * 128; }, [&](int n) { return vc + (size_t)n * 128; },
                   [&](int j, int n) { const int kp = 16 * n + 31; return kp <= qpos ? -alibi_slope2(g * HPG + j) * (float)(qpos - kp) : -1e30f; }, tid);
    const float* GATES = (const float*)(a.ws + WS_GATES) + (size_t)(MPR + srow) * 40;
    float* SOC = (float*)(a.ws + WS_SOC) + (size_t)srow * TOK + g * HPG * HD;
    for (int o = tid; o < HPG * HD; o += NTHR) SOC[o] = RED[o] * GATES[(g * HPG + (o >> 7)) * 3 + 0];
    for (int n = tid; n < 520; n += NTHR) { float s = 0.f; if (n < NCS) { for (int j = 0; j < HPG; ++j) s += SC[j * SCLD + n]; } IMP[n] = s; }
    __syncthreads();
    if (tid < NSS) { const int j = tid; float s = 0.f;
        for (int n = 4 * j - 1; n <= 4 * j + 3; ++n) if (n >= 0 && n < NCS) s += IMP[n];
        const bool forced = (j == 0) || (j == NSS - 1) || (j == NSS - 2);
        PS[j] = s + (forced ? 1e4f : 0.f); }
    __syncthreads();
    if (tid < NSS) { const float me = PS[tid]; int rank = 0;
        for (int k = 0; k < NSS; ++k) { const float o = PS[k]; rank += (o > me || (o == me && k < tid)) ? 1 : 0; }
        if (rank < 16) ((int*)(a.ws + WS_SIDX))[(size_t)(srow * 2 + g) * 16 + rank] = tid; }
}
DI void sn_selwin_item(ArgsRef a, LAS unsigned char* lds, int it, int tid) {
    const int b = it >> 3, g = (it >> 2) & 1, t = it & 3, srow = b * 4 + t, qpos = PAST + t;
    LAS float* L = (LAS float*)lds; LAS float* Qs = L + SN_Q; LAS float* SC = L + SN_SC; LAS float* RED = L + SN_RED; LAS int* IDX = (LAS int*)(L + SN_IDX);
    __syncthreads();
    sn_load_q(a, Qs, srow, g, tid);
    if (tid < 16) { const int blk = ((const int*)(a.ws + WS_SIDX))[(size_t)(srow * 2 + g) * 16 + tid]; IDX[tid] = blk;
        IDX[16 + tid] = blk < 128 ? ((const int*)a.in[I_PT])[b * NPAGE + (blk >> 1)] : 0; }
    __syncthreads();
    const float* ckv = a.in[I_CKV]; const float* nkv = a.out + O_KVS + (size_t)(b * 4) * 1024;
    auto selrow = [&](int n, int kind) -> const float* {
        const int sb = n >> 6, s = n & 63, blk = IDX[sb];
        if (blk < 128) return ckv + ((size_t)IDX[16 + sb] * PAGE + (blk & 1) * 64 + s) * 1024 + kind * 256 + g * 128;
        return nkv + (size_t)(s < 4 ? s : 3) * 1024 + kind * 256 + g * 128;
    };
    wg_attend<HPG>(Qs, SC, RED, 1024, [&](int n) { return selrow(n, 2); }, [&](int n) { return selrow(n, 3); },
                   [&](int j, int n) { const int kp = IDX[n >> 6] * 64 + (n & 63); return kp <= qpos ? -alibi_slope2(g * HPG + j) * (float)(qpos - kp) : -1e30f; }, tid);
    const float* GATES = (const float*)(a.ws + WS_GATES) + (size_t)(MPR + srow) * 40;
    float acc[2];
    { const float* SOC = (const float*)(a.ws + WS_SOC) + (size_t)srow * TOK + g * HPG * HD;
      for (int q = 0; q < 2; ++q) { const int o = tid + q * NTHR; acc[q] = o < HPG * HD ? SOC[o] + RED[o] * GATES[(g * HPG + (o >> 7)) * 3 + 1] : 0.f; } }
    __syncthreads();
    const float* cw = a.in[I_CWIN] + (size_t)b * 512 * 512; const float* nw = a.out + O_WS + (size_t)(b * 4) * 512;
    auto winrow = [&](int n, int kind) -> const float* { return n < 512 ? cw + (size_t)n * 512 + kind * 256 + g * 128 : nw + (size_t)(n - 512) * 512 + kind * 256 + g * 128; };
    wg_attend<HPG>(Qs, SC, RED, 516, [&](int n) { return winrow(n, 0); }, [&](int n) { return winrow(n, 1); },
                   [&](int j, int n) { const int dist = qpos - (PAST - 512 + n); return (dist >= 0 && dist < 512) ? -alibi_slope2(g * HPG + j) * (float)dist : -1e30f; }, tid);
    bf16* CAT = (bf16*)(a.ws + WS_CAT) + (size_t)(MPR + srow) * D + g * HPG * HD;
    for (int q = 0; q < 2; ++q) { const int o = tid + q * NTHR; if (o < HPG * HD) CAT[o] = f2bf(acc[q] + RED[o] * GATES[(g * HPG + (o >> 7)) * 3 + 2]); }
}

constexpr int SM_O = 0, SM_Q = RING_BYTES + 2048, SM_ML = SM_Q + 8192, SM_LIST = SM_ML + 2048, SM_MEMB = SM_LIST + 256, SM_UB = SM_MEMB + 544, SM_PG = SM_UB + 32;
static_assert(SM_PG + 256 <= LDS_BYTES && MISC_OFF + 256 <= RING_BYTES + 2048, "sample NSA (MFMA) LDS map");
DI void sn_selwin_mfma(ArgsRef a, LAS unsigned char* lds, int bg, int tid) {
    const int wave = __builtin_amdgcn_readfirstlane(tid >> 6), lane = tid & 63, r = lane & 31, h = lane >> 5;
    const int b = bg >> 1, g = bg & 1, t = r >> 3, js = r & 7, j = js < HPG ? js : HPG - 1, head = g * HPG + j, srow = b * 4 + t, qpos = PAST + t;
    LAS bf16x8* ql = (LAS bf16x8*)(lds + SM_Q); LAS int* LIST = (LAS int*)(lds + SM_LIST); LAS unsigned* MEMB = (LAS unsigned*)(lds + SM_MEMB); LAS unsigned* UB = (LAS unsigned*)(lds + SM_UB);
    LAS int* PG = (LAS int*)(lds + SM_PG); LAS float* ML = (LAS float*)(lds + SM_ML); LAS float* OB = (LAS float*)(lds + SM_O);
    __syncthreads();
    if (wave == 0) LIST[lane] = ((const int*)(a.ws + WS_SIDX))[(size_t)((b * 4 + (lane >> 4)) * 2 + g) * 16 + (lane & 15)];
    if (wave == 1) PG[lane] = ((const int*)a.in[I_PT])[b * NPAGE + lane];
    if (wave == 2) { bf16x8 qf[8]; load_qf(qf, (const bf16*)(a.ws + WS_QB) + (size_t)(MPR + srow) * TOK + head * HD, h);
#pragma unroll
        for (int ks = 0; ks < 8; ++ks) ql[ks * 64 + lane] = qf[ks]; }
    __syncthreads();
    if (tid < 136) { unsigned m = 0u; for (int e = 0; e < 64; ++e) m |= (LIST[e] == tid) ? (1u << (e >> 4)) : 0u; MEMB[tid] = m; }
    __syncthreads();
    if (tid < 8) { unsigned u = 0u; for (int e = 0; e < 32; ++e) { const int blk = 32 * tid + e; u |= (blk < 136 && MEMB[blk] != 0u) ? (1u << e) : 0u; } UB[tid] = u; }
    __syncthreads();
    const float slope2 = alibi_slope2(head);
    auto run_tile = [&](AttnAcc& A, const float* kb, const float* vb, int stride, int nvalid, int pos0, bool member, int maxdist) {
        asm volatile("" : "+s"(stride), "+s"(nvalid) :: "memory");
        {
            LAS unsigned* vl = (LAS unsigned*)(lds + wave * 16384);
            const float* vbl = vb + (unsigned)(h * stride + 4 * r);
            const int lastpair = (nvalid >> 1) - 1;
#pragma unroll
            for (int i = 0; i < 16; ++i) { const int i2 = i < lastpair ? i : lastpair;
                __builtin_amdgcn_global_load_lds((const unsigned*)(vbl + (size_t)(2 * i2 * stride)), vl + i * 256, 16, 0, 0); }
        }
        f32x16 s = zero16();
        { const int kr = r < nvalid ? r : nvalid - 1; const float* kp = kb + (unsigned)(kr * stride + 8 * h);
#pragma unroll
          for (int hk = 0; hk < 2; ++hk) {
              f32x4 kq[4][2];
#pragma unroll
              for (int ks = 0; ks < 4; ++ks) { kq[ks][0] = *(const f32x4*)(kp + 64 * hk + 16 * ks); kq[ks][1] = *(const f32x4*)(kp + 64 * hk + 16 * ks + 4); }
              bf16x8 kf[4];
#pragma unroll
              for (int ks = 0; ks < 4; ++ks) { u32x4 w; w.x = pk2(kq[ks][0][0], kq[ks][0][1]); w.y = pk2(kq[ks][0][2], kq[ks][0][3]); w.z = pk2(kq[ks][1][0], kq[ks][1][1]); w.w = pk2(kq[ks][1][2], kq[ks][1][3]);
                  kf[ks] = __builtin_bit_cast(bf16x8, w); }
              __builtin_amdgcn_sched_barrier(0);
#pragma unroll
              for (int ks = 0; ks < 4; ++ks) s = MFMA32(kf[ks], ql[(4 * hk + ks) * 64 + lane], s);
          } }
        float mt = -1e30f;
#pragma unroll
        for (int i = 0; i < 16; ++i) { const int key = crow(i, h), dist = qpos - (pos0 + key);
            float v = fmaf(s[i], SCALE2, -slope2 * (float)dist);
            v = (member && dist >= 0 && dist < maxdist && key < nvalid) ? v : -1e30f; s[i] = v; mt = fmaxf(mt, v); }
        mt = fmaxf(mt, __shfl_xor(mt, 32));
        float mn = A.m;
        if (__any(mt > A.m + 8.f)) { mn = fmaxf(A.m, mt); const float alpha = __builtin_amdgcn_exp2f(A.m - mn); A.m = mn; A.l *= alpha;
#pragma unroll
            for (int db = 0; db < 4; ++db) A.o[db] *= alpha; }
        float ls = 0.f;
#pragma unroll
        for (int i = 0; i < 16; ++i) { const float p = s[i] > -1e29f ? __builtin_amdgcn_exp2f(s[i] - mn) : 0.f; s[i] = p; ls += p; }
        A.l += ls;
        asm volatile("s_waitcnt vmcnt(0)" ::: "memory");
        { const LAS float* vr = (const LAS float*)(lds + wave * 16384) + 4 * h * 128 + r;
#pragma unroll
          for (int st = 0; st < 2; ++st) { const bf16x8 pf = packp(s, st);
#pragma unroll
            for (int db = 0; db < 4; ++db) { float x[8];
#pragma unroll
                for (int jj = 0; jj < 8; ++jj) x[jj] = vr[(16 * st + 8 * (jj >> 2) + (jj & 3)) * 128 + 32 * db];
                u32x4 w; w.x = pk2(x[0], x[1]); w.y = pk2(x[2], x[3]); w.z = pk2(x[4], x[5]); w.w = pk2(x[6], x[7]);
                A.o[db] = MFMA32(__builtin_bit_cast(bf16x8, w), pf, A.o[db]); } } }
        asm volatile("s_waitcnt lgkmcnt(0)" ::: "memory");
    };
    auto merge = [&](AttnAcc& A, float (&res)[8]) {
        __syncthreads();
        if (wave >= 4) { LAS float* o = OB + (wave - 4) * 4096 + lane; ML[(wave - 4) * 128 + lane] = A.m; ML[(wave - 4) * 128 + 64 + lane] = A.l;
#pragma unroll
            for (int db = 0; db < 4; ++db)
#pragma unroll
                for (int i = 0; i < 16; ++i) o[(db * 16 + i) * 64] = A.o[db][i]; }
        __syncthreads();
        if (wave < 4) { const LAS float* o = OB + wave * 4096 + lane; const float mb = ML[wave * 128 + lane], lb = ML[wave * 128 + 64 + lane];
            const float M = fmaxf(A.m, mb), sa = __builtin_amdgcn_exp2f(A.m - M), sb = __builtin_amdgcn_exp2f(mb - M);
            A.m = M; A.l = A.l * sa + lb * sb;
#pragma unroll
            for (int db = 0; db < 4; ++db)
#pragma unroll
                for (int i = 0; i < 16; ++i) A.o[db][i] = A.o[db][i] * sa + o[(db * 16 + i) * 64] * sb; }
        __syncthreads();
        if (wave < 4) { LAS float* o = OB + wave * 4096 + lane; ML[wave * 128 + lane] = A.m; ML[wave * 128 + 64 + lane] = A.l;
#pragma unroll
            for (int db = 0; db < 4; ++db)
#pragma unroll
                for (int i = 0; i < 16; ++i) o[(db * 16 + i) * 64] = A.o[db][i]; }
        __syncthreads();
        { float M = -1e30f, sc[4], L = 0.f;
#pragma unroll
          for (int w2 = 0; w2 < 4; ++w2) M = fmaxf(M, ML[w2 * 128 + lane]);
#pragma unroll
          for (int w2 = 0; w2 < 4; ++w2) { sc[w2] = __builtin_amdgcn_exp2f(ML[w2 * 128 + lane] - M); L += ML[w2 * 128 + 64 + lane] * sc[w2]; }
          L += __shfl_xor(L, 32);
          const float inv = L > 0.f ? 1.f / L : 0.f;
          const int base = ((wave >> 1) * 16 + 8 * (wave & 1)) * 64 + lane;
#pragma unroll
          for (int e = 0; e < 8; ++e) { float o = 0.f;
#pragma unroll
              for (int w2 = 0; w2 < 4; ++w2) o += OB[w2 * 4096 + base + e * 64] * sc[w2];
              res[e] = o * inv; } }
        __syncthreads();
    };
    {
        AttnAcc A; attn_init(A);
        const float* ckv = a.in[I_CKV]; const float* nkv = a.out + O_KVS + (size_t)(b * 4) * 1024 + 512 + g * 128;
        int cnt = 0;
        for (int w5 = 0; w5 < 5; ++w5) {
            unsigned bits = __builtin_amdgcn_readfirstlane(UB[w5]);
            while (bits) {
                const int blk = 32 * w5 + __builtin_ctz(bits); bits &= bits - 1u;
                const bool member = (MEMB[blk] >> t) & 1u;
                const int page = __builtin_amdgcn_readfirstlane(PG[blk < 128 ? blk >> 1 : 0]);
                const int nt = blk < 128 ? 2 : 1;
#pragma unroll 1
                for (int hf = 0; hf < nt; ++hf, ++cnt) if ((cnt & 7) == wave) {
                    const float* kb = blk < 128 ? ckv + ((size_t)page * PAGE + (blk & 1) * 64 + hf * 32) * 1024 + 512 + g * 128 : nkv;
                    run_tile(A, kb, kb + 256, 1024, blk < 128 ? 32 : 4, blk * 64 + hf * 32, member, 1 << 30);
                }
            }
        }
        float rsel[8];
        merge(A, rsel);
        if (js < HPG) {
            const float g1 = ((const float*)(a.ws + WS_GATES))[(size_t)(MPR + srow) * 40 + head * 3 + 1];
            float* soc = (float*)(a.ws + WS_SOC) + (size_t)srow * TOK + head * HD + 32 * (wave >> 1) + 16 * (wave & 1) + 4 * h;
#pragma unroll
            for (int q = 0; q < 2; ++q) { f32x4 c = *(const f32x4*)(soc + 8 * q);
#pragma unroll
                for (int e = 0; e < 4; ++e) c[e] += rsel[4 * q + e] * g1;
                *(f32x4*)(soc + 8 * q) = c; }
        }
    }
    {
        float rwin[8];
        AttnAcc A; attn_init(A);
        const float* cw = a.in[I_CWIN] + (size_t)b * 512 * 512 + g * 128; const float* nw = a.out + O_WS + (size_t)(b * 4) * 512 + g * 128;
#pragma unroll 1
        for (int wt = 7 - wave; wt < 17; wt += 8) {
            const float* kb = wt < 16 ? cw + (size_t)(32 * wt) * 512 : nw;
            run_tile(A, kb, kb + 256, 512, wt < 16 ? 32 : 4, PAST - 512 + 32 * wt, true, 512);
        }
        merge(A, rwin);
        if (js < HPG) {
            const float* GATES = (const float*)(a.ws + WS_GATES) + (size_t)(MPR + srow) * 40 + head * 3;
            const float g2 = GATES[2];
            const int d0 = 32 * (wave >> 1) + 16 * (wave & 1) + 4 * h;
            const float* soc = (const float*)(a.ws + WS_SOC) + (size_t)srow * TOK + head * HD + d0;
            bf16* cat = (bf16*)(a.ws + WS_CAT) + (size_t)(MPR + srow) * D + head * HD + d0;
#pragma unroll
            for (int q = 0; q < 2; ++q) { const f32x4 c = *(const f32x4*)(soc + 8 * q);
                u32x2 w; w.x = pk2(c[0] + rwin[4 * q] * g2, c[1] + rwin[4 * q + 1] * g2);
                w.y = pk2(c[2] + rwin[4 * q + 2] * g2, c[3] + rwin[4 * q + 3] * g2);
                *(u32x2*)(cat + 8 * q) = w; }
        }
    }
    __syncthreads();
}

constexpr int CW_Q13 = 4000;
constexpr int CW_BAR = 4096;
static_assert((CW_BAR + XCD_BAR_WORDS) * 4 <= (int)CTL_BYTES, "control block");

#define GEMM_CALL(FN, fnobj, Aoff, Boff, Mrows, Ncols, Kdim, cperm) do { \
    pg8::Gemm g_{(const pg8::bf16_t*)(a.ws + (Aoff)), (const pg8::bf16_t*)(a.ws + (Boff)), (Mrows), (Ncols), (Kdim)}; \
    pg8::StaticOrder S_; S_.init((Mrows), (Ncols), G, (cperm)); \
    EpiFn<FN> E_{fnobj}; \
    pg8::gemm_phase<EpiFn<FN>, pg8::StaticOrder, true, true>(lds, g_, S_, E_); } while (0)

__global__ void __launch_bounds__(NTHR, 2) yoco_fwd(Args a_) {
    extern __shared__ __attribute__((aligned(16))) unsigned char lds_raw[];
    LAS unsigned char* lds = (LAS unsigned char*)lds_raw;
    const int tid0 = threadIdx.x, wave0 = __builtin_amdgcn_readfirstlane(tid0 >> 6);
    const int G = gridDim.x, bx = blockIdx.x, ngw = G * NWAVES;
    volatile LAS unsigned* MISC = (volatile LAS unsigned*)(lds + MISC_OFF);
    for (int u = tid0; u < (LDS_BYTES - RING_BYTES) / 4; u += NTHR) ((LAS unsigned*)(lds + RING_BYTES))[u] = 0u;
    __syncthreads();
    XcdBarrier bar = xcd_barrier_post((unsigned*)(a_.ws + WS_CTL) + CW_BAR, MISC + 8);
#define PH ArgsRef a = *phase_args(); float* out = a.out; (void)out; int tid = tid0, wave = wave0; asm volatile("" : "+v"(tid)); asm volatile("" : "+s"(wave)); const int lane = tid & 63, gw = bx * NWAVES + wave; (void)lane; (void)gw;

    { PH wg_transpose_run(a, lds, bx, TL_A0 + (TL_END - TL_LATE1), G, [](int t) { return t < TL_A0 ? t : t - TL_A0 + TL_LATE1; }, tid); }
    { PH p0_prologue(a, lds, gw, ngw, wave, lane); }
    xcd_barrier(bar);
    { PH for (int it = bx; it < 256; it += G) cmpgemm_direct(a, lds, it, tid); }

    { PH
        FnA fa{(bf16*)(a.ws + WS_QA), (float*)(a.ws + WS_FA), (bf16*)(a.ws + WS_VA), (bf16*)(a.ws + WS_OGA), (bf16*)(a.ws + WS_MEMQ), (const float*)(a.ws + WS_LB)};
        EpiA ea{(bf16*)(a.ws + WS_QP), (bf16*)(a.ws + WS_KP), (bf16*)(a.ws + WS_KT), (bf16*)(a.ws + WS_VF), (float*)(a.ws + WS_DV), (bf16*)(a.ws + WS_OGA), (bf16*)(a.ws + WS_MEMQ), (const float*)(a.ws + WS_LB), fa};
        { pg8::Gemm g_{(const pg8::bf16_t*)(a.ws + WS_XN), (const pg8::bf16_t*)(a.ws + WS_BTA), MPAD, NA, 2048};
          pg8::StaticOrder S_; S_.init(MPAD, NA, G, bx);
          pg8::gemm_phase<EpiA, pg8::StaticOrder, true, true>(lds, g_, S_, ea); }
    }
    { PH
        FnM fm{out, (bf16*)(a.ws + WS_MK), (bf16*)(a.ws + WS_MVT)};
        GEMM_CALL(FnM, fm, WS_MEMPB, WS_BTM, 2048, 2048, 2048, (bx + 64) % G);
    }
    xcd_barrier(bar);

    { PH
        const bool split = G > 96;
        if (!split || bx < 96) { for (int k = bx; k < BP * NH; k += (split ? 96 : G)) hgrn_mfma_item(a, lds, k, tid); }
        if (!split || bx >= 96) {
            const int w2 = split ? bx - 96 : bx, nw = split ? G - 96 : G;
            for (int k = w2; k < BS * NH; k += nw) hgrn_sample_item(a, lds, k / NH, k % NH, tid);
            for (int it = w2; it < 256 + BS * MEMH; it += nw) memattn_wg(a, 0, it, lds, tid);
        }
    }
    __syncthreads();
    { PH
        constexpr int NREC = TL_LATE0 + 288;
        auto idm = [](int t) { return t; };
        if (G > 96) { if (bx < 96) wg_transpose_run(a, lds, TL_LATE0 + bx, NREC, 96, idm, tid);
                      else wg_transpose_run(a, lds, NREC + (bx - 96), TL_LATE1, G - 96, idm, tid); }
        else wg_transpose_run(a, lds, TL_LATE0 + bx, TL_LATE1, G, idm, tid);
    }
    xcd_barrier(bar);

    { PH FnO fo{(bf16*)(a.ws + WS_OB), D}; GEMM_CALL(FnO, fo, WS_CAT, WS_BTO0, MPR, D, 2048, bx);
      skinny_gemm<8>(fo, (const bf16*)(a.ws + WS_CAT) + (size_t)MPR * 2048, (const bf16*)(a.ws + WS_BTO0), D, 2048, lds, bx, G, tid); }
    xcd_barrier(bar);
    { PH normpass<true, false>(a, a.in[I_NG] + 1 * D, gw, ngw, lane); }
    xcd_barrier(bar);
    { PH EpiF1 ef{(bf16*)(a.ws + WS_HID), (float*)(a.ws + WS_FIX), (float*)(a.ws + WS_HALO), out, a.in[I_WCONV] + (size_t)0 * 3 * FF, a.in[I_BCONV] + (size_t)0 * FF, 0};
      { pg8::Gemm g_{(const pg8::bf16_t*)(a.ws + WS_XN), (const pg8::bf16_t*)(a.ws + WS_BTF10), MPR, FF2, 2048}; pg8::StaticOrder S_; S_.init(MPR, FF2, G, bx);
        pg8::gemm_phase<EpiF1, pg8::StaticOrder, true, true>(lds, g_, S_, ef); }
      FnF1 ff{(bf16*)(a.ws + WS_AB), out, 0};
      skinny_gemm<8>(ff, (const bf16*)(a.ws + WS_XN) + (size_t)MPR * 2048, (const bf16*)(a.ws + WS_BTF10), FF2, 2048, lds, bx, G, tid); }
    xcd_barrier(bar);
    { PH ffn_fixup(a, 0, bx * NTHR + tid, G * NTHR); gating_pass(a, 0, bx * NTHR + tid, G * NTHR); }
    xcd_barrier(bar);
    { PH FnO fo{(bf16*)(a.ws + WS_OB), D}; GEMM_CALL(FnO, fo, WS_HID, WS_BTF20, MPR, D, FF, bx);
      skinny_gemm<8>(fo, (const bf16*)(a.ws + WS_HID) + (size_t)MPR * FF, (const bf16*)(a.ws + WS_BTF20), D, FF, lds, bx, G, tid); }
    xcd_barrier(bar);
    { PH normpass<false, false>(a, a.in[I_NG] + 3 * D, gw, ngw, lane); }
    xcd_barrier(bar);

    { PH
        FnB fb{(bf16*)(a.ws + WS_QB), (bf16*)(a.ws + WS_MEMQ), (float*)(a.ws + WS_GATES), out, (bf16*)(a.ws + WS_KCMP), (bf16*)(a.ws + WS_VCMP),
               (bf16*)(a.ws + WS_KSEL), (bf16*)(a.ws + WS_VSELT), (bf16*)(a.ws + WS_KWIN), (bf16*)(a.ws + WS_VWINT)};
        GEMM_CALL(FnB, fb, WS_XN, WS_BTB, MPAD, NBM, 2048, bx);
    }
    xcd_barrier(bar);

    { PH FnC fk{(float*)(a.ws + WS_PPP), 256};
      skinny_gemm<8>(fk, (const bf16*)(a.ws + WS_KCMP), (const bf16*)(a.ws + WS_BTC), 256, 2048, lds, bx, G, tid, 64, 0); }
    { PH FnC fv{(float*)(a.ws + WS_PPP) + (size_t)2048 * 256, 256};
      skinny_gemm<8>(fv, (const bf16*)(a.ws + WS_VCMP), (const bf16*)(a.ws + WS_BTC) + (size_t)256 * 2048, 256, 2048, lds, (bx + G / 2) % G, G, tid, 64, 0); }
    { PH for (int it = bx; it < 256 + (G == 256 ? 0 : BS * MEMH); it += G) memattn_wg(a, 1, it, lds, tid); }
    { PH for (int it = 128 + gw; it < 128 + 2048; it += ngw) cmp2_item(a, it, lane); }
    xcd_barrier(bar);
    { PH for (int it = gw; it < 128; it += ngw) cmp2_item(a, it, lane); }
    { PH if (G == 256 && bx >= 128) memattn_wg(a, 1, 256 + (bx - 128), lds, tid); }
    xcd_barrier(bar);
    { PH for (int w = bx; w < 128; w += G) nsa_cmp_wg(a, lds, w, tid); }
    { PH for (int w = (bx + G - 128 % G) % G; w < 128; w += G) { sn_cmp_item(a, lds, 2 * w, tid); sn_cmp_item(a, lds, 2 * w + 1, tid); } }
    xcd_barrier(bar);
    { PH for (int it = bx; it < BS * 2; it += G) sn_selwin_mfma(a, lds, it, tid); }
    __syncthreads();
    { PH
        LAS unsigned* TK = (LAS unsigned*)(lds + RING_BYTES + 1024);
        unsigned* qctr = (unsigned*)(a.ws + WS_CTL) + CW_Q13;
        int grp = bx, par = 0;
        while (grp < 6144 / NWAVES) {
            unsigned nx = 0u;
            if (tid == 0) nx = atomicAdd(qctr, 1u);
            nsa_selwin_item(a, grp * NWAVES + wave, (LAS float*)(lds + wave * 16384), lane);
            if (tid == 0) TK[par] = nx;
            __syncthreads();
            grp = G + (int)TK[par]; par ^= 1;
        }
    }
    xcd_barrier(bar);

    { PH FnO fo{(bf16*)(a.ws + WS_OB), D}; GEMM_CALL(FnO, fo, WS_CAT, WS_BTO1, MPR, D, 2048, bx);
      skinny_gemm<8>(fo, (const bf16*)(a.ws + WS_CAT) + (size_t)MPR * 2048, (const bf16*)(a.ws + WS_BTO1), D, 2048, lds, bx, G, tid); }
    xcd_barrier(bar);
    { PH normpass<false, false>(a, a.in[I_NG] + 5 * D, gw, ngw, lane); }
    xcd_barrier(bar);
    { PH EpiF1 ef{(bf16*)(a.ws + WS_HID), (float*)(a.ws + WS_FIX), (float*)(a.ws + WS_HALO), out, a.in[I_WCONV] + (size_t)1 * 3 * FF, a.in[I_BCONV] + (size_t)1 * FF, 1};
      { pg8::Gemm g_{(const pg8::bf16_t*)(a.ws + WS_XN), (const pg8::bf16_t*)(a.ws + WS_BTF11), MPR, FF2, 2048}; pg8::StaticOrder S_; S_.init(MPR, FF2, G, bx);
        pg8::gemm_phase<EpiF1, pg8::StaticOrder, true, true>(lds, g_, S_, ef); }
      FnF1 ff{(bf16*)(a.ws + WS_AB), out, 1};
      skinny_gemm<8>(ff, (const bf16*)(a.ws + WS_XN) + (size_t)MPR * 2048, (const bf16*)(a.ws + WS_BTF11), FF2, 2048, lds, bx, G, tid); }
    xcd_barrier(bar);
    { PH ffn_fixup(a, 1, bx * NTHR + tid, G * NTHR); gating_pass(a, 1, bx * NTHR + tid, G * NTHR); }
    xcd_barrier(bar);
    { PH FnO fo{(bf16*)(a.ws + WS_OB), D}; GEMM_CALL(FnO, fo, WS_HID, WS_BTF21, MPR, D, FF, bx);
      skinny_gemm<8>(fo, (const bf16*)(a.ws + WS_HID) + (size_t)MPR * FF, (const bf16*)(a.ws + WS_BTF21), D, FF, lds, bx, G, tid); }
    xcd_barrier(bar);
    { PH normpass<false, true>(a, a.in[I_NG] + 7 * D, gw, ngw, lane); }
}

extern "C" void kernel_launch(void* const* d_in, const int* in_sizes, int n_in, void* d_out, int out_size, void* d_ws, size_t ws_size, hipStream_t stream) {
    static int grid = 0;
    if (grid == 0) {
        if (n_in != 25 || out_size != (int)O_END || ws_size < WS_END) { fprintf(stderr, "kernel_launch: unexpected shapes (n_in %d out %d ws %zu, need ws %zu)\n", n_in, out_size, ws_size, (size_t)WS_END); grid = -1; return; }
        int dev = 0, cus = 0, per_cu = 0;
        if (hipGetDevice(&dev) != hipSuccess || hipDeviceGetAttribute(&cus, hipDeviceAttributeMultiprocessorCount, dev) != hipSuccess) { grid = -1; return; }
        if (hipFuncSetAttribute((const void*)yoco_fwd, hipFuncAttributeMaxDynamicSharedMemorySize, LDS_BYTES) != hipSuccess) { fprintf(stderr, "kernel_launch: hipFuncSetAttribute failed\n"); grid = -1; return; }
        if (hipOccupancyMaxActiveBlocksPerMultiprocessor(&per_cu, (const void*)yoco_fwd, NTHR, LDS_BYTES) != hipSuccess || per_cu < 1)
            fprintf(stderr, "kernel_launch: note: occupancy query reports %d workgroups per CU\n", per_cu);
        (void)hipGetLastError();
        grid = cus;
    }
    if (grid < 0) return;
    if (hipMemsetAsync((char*)d_ws + WS_CTL + (size_t)CW_Q13 * 4, 0, (size_t)(CW_BAR - CW_Q13 + XCD_BAR_WORDS) * 4, stream) != hipSuccess) { fprintf(stderr, "kernel_launch: memset failed\n"); return; }
    Args a{};
    for (int i = 0; i < 25; ++i) a.in[i] = (const float*)d_in[i];
    a.out = (float*)d_out; a.ws = (unsigned char*)d_ws;
    hipLaunchKernelGGL(yoco_fwd, dim3(grid), dim3(NTHR), LDS_BYTES, stream, a);
    const hipError_t le = hipPeekAtLastError();
    if (le != hipSuccess) fprintf(stderr, "kernel_launch: launch failed: %s\n", hipGetErrorName(le));
}
```

```cpp
#include <hip/hip_runtime.h>
#include <cstdio>
#include <cstdint>

#define DI __device__ __forceinline__
#define GAS __attribute__((address_space(1)))
#define LAS __attribute__((address_space(3)))
typedef unsigned short bf16;
typedef short bf16x8 __attribute__((ext_vector_type(8)));
typedef short s16x4 __attribute__((ext_vector_type(4)));
typedef float f32x2 __attribute__((ext_vector_type(2)));
typedef float f32x4 __attribute__((ext_vector_type(4)));
typedef float f32x16 __attribute__((ext_vector_type(16)));
typedef unsigned u32x2 __attribute__((ext_vector_type(2)));
typedef unsigned u32x4 __attribute__((ext_vector_type(4)));
typedef __bf16 hbf2 __attribute__((ext_vector_type(2)));

constexpr int D = 2048, BP = 8, TP = 2048, BS = 32, TS = 4, PAST = 8192, PAGE = 128, NPAGE = PAST / PAGE;
constexpr int MPR = BP * TP;
constexpr int MSR = BS * TS;
constexpr int MR = MPR + MSR;
constexpr int MPAD = 16640;
constexpr int TOK = 1536, MEMW = 512, HD = 128, NH = 12, GB = 2, HPG = 6, MEMH = 4, MEML = 256;
constexpr int NA = 4 * TOK + MEMW;
constexpr int NBM = 3840;
constexpr int FF = 5632, FF2 = 2 * FF;
constexpr int NCP = 127, NCS = 511, NSP = 32, NSS = 129;
constexpr float EPS = 1e-6f;
constexpr float LOG2E = 1.4426950408889634f;
constexpr float SCALE2 = 0.08838834764831845f * LOG2E;

constexpr size_t O_YP = 0;
constexpr size_t O_YS = O_YP + (size_t)MPR * D;
constexpr size_t O_HP = O_YS + (size_t)MSR * D;
constexpr size_t O_HS = O_HP + (size_t)BP * NH * HD * HD;
constexpr size_t O_CP = O_HS + (size_t)BS * NH * HD * HD;
constexpr size_t O_CS = O_CP + (size_t)2 * BP * 2 * FF;
constexpr size_t O_MP = O_CS + (size_t)2 * BS * 2 * FF;
constexpr size_t O_KVP = O_MP + (size_t)2 * BP * MEML * 1024;
constexpr size_t O_KVS = O_KVP + (size_t)MPR * 1024;
constexpr size_t O_WP = O_KVS + (size_t)MSR * 1024;
constexpr size_t O_WS = O_WP + (size_t)BP * 512 * 512;
constexpr size_t O_END = O_WS + (size_t)MSR * 512;
static_assert(O_END == 65847296, "d_out size");

constexpr size_t alup(size_t x) { return (x + 4095) & ~(size_t)4095; }
constexpr size_t WS_CTL = 0, CTL_BYTES = 1u << 20;
constexpr size_t WS_BTA = CTL_BYTES;
constexpr size_t WS_BTO0 = WS_BTA + alup((size_t)NA * D * 2);
constexpr size_t WS_BTO1 = WS_BTO0 + alup((size_t)D * D * 2);
constexpr size_t WS_BTF10 = WS_BTO1 + alup((size_t)D * D * 2);
constexpr size_t WS_BTF11 = WS_BTF10 + alup((size_t)FF2 * D * 2);
constexpr size_t WS_BTF20 = WS_BTF11 + alup((size_t)FF2 * D * 2);
constexpr size_t WS_BTF21 = WS_BTF20 + alup((size_t)D * FF * 2);
constexpr size_t WS_BTB = WS_BTF21 + alup((size_t)D * FF * 2);
constexpr size_t WS_BTM = WS_BTB + alup((size_t)NBM * D * 2);
constexpr size_t WS_BTC = WS_BTM + alup((size_t)D * D * 2);
constexpr size_t WS_LB = WS_BTC + alup((size_t)2 * 256 * 2048 * 2);
constexpr size_t WS_PRE0 = WS_LB + alup(1536 * 4);
constexpr size_t WS_XN = WS_PRE0 + alup(256 * 4);
constexpr size_t WS_MEMPB = WS_XN + alup((size_t)MPAD * D * 2);
constexpr size_t WS_QA = WS_MEMPB + alup((size_t)2048 * D * 2);
constexpr size_t WS_FA = WS_QA + alup((size_t)MPAD * TOK * 2);
constexpr size_t WS_VA = WS_FA + alup((size_t)MPAD * TOK * 4);
constexpr size_t WS_OGA = WS_VA + alup((size_t)MPAD * TOK * 2);
constexpr size_t WS_MEMQ = WS_OGA + alup((size_t)MPAD * TOK * 2);
constexpr size_t WS_ORAW = WS_MEMQ + alup((size_t)MPAD * MEMW * 2);
constexpr size_t WS_CAT = WS_ORAW + alup((size_t)MPAD * TOK * 4);
constexpr size_t WS_OB = WS_CAT + alup((size_t)MPAD * D * 2);
constexpr size_t WS_H = WS_OB + alup((size_t)MPAD * D * 2);
constexpr size_t WS_AB = WS_H + alup((size_t)MPAD * D * 4);
constexpr size_t WS_HID = WS_AB + alup((size_t)MPAD * FF2 * 2);
constexpr size_t WS_QB = WS_HID + alup((size_t)MPAD * FF * 2);
constexpr size_t WS_GATES = WS_QB + alup((size_t)MPAD * TOK * 2);
constexpr size_t KVB = (size_t)BP * GB * TP * HD * 2;
constexpr size_t WS_KCMP = WS_GATES + alup((size_t)MPAD * 40 * 4);
constexpr size_t WS_VCMP = WS_KCMP + alup(KVB);
constexpr size_t WS_KSEL = WS_VCMP + alup(KVB);
constexpr size_t WS_VSELT = WS_KSEL + alup(KVB);
constexpr size_t WS_KWIN = WS_VSELT + alup(KVB);
constexpr size_t WS_VWINT = WS_KWIN + alup(KVB);
constexpr size_t WS_CAK = WS_VWINT + alup(KVB);
constexpr size_t WS_CAV = WS_CAK + alup((size_t)32768 * 2048 * 2);
constexpr size_t WS_PPP = WS_CAV + alup((size_t)32768 * 2048 * 2);
constexpr size_t WS_PPS = WS_PPP + alup((size_t)2 * 2048 * 256 * 4);
constexpr size_t WS_KC = WS_PPS + alup((size_t)2 * 32768 * 256 * 4);
constexpr size_t WS_VCT = WS_KC + alup((size_t)16 * 128 * 128 * 2);
constexpr size_t WS_KCS = WS_VCT + alup((size_t)16 * 128 * 128 * 2);
constexpr size_t WS_VCS = WS_KCS + alup((size_t)64 * 512 * 128 * 4);
constexpr size_t WS_MK = WS_VCS + alup((size_t)64 * 512 * 128 * 4);
constexpr size_t WS_MVT = WS_MK + alup((size_t)2 * 40 * 4 * 256 * 128 * 2);
constexpr size_t WS_OCMP = WS_MVT + alup((size_t)2 * 40 * 4 * 256 * 128 * 2);
constexpr size_t WS_SELM = WS_OCMP + alup((size_t)MPAD * TOK * 2);
constexpr size_t WS_SOC = WS_SELM + alup((size_t)MPR * 2 * 4);
constexpr size_t WS_SIDX = WS_SOC + alup((size_t)MSR * TOK * 4);
constexpr size_t WS_DV = WS_SIDX + alup((size_t)MSR * 2 * 16 * 4);
constexpr size_t WS_FIX = WS_DV + alup((size_t)96 * 64 * 256 * 4);
constexpr size_t WS_HALO = WS_FIX + alup((size_t)256 * 2 * 2 * FF * 4);
constexpr size_t WS_W2T = WS_HALO + alup((size_t)256 * 2 * FF * 4);
constexpr size_t WS_END = WS_W2T + alup((size_t)2 * 128 * 128 * 2);
constexpr size_t WS_QP = WS_QA, WS_KP = WS_FA, WS_KT = WS_FA + (size_t)MPR * TOK * 2, WS_VF = WS_VA;

constexpr int NWAVES = 8, NTHR = 512;
constexpr int LDS_BYTES = 147456;
constexpr int RING_BYTES = 131072;
constexpr int MISC_OFF = RING_BYTES + 320;

DI unsigned pk2(float lo, float hi) { hbf2 v = __builtin_convertvector((f32x2){lo, hi}, hbf2); return __builtin_bit_cast(unsigned, v); }
DI bf16 f2bf(float f) { return (bf16)(pk2(f, 0.f) & 0xffffu); }
DI float bf2f(bf16 v) { return __uint_as_float((unsigned)v << 16); }
DI float bflo(unsigned w) { return __uint_as_float(w << 16); }
DI float bfhi(unsigned w) { return __uint_as_float(w & 0xffff0000u); }
DI float sigm(float x) { return __builtin_amdgcn_rcpf(1.f + __builtin_amdgcn_exp2f(-LOG2E * x)); }
DI float gelu_t(float x) { const float z = 1.5957691216f * (x + 0.044715f * x * x * x); return x * sigm(z); }
DI float wave_sum(float v) {
#pragma unroll
    for (int o = 1; o < 64; o <<= 1) v += __shfl_xor(v, o);
    return v;
}
DI float wave_max(float v) {
#pragma unroll
    for (int o = 1; o < 64; o <<= 1) v = fmaxf(v, __shfl_xor(v, o));
    return v;
}
#define LDS_WAIT() asm volatile("s_waitcnt lgkmcnt(0)" ::: "memory")
#define VM_WAIT() asm volatile("s_waitcnt vmcnt(0)" ::: "memory")
DI int kf_off(int r, int d) { return (((d >> 4) * 64 + r + 32 * ((d >> 3) & 1)) << 3) + (d & 7); }
DI int vf_off(int kvl, int d) { return ((((kvl >> 4) * 4 + (d >> 5)) * 64 + (d & 31) + 32 * ((kvl >> 2) & 1)) << 3) + ((((kvl >> 3) & 1) << 2) | (kvl & 3)); }
namespace pg8 {
#define PG8_LAS __attribute__((address_space(3)))
typedef unsigned short bf16_t;
typedef short bf16x8 __attribute__((ext_vector_type(8)));
typedef float f32x4 __attribute__((ext_vector_type(4)));
typedef unsigned u32x4 __attribute__((ext_vector_type(4)));
constexpr int BM = 256, BK = 64, HALF = 128, HTB = HALF * BK * 2  , STAGE_BYTES = 8 * HTB, NXCD = 8, WGM = 8;

__host__ __device__ __forceinline__ int lds_byte(int r, int c) { const int st = (r >> 4) * 2 + (c >> 5), rr = r & 15, cc = c & 31, ob = rr * 64 + cc * 2; return st * 1024 + (ob ^ (((ob >> 9) & 1) << 5)); }
__host__ __device__ __forceinline__ void stage_rc(int b, int& R, int& C) { const int st = b / 1024, sb = b % 1024, swz = sb ^ (((sb >> 9) & 1) << 5); R = (st >> 1) * 16 + swz / 64; C = (st & 1) * 32 + (swz % 64) / 2; }
__host__ __device__ __forceinline__ int perm32(int rho) { const int n = rho >> 4, i = rho & 15; return 8 * (i >> 2) + 4 * n + (i & 3); }

struct Unit { int pm, pn; };
struct Gemm { const bf16_t* A; const bf16_t* Bt; int M, N, K; };

struct StaticOrder {
    int nM, nN, nwg, G, c;
    __host__ __device__ void init(int M, int N, int G_, int c_) { nM = M / BM; nN = N / BM; nwg = nM * nN; G = G_; c = c_; }
    __host__ __device__ __forceinline__ bool next(int i, Unit& u) const {
        const long L = (long)i * G + c; if (L >= nwg) return false;
        int wgid = (int)L; { const int q = nwg / NXCD, r = nwg % NXCD, xcd = wgid % NXCD, off = wgid / NXCD; wgid = (xcd < r ? xcd * (q + 1) : r * (q + 1) + (xcd - r) * q) + off; }
        const int nig = WGM * nN, gid = wgid / nig, fm = gid * WGM, gsz = (nM - fm) < WGM ? (nM - fm) : WGM;
        u.pm = fm + ((wgid % nig) % gsz); u.pn = (wgid % nig) / gsz; return true;
    }
    __device__ __forceinline__ void a_ready(const Unit&) const {}
    __device__ __forceinline__ void done(const Unit&) const {}
};

template <class Epi, class Sched, bool ALIGN_EPI = false, bool SP2 = false>
__device__ __forceinline__ void gemm_phase(PG8_LAS unsigned char* lds, const Gemm g, const Sched& S, const Epi& E) {
    const int tid = threadIdx.x, wid = __builtin_amdgcn_readfirstlane(tid >> 6), lane = tid & 63, wr = wid >> 2, wc = wid & 3, fr = lane & 15, fq = lane >> 4;
    const int K = g.K, nt = K / BK;
    unsigned voffA[2], voffB[2];
#pragma unroll
    for (int i = 0; i < 2; ++i) { int R, C; stage_rc(tid * 16 + i * 8192, R, C); const int Rb = Epi::PERM ? ((R & ~31) + perm32(R & 31)) : R;
        voffA[i] = (unsigned)(R * K + C) * 2u; voffB[i] = (unsigned)(Rb * K + C) * 2u; }
    const size_t kstep = (size_t)(BK * 2);
    const size_t hstep = (size_t)HALF * K * 2;
    const size_t tstep = 2 * hstep;
    const unsigned ldsw = (unsigned)wid * 1024u;
    const int aoff = lds_byte(wr * 64 + fr, fq * 8), boff = lds_byte(wc * 32 + fr, fq * 8);
#define PG8_SA(b, h) (((b) * 2 + (h)) * HTB)
#define PG8_SB(b, h) ((4 + (b) * 2 + (h)) * HTB)
#define PG8_STAGE(bufoff, gbase, voff) do { _Pragma("unroll") for (int _i = 0; _i < 2; ++_i) \
        __builtin_amdgcn_global_load_lds((const unsigned*)((const char*)(gbase) + (voff)[_i]), (PG8_LAS unsigned*)(lds + (bufoff) + ldsw + _i * 8192), 16, 0, 0); } while (0)
#define PG8_LDA(dst, b, h) do { _Pragma("unroll") for (int m = 0; m < 4; ++m) _Pragma("unroll") for (int k = 0; k < 2; ++k) dst[m][k] = *(const PG8_LAS bf16x8*)(lds + PG8_SA(b, h) + aoff + m * 2048 + k * 1024); } while (0)
#define PG8_LDB(dst, b, h) do { _Pragma("unroll") for (int n = 0; n < 2; ++n) _Pragma("unroll") for (int k = 0; k < 2; ++k) dst[n][k] = *(const PG8_LAS bf16x8*)(lds + PG8_SB(b, h) + boff + n * 2048 + k * 1024); } while (0)
#define PG8_MMA(ai, bj, At, Bt) do { __builtin_amdgcn_s_setprio(1); _Pragma("unroll") for (int m = 0; m < 4; ++m) _Pragma("unroll") for (int n = 0; n < 2; ++n) _Pragma("unroll") for (int k = 0; k < 2; ++k) \
        acc[ai][bj][m][n] = __builtin_amdgcn_mfma_f32_16x16x32_bf16(Bt[n][k], At[m][k], acc[ai][bj][m][n], 0, 0, 0); __builtin_amdgcn_s_setprio(0); } while (0)
#define PG8_WAIT_V(n) asm volatile("s_waitcnt vmcnt(" #n ")" ::: "memory")
#define PG8_WAIT_L(n) asm volatile("s_waitcnt lgkmcnt(" #n ")" ::: "memory")
#define PG8_BAR __builtin_amdgcn_s_barrier()
#define PG8_SCHED __builtin_amdgcn_sched_barrier(0)
    Unit cur, nxt; int ui = 0;
    if (!S.next(0, cur)) return;
    f32x4 acc[2][2][4][2];
#pragma unroll
    for (int a = 0; a < 2; ++a)
#pragma unroll
        for (int b = 0; b < 2; ++b)
#pragma unroll
            for (int m = 0; m < 4; ++m)
#pragma unroll
                for (int n = 0; n < 2; ++n) acc[a][b][m][n] = (f32x4){0.f, 0.f, 0.f, 0.f};
    bf16x8 At[4][2], B0[2][2], B1[2][2];
    const char* cA = (const char*)g.A + (size_t)cur.pm * tstep; const char* cB = (const char*)g.Bt + (size_t)cur.pn * tstep;
    S.a_ready(cur);
    if constexpr (SP2) {
        PG8_STAGE(PG8_SB(0, 0), cB, voffB); PG8_STAGE(PG8_SB(0, 1), cB + hstep, voffB); PG8_STAGE(PG8_SA(0, 0), cA, voffA); PG8_STAGE(PG8_SA(0, 1), cA + hstep, voffA);
        if (wr == 1) PG8_BAR;
        PG8_WAIT_V(2); PG8_BAR;
        PG8_STAGE(PG8_SB(1, 0), cB + kstep, voffB); PG8_STAGE(PG8_SA(1, 0), cA + kstep, voffA); PG8_STAGE(PG8_SB(1, 1), cB + hstep + kstep, voffB);
        PG8_WAIT_V(6); PG8_BAR;
    } else {
        PG8_STAGE(PG8_SB(0, 0), cB, voffB); PG8_STAGE(PG8_SA(0, 0), cA, voffA); PG8_STAGE(PG8_SB(0, 1), cB + hstep, voffB); PG8_STAGE(PG8_SA(0, 1), cA + hstep, voffA);
        if (wr == 1) PG8_BAR;
        PG8_WAIT_V(4); PG8_BAR;
        PG8_STAGE(PG8_SB(1, 0), cB + kstep, voffB); PG8_STAGE(PG8_SA(1, 0), cA + kstep, voffA); PG8_STAGE(PG8_SB(1, 1), cB + hstep + kstep, voffB);
        PG8_WAIT_V(6); PG8_BAR;
    }
    for (;;) {
        const bool has_next = S.next(ui + 1, nxt);
        const char* nA = has_next ? (const char*)g.A + (size_t)nxt.pm * tstep : cA; const char* nB = has_next ? (const char*)g.Bt + (size_t)nxt.pn * tstep : cB;
        for (int t = 0; t < nt; t += 2) {
            const bool last = (t == nt - 2);
            const char* a1 = cA + (size_t)(t + 1) * kstep;
            const char* a2 = last ? nA : cA + (size_t)(t + 2) * kstep; const char* b2 = last ? nB : cB + (size_t)(t + 2) * kstep;
            const char* a3 = a2 + kstep; const char* b3 = b2 + kstep;
            if (last && has_next) S.a_ready(nxt);
            if constexpr (SP2) {
            PG8_LDB(B0, 0, 0); PG8_LDB(B1, 0, 1); PG8_SCHED; PG8_LDA(At, 0, 0); PG8_STAGE(PG8_SA(1, 1), a1 + hstep, voffA);
            PG8_WAIT_V(8); PG8_WAIT_L(0); PG8_BAR; PG8_MMA(0, 0, At, B0); PG8_MMA(0, 1, At, B1); PG8_BAR; PG8_SCHED;
            PG8_LDA(At, 0, 1); PG8_STAGE(PG8_SB(0, 0), b2, voffB); PG8_STAGE(PG8_SB(0, 1), b2 + hstep, voffB); PG8_STAGE(PG8_SA(0, 0), a2, voffA);
            PG8_WAIT_V(8); PG8_WAIT_L(0); PG8_BAR; PG8_MMA(1, 0, At, B0); PG8_MMA(1, 1, At, B1); PG8_BAR; PG8_SCHED;
            PG8_LDB(B0, 1, 0); PG8_LDB(B1, 1, 1); PG8_SCHED; PG8_LDA(At, 1, 0); PG8_STAGE(PG8_SA(0, 1), a2 + hstep, voffA);
            PG8_WAIT_V(8); PG8_WAIT_L(0); PG8_BAR; PG8_MMA(0, 0, At, B0); PG8_MMA(0, 1, At, B1); PG8_BAR; PG8_SCHED;
            PG8_LDA(At, 1, 1); PG8_STAGE(PG8_SB(1, 0), b3, voffB); PG8_STAGE(PG8_SB(1, 1), b3 + hstep, voffB); PG8_STAGE(PG8_SA(1, 0), a3, voffA);
            PG8_WAIT_V(8); PG8_WAIT_L(0); PG8_BAR; PG8_MMA(1, 0, At, B0); PG8_MMA(1, 1, At, B1); PG8_BAR; PG8_SCHED;
            } else {
            PG8_LDB(B0, 0, 0); PG8_SCHED; PG8_LDA(At, 0, 0); PG8_STAGE(PG8_SA(1, 1), a1 + hstep, voffA);
            PG8_WAIT_L(8); PG8_BAR; PG8_WAIT_L(0); PG8_MMA(0, 0, At, B0); PG8_BAR; PG8_SCHED;
            PG8_LDB(B1, 0, 1); PG8_STAGE(PG8_SB(0, 0), b2, voffB);
            PG8_BAR; PG8_WAIT_L(0); PG8_MMA(0, 1, At, B1); PG8_BAR;
            PG8_LDA(At, 0, 1); PG8_STAGE(PG8_SA(0, 0), a2, voffA);
            PG8_BAR; PG8_WAIT_L(0); PG8_MMA(1, 0, At, B0); PG8_BAR; PG8_SCHED;
            PG8_STAGE(PG8_SB(0, 1), b2 + hstep, voffB);
            PG8_WAIT_V(6); PG8_BAR; PG8_MMA(1, 1, At, B1); PG8_BAR;
            PG8_LDB(B0, 1, 0); PG8_SCHED; PG8_LDA(At, 1, 0); PG8_STAGE(PG8_SA(0, 1), a2 + hstep, voffA);
            PG8_WAIT_L(8); PG8_BAR; PG8_WAIT_L(0); PG8_MMA(0, 0, At, B0); PG8_BAR; PG8_SCHED;
            PG8_LDB(B1, 1, 1); PG8_STAGE(PG8_SB(1, 0), b3, voffB);
            PG8_BAR; PG8_WAIT_L(0); PG8_MMA(0, 1, At, B1); PG8_BAR;
            PG8_LDA(At, 1, 1); PG8_STAGE(PG8_SA(1, 0), a3, voffA);
            PG8_BAR; PG8_WAIT_L(0); PG8_MMA(1, 0, At, B0); PG8_BAR; PG8_SCHED;
            PG8_STAGE(PG8_SB(1, 1), b3 + hstep, voffB);
            PG8_WAIT_V(6); PG8_BAR; PG8_MMA(1, 1, At, B1); PG8_BAR;
            }
        }
        if constexpr (ALIGN_EPI) { if (wr == 0) PG8_BAR; }
        if constexpr (!Epi::AFTER_DRAIN) { E(acc, cur, wr, wc, fr, fq); S.done(cur); }
        if (!has_next) break;
#pragma unroll
        for (int a = 0; a < 2; ++a)
#pragma unroll
            for (int b = 0; b < 2; ++b)
#pragma unroll
                for (int m = 0; m < 4; ++m)
#pragma unroll
                    for (int n = 0; n < 2; ++n) acc[a][b][m][n] = (f32x4){0.f, 0.f, 0.f, 0.f};
        cur = nxt; cA = nA; cB = nB; ++ui;
        if constexpr (ALIGN_EPI) { if (wr == 1) PG8_BAR; }
    }
    PG8_WAIT_V(0);
    if constexpr (!ALIGN_EPI) { if (wr == 0) PG8_BAR; }
    PG8_BAR;
    if constexpr (Epi::AFTER_DRAIN) { E.fused(acc, cur, wr, wc, fr, fq, lds, wid, lane); S.done(cur); }
#undef PG8_SA
#undef PG8_SB
#undef PG8_STAGE
#undef PG8_LDA
#undef PG8_LDB
#undef PG8_MMA
#undef PG8_WAIT_V
#undef PG8_WAIT_L
#undef PG8_BAR
#undef PG8_SCHED
}
}
#define XB_TMO      128
#define XB_XCNT(j)  (256  + 64 * (j))
#define XB_XSUB(j)  (1280 + 64 * (j))
#define XB_XGEN(j)  (2304 + 64 * (j))
#define XB_TOP      3328
#define XB_TOPGEN   3392
#define XCD_BAR_WORDS 3456
#define XB_SPIN_CAP (1u << 18)

__device__ __forceinline__ unsigned xb_ld(unsigned* p)              { return __hip_atomic_load(p, __ATOMIC_RELAXED, __HIP_MEMORY_SCOPE_AGENT); }
__device__ __forceinline__ unsigned xb_add(unsigned* p, unsigned v) { return __hip_atomic_fetch_add(p, v, __ATOMIC_RELAXED, __HIP_MEMORY_SCOPE_AGENT); }
__device__ __forceinline__ unsigned xb_xcc_id() { return (unsigned)__builtin_amdgcn_s_getreg((3 << 11) | 20) & 0xFu; }
#define XB_SPIN(cond, bar) do { unsigned _sp = 0; while (cond) { __builtin_amdgcn_s_sleep(1); \
    if ((++_sp & 255u) == 0u) { if (xb_ld(&(bar)[XB_TMO])) break; if (_sp > XB_SPIN_CAP) { atomicAdd(&(bar)[XB_TMO], 1u); break; } } } } while (0)

struct XcdBarrier {
    unsigned* bar; unsigned x;
    volatile LAS unsigned* st;
};

__device__ __forceinline__ XcdBarrier xcd_barrier_post(unsigned* bar, volatile LAS unsigned* st) {
    XcdBarrier b; b.bar = bar; b.x = xb_xcc_id(); b.st = st;
    if (threadIdx.x == 0) (void)xb_add(&bar[XB_XCNT(b.x)], 1u);
    return b;
}
__device__ __forceinline__ void xcd_barrier_complete(unsigned* bar, unsigned x, unsigned& nloc, unsigned& nx) {
    const unsigned G = gridDim.x * gridDim.y * gridDim.z;
    unsigned sum, cnt, mine, sp = 0u;
    for (;;) {
        sum = 0u; cnt = 0u; mine = 0u;
#pragma unroll
        for (unsigned j = 0; j < 16; ++j) { const unsigned c = xb_ld(&bar[XB_XCNT(j)]); sum += c; cnt += (c > 0u) ? 1u : 0u; mine = (j == x) ? c : mine; }
        if (sum == G) break;
        __builtin_amdgcn_s_sleep(1);
        if ((++sp & 255u) == 0u) { if (xb_ld(&bar[XB_TMO])) break; if (sp > XB_SPIN_CAP) { atomicAdd(&bar[XB_TMO], 1u); break; } }
    }
    nloc = mine > 0u ? mine : 1u; nx = cnt > 0u ? cnt : 1u;
}

__device__ __forceinline__ void xcd_barrier(const XcdBarrier& b) {
    asm volatile("s_waitcnt vmcnt(0)" ::: "memory");
    __syncthreads();
    if (threadIdx.x == 0) {
        unsigned* bar = b.bar;
        __builtin_amdgcn_s_waitcnt(0);
        unsigned nloc = b.st[0], nx = b.st[1];
        if (nloc == 0u) { xcd_barrier_complete(bar, b.x, nloc, nx); b.st[0] = nloc; b.st[1] = nx; }
        const unsigned old = xb_add(&bar[XB_XSUB(b.x)], 1u);
        const unsigned gen = old / nloc;
        if (old + 1u == (gen + 1u) * nloc) {
            __builtin_amdgcn_fence(__ATOMIC_RELEASE, "agent");
            asm volatile("s_waitcnt vmcnt(0)" ::: "memory");
            const unsigned og = xb_add(&bar[XB_TOP], 1u);
            const unsigned tg = og / nx;
            if (og + 1u == (tg + 1u) * nx) xb_add(&bar[XB_TOPGEN], 1u);
            else XB_SPIN(xb_ld(&bar[XB_TOPGEN]) == tg, bar);
            __builtin_amdgcn_fence(__ATOMIC_ACQUIRE, "agent");
            xb_add(&bar[XB_XGEN(b.x)], 1u);
            asm volatile("s_waitcnt vmcnt(0)" ::: "memory");
        } else {
            XB_SPIN(xb_ld(&bar[XB_XGEN(b.x)]) == gen, bar);
            __builtin_amdgcn_fence(__ATOMIC_ACQUIRE, "agent");
            asm volatile("s_waitcnt vmcnt(0)" ::: "memory");
        }
    }
    __syncthreads();
}

template <class F> struct EpiFn {
    static constexpr bool PERM = true, AFTER_DRAIN = false;
    F f;
    DI void operator()(const f32x4 (&acc)[2][2][4][2], const pg8::Unit& u, int wr, int wc, int fr, int fq) const {
        const int row0 = u.pm * 256 + wr * 64 + fr, col0 = u.pn * 256 + wc * 32 + 8 * fq;
        const int kind = f.kind(u.pn);
#pragma unroll
        for (int ai = 0; ai < 2; ++ai)
#pragma unroll
            for (int m = 0; m < 4; ++m)
#pragma unroll
                for (int bj = 0; bj < 2; ++bj) f(kind, row0 + ai * 128 + m * 16, col0 + bj * 128, acc[ai][bj][m][0], acc[ai][bj][m][1]);
    }
};
DI u32x4 pack8(f32x4 a, f32x4 b) { u32x4 w; w.x = pk2(a[0], a[1]); w.y = pk2(a[2], a[3]); w.z = pk2(b[0], b[1]); w.w = pk2(b[2], b[3]); return w; }
DI void st8f(float* p, f32x4 a, f32x4 b) { *(f32x4*)p = a; *(f32x4*)(p + 4) = b; }

struct FnA {
    bf16* qa; float* fa; bf16* va; bf16* oga; bf16* memq; const float* lb;
    DI int kind(int pn) const { return pn < 12 ? 0 : pn < 18 ? 2 : pn < 24 ? 3 : 4; }
    DI void operator()(int kind, int row, int col, f32x4 v0, f32x4 v1) const {
        if (kind == 0) {
            const int ch = (col >> 8) * HD + (col & 127);
            if (((col >> 7) & 1) == 0) {
#pragma unroll
                for (int e = 0; e < 4; ++e) { v0[e] = v0[e] * sigm(v0[e]); v1[e] = v1[e] * sigm(v1[e]); }
                *(u32x4*)(qa + (size_t)row * TOK + ch) = pack8(v0, v1);
            } else {
                const f32x4 l0 = *(const f32x4*)(lb + ch), l1 = *(const f32x4*)(lb + ch + 4);
#pragma unroll
                for (int e = 0; e < 4; ++e) { v0[e] = l0[e] + (1.f - l0[e]) * sigm(v0[e]); v1[e] = l1[e] + (1.f - l1[e]) * sigm(v1[e]); }
                st8f(fa + (size_t)row * TOK + ch, v0, v1);
            }
        } else if (kind == 2) {
            *(u32x4*)(va + (size_t)row * TOK + (col - 2 * TOK)) = pack8(v0, v1);
        } else if (kind == 3) {
#pragma unroll
            for (int e = 0; e < 4; ++e) { v0[e] = sigm(v0[e]); v1[e] = sigm(v1[e]); }
            *(u32x4*)(oga + (size_t)row * TOK + (col - 3 * TOK)) = pack8(v0, v1);
        } else {
            *(u32x4*)(memq + (size_t)row * MEMW + (col - 4 * TOK)) = pack8(v0, v1);
        }
    }
};
template <int CTRL> DI float dpp_mov0(float x) { return __builtin_bit_cast(float, __builtin_amdgcn_update_dpp(0, __builtin_bit_cast(int, x), CTRL, 0xf, 0xf, false)); }
DI float row_scan16(float x) { x += dpp_mov0<0x111>(x); x += dpp_mov0<0x112>(x); x += dpp_mov0<0x114>(x); x += dpp_mov0<0x118>(x); return x; }
struct EpiA {
    static constexpr bool PERM = true, AFTER_DRAIN = false;
    bf16* qp; bf16* kp; bf16* kt; bf16* vf; float* dv; bf16* oga; bf16* memq; const float* lb; FnA fs;
    DI void operator()(const f32x4 (&acc)[2][2][4][2], const pg8::Unit& u, int wr, int wc, int fr, int fq) const {
        const int pn = u.pn;
        if (u.pm >= MPR / 256) {
            const int row0 = u.pm * 256 + wr * 64 + fr, col0 = pn * 256 + wc * 32 + 8 * fq, kind = fs.kind(pn);
#pragma unroll
            for (int ai = 0; ai < 2; ++ai)
#pragma unroll
                for (int m = 0; m < 4; ++m)
#pragma unroll
                    for (int bj = 0; bj < 2; ++bj) fs(kind, row0 + ai * 128 + m * 16, col0 + bj * 128, acc[ai][bj][m][0], acc[ai][bj][m][1]);
        } else if (pn < 12) {
            const int k0 = 32 * wc + 8 * fq;
            const f32x4 l0 = *(const f32x4*)(lb + pn * HD + k0), l1 = *(const f32x4*)(lb + pn * HD + k0 + 4);
#pragma unroll
            for (int ai = 0; ai < 2; ++ai)
#pragma unroll
                for (int mp = 0; mp < 2; ++mp) {
                    const int grow0 = u.pm * 256 + ai * 128 + wr * 64 + mp * 32, bh = (grow0 >> 11) * NH + pn, c = (grow0 & (TP - 1)) >> 5;
                    const size_t cb = ((size_t)bh * 64 + c) * 4096;
                    const size_t rowoff = (size_t)(wc * 2 + ((fq >> 1) & 1)) * 512 + (fq & 1) * 4;
#pragma unroll
                    for (int eh = 0; eh < 2; ++eh) {
                        float q1[2][4], k1[2][4], k2[2][4];
#pragma unroll
                        for (int e4 = 0; e4 < 4; ++e4) {
                            const float lbv = eh ? l1[e4] : l0[e4];
                            float qv[2], kk[2], sc[2];
#pragma unroll
                            for (int mo = 0; mo < 2; ++mo) {
                                const float uq = acc[ai][0][2 * mp + mo][eh][e4], uf = acc[ai][1][2 * mp + mo][eh][e4];
                                qv[mo] = uq * sigm(uq);
                                const float f = lbv + (1.f - lbv) * sigm(uf);
                                kk[mo] = 1.f - f;
                                sc[mo] = row_scan16(__builtin_amdgcn_logf(f));
                            }
                            const float tot0 = __shfl(sc[0], 15, 16), tot1 = __shfl(sc[1], 15, 16);
                            const float b0 = sc[0], b1 = tot0 + sc[1], r = tot0, b31 = tot0 + tot1;
                            q1[0][e4] = qv[0] * __builtin_amdgcn_exp2f(b0 - r); q1[1][e4] = qv[1] * __builtin_amdgcn_exp2f(b1 - r);
                            k1[0][e4] = kk[0] * __builtin_amdgcn_exp2f(r - b0); k1[1][e4] = kk[1] * __builtin_amdgcn_exp2f(r - b1);
                            k2[0][e4] = kk[0] * __builtin_amdgcn_exp2f(b31 - b0); k2[1][e4] = kk[1] * __builtin_amdgcn_exp2f(b31 - b1);
                            if (fr == 0) { float* dp = dv + ((size_t)bh * 64 + c) * 256 + k0 + 4 * eh + e4; dp[0] = __builtin_amdgcn_exp2f(b31); dp[128] = __builtin_amdgcn_exp2f(r); }
                        }
#pragma unroll
                        for (int mo = 0; mo < 2; ++mo) {
                            const int tt = 16 * mo + fr;
                            const size_t o = cb + rowoff + (size_t)(tt + 32 * eh) * 8;
                            u32x2 w; w.x = pk2(q1[mo][0], q1[mo][1]); w.y = pk2(q1[mo][2], q1[mo][3]); *(u32x2*)(qp + o) = w;
                            w.x = pk2(k1[mo][0], k1[mo][1]); w.y = pk2(k1[mo][2], k1[mo][3]); *(u32x2*)(kp + o) = w;
                            bf16* tp = kt + cb + vf_off(tt, k0 + 4 * eh);
#pragma unroll
                            for (int e4 = 0; e4 < 4; ++e4) tp[e4 * 8] = f2bf(k2[mo][e4]);
                        }
                    }
                }
        } else {
            const int row0 = u.pm * 256 + wr * 64 + fr, col0 = pn * 256 + wc * 32 + 8 * fq;
#pragma unroll
            for (int ai = 0; ai < 2; ++ai)
#pragma unroll
                for (int m = 0; m < 4; ++m)
#pragma unroll
                    for (int bj = 0; bj < 2; ++bj) {
                        const int row = row0 + ai * 128 + m * 16, col = col0 + bj * 128; f32x4 v0 = acc[ai][bj][m][0], v1 = acc[ai][bj][m][1];
                        if (pn < 18) {
                            const int hv = (col - 2 * TOK) >> 7, vd = col & 127, t = row & (TP - 1);
                            bf16* p = vf + ((size_t)((row >> 11) * NH + hv) * 64 + (t >> 5)) * 4096 + vf_off(t & 31, vd);
#pragma unroll
                            for (int e = 0; e < 4; ++e) { p[e * 8] = f2bf(v0[e]); p[(e + 4) * 8] = f2bf(v1[e]); }
                        } else if (pn < 24) {
#pragma unroll
                            for (int e = 0; e < 4; ++e) { v0[e] = sigm(v0[e]); v1[e] = sigm(v1[e]); }
                            *(u32x4*)(oga + (size_t)row * TOK + (col - 3 * TOK)) = pack8(v0, v1);
                        } else {
                            *(u32x4*)(memq + (size_t)row * MEMW + (col - 4 * TOK)) = pack8(v0, v1);
                        }
                    }
        }
    }
};
struct FnM {
    float* out; bf16* mk; bf16* mvt;
    DI int kind(int pn) const { return (pn & 3) >> 1; }
    DI void operator()(int kind, int row, int col, f32x4 v0, f32x4 v1) const {
        const int b = row >> 8, m = row & 255, l = col >> 10, c = col & 1023, h = (c >> 7) & 3, d = c & 127;
        st8f(out + O_MP + ((size_t)((l * BP + b) * MEML + m)) * 1024 + c, v0, v1);
        const size_t hb = ((size_t)((l * 40 + b) * 4 + h)) * MEML * HD + (size_t)(m >> 5) * 4096;
        if (kind == 0) {
            *(u32x4*)(mk + hb + kf_off(m & 31, d)) = pack8(v0, v1);
        } else {
            bf16* p = mvt + hb + vf_off(m & 31, d);
#pragma unroll
            for (int e = 0; e < 4; ++e) { p[e * 8] = f2bf(v0[e]); p[(e + 4) * 8] = f2bf(v1[e]); }
        }
    }
};
struct FnC {
    float* o; int ld;
    DI int kind(int) const { return 0; }
    DI void operator()(int, int row, int col, f32x4 v0, f32x4 v1) const { st8f(o + (size_t)row * ld + col, v0, v1); }
};
struct FnO {
    bf16* o; int ld;
    DI int kind(int) const { return 0; }
    DI void operator()(int, int row, int col, f32x4 v0, f32x4 v1) const { *(u32x4*)(o + (size_t)row * ld + col) = pack8(v0, v1); }
};
struct FnF1 {
    bf16* ab; float* out; int layer;
    DI int kind(int) const { return 0; }
    DI void operator()(int, int row, int col, f32x4 v0, f32x4 v1) const {
        const int half = (col >> 7) & 1, n = (col >> 8) * 128 + (col & 127);
        *(u32x4*)(ab + (size_t)row * FF2 + half * FF + n) = pack8(v0, v1);
        if (half == 0 && row >= MPR && row < MR) { const int rs = row - MPR, t = rs & 3; if (t >= 2) st8f(out + O_CS + ((size_t)((layer * BS + (rs >> 2)) * 2 + (t - 2))) * FF + n, v0, v1); }
    }
};
template <int CTRL> DI float dpp_ror(float x) { return __builtin_bit_cast(float, __builtin_amdgcn_update_dpp(0, __builtin_bit_cast(int, x), CTRL, 0xf, 0xf, false)); }
struct EpiF1 {
    static constexpr bool PERM = true, AFTER_DRAIN = false;
    bf16* hid; float* fix; float* halo; float* out; const float* wconv; const float* bconv; int layer;
    DI void operator()(const f32x4 (&acc)[2][2][4][2], const pg8::Unit& u, int wr, int wc, int fr, int fq) const {
        const int n0 = u.pn * 128 + wc * 32 + 8 * fq;
        f32x4 w0[2], w1[2], w2[2], bb[2];
#pragma unroll
        for (int eh = 0; eh < 2; ++eh) { w0[eh] = *(const f32x4*)(wconv + n0 + 4 * eh); w1[eh] = *(const f32x4*)(wconv + FF + n0 + 4 * eh); w2[eh] = *(const f32x4*)(wconv + 2 * FF + n0 + 4 * eh); bb[eh] = *(const f32x4*)(bconv + n0 + 4 * eh); }
#pragma unroll
        for (int ai = 0; ai < 2; ++ai) {
            const int rowb = u.pm * 256 + ai * 128 + wr * 64, blk = rowb >> 6;
            f32x4 p1[2] = {(f32x4){0.f, 0.f, 0.f, 0.f}, (f32x4){0.f, 0.f, 0.f, 0.f}}, p2[2] = {(f32x4){0.f, 0.f, 0.f, 0.f}, (f32x4){0.f, 0.f, 0.f, 0.f}};
#pragma unroll
            for (int m = 0; m < 4; ++m) {
                const int row = rowb + m * 16 + fr;
                f32x4 h[2];
#pragma unroll
                for (int eh = 0; eh < 2; ++eh) {
                    f32x4 c1, c2;
#pragma unroll
                    for (int e = 0; e < 4; ++e) { const float av = acc[ai][0][m][eh][e]; c1[e] = dpp_ror<0x121>(av); c2[e] = dpp_ror<0x122>(av); }
#pragma unroll
                    for (int e = 0; e < 4; ++e) {
                        const float e1 = fr >= 1 ? c1[e] : p1[eh][e], e0 = fr >= 2 ? c2[e] : p2[eh][e];
                        const float cc = bb[eh][e] + w0[eh][e] * e0 + w1[eh][e] * e1 + w2[eh][e] * acc[ai][0][m][eh][e];
                        h[eh][e] = gelu_t(cc) * acc[ai][1][m][eh][e];
                    }
                    p1[eh] = c1; p2[eh] = c2;
                }
                if (m == 0 && fr < 2) {
                    float* fp = fix + ((size_t)(blk * 2 + fr) * 2) * FF + n0;
                    st8f(fp, acc[ai][0][0][0], acc[ai][0][0][1]); st8f(fp + FF, acc[ai][1][0][0], acc[ai][1][0][1]);
                } else {
                    *(u32x4*)(hid + (size_t)row * FF + n0) = pack8(h[0], h[1]);
                }
                if (m == 3 && fr >= 14) {
                    st8f(halo + ((size_t)(blk * 2 + (fr - 14))) * FF + n0, acc[ai][0][3][0], acc[ai][0][3][1]);
                    const int t = row & (TP - 1);
                    if (t >= TP - 2) st8f(out + O_CP + ((size_t)((layer * BP + (row >> 11)) * 2 + (t - (TP - 2)))) * FF + n0, acc[ai][0][3][0], acc[ai][0][3][1]);
                }
            }
        }
    }
};
struct FnB {
    bf16* qb; bf16* memq; float* gates; float* out; bf16* kcmp; bf16* vcmp; bf16* ksel; bf16* vselt; bf16* kwin; bf16* vwint;
    DI int kind(int pn) const { return pn < 6 ? 0 : pn < 8 ? 1 : pn < 14 ? 2 + (pn - 8) : 8; }
    DI void operator()(int kind, int row, int col, f32x4 v0, f32x4 v1) const {
        if (kind == 0) { *(u32x4*)(qb + (size_t)row * TOK + col) = pack8(v0, v1); }
        else if (kind == 1) { *(u32x4*)(memq + (size_t)row * MEMW + (col - TOK)) = pack8(v0, v1); }
        else if (kind == 8) {
            const int c = col - 3584;
            if (c < 36) {
#pragma unroll
                for (int e = 0; e < 4; ++e) { v0[e] = sigm(v0[e]); v1[e] = sigm(v1[e]); }
                st8f(gates + (size_t)row * 40 + c, v0, v1);
            }
        } else {
            const int kk = kind - 2, cp = col - 2048, g = (col >> 7) & 1, d = col & 127;
            if (row < MPR) {
                const int b = row >> 11, t = row & (TP - 1);
                if (kk < 4) st8f(out + O_KVP + (size_t)row * 1024 + cp, v0, v1);
                else if (t >= TP - 512) st8f(out + O_WP + ((size_t)(b * 512 + (t - (TP - 512)))) * 512 + (cp - 1024), v0, v1);
                const size_t gb = (size_t)(b * GB + g) * TP * HD;
                if (kk == 3 || kk == 5) {
                    bf16* p = (kk == 3 ? vselt : vwint) + gb + (size_t)(t >> 5) * 4096 + vf_off(t & 31, d);
#pragma unroll
                    for (int e = 0; e < 4; ++e) { p[e * 8] = f2bf(v0[e]); p[(e + 4) * 8] = f2bf(v1[e]); }
                } else if (kk < 2) {
                    *(u32x4*)((kk == 0 ? kcmp : vcmp) + gb + (size_t)t * HD + d) = pack8(v0, v1);
                } else {
                    *(u32x4*)((kk == 2 ? ksel : kwin) + gb + (size_t)(t >> 5) * 4096 + kf_off(t & 31, d)) = pack8(v0, v1);
                }
            } else if (row < MR) {
                const int rs = row - MPR;
                if (kk < 4) st8f(out + O_KVS + (size_t)rs * 1024 + cp, v0, v1);
                else st8f(out + O_WS + (size_t)rs * 512 + (cp - 1024), v0, v1);
            }
        }
    }
};

struct Args { const float* in[25]; float* out; unsigned char* ws; };
typedef const __attribute__((address_space(4))) Args& ArgsRef;
DI const __attribute__((address_space(4))) Args* phase_args() { const __attribute__((address_space(4))) Args* p = (const __attribute__((address_space(4))) Args*)__builtin_amdgcn_kernarg_segment_ptr(); asm volatile("" : "+s"(p)); return p; }
enum { I_XP = 0, I_XS, I_MEMP, I_HST, I_CCONV, I_CMEM, I_CKV, I_CWIN, I_PT, I_NG, I_WINA, I_LBL, I_HGN, I_WINB, I_WO, I_WMKV, I_KVN, I_WKVB, I_CPOS, I_WC1, I_WC2, I_WF1, I_WCONV, I_BCONV, I_WF2 };

struct SegD { int in_idx, src_off, ldw, col0, nvalid, ncols, gain_idx, gain_off, row0, K; unsigned long long dst; };
static constexpr SegD k_segs[17] = {
    {I_WINA, 0, NA, 0, NA, NA, I_NG, 0, 0, 2048, WS_BTA},
    {I_WO, 0, D, 0, D, D, -1, 0, 0, 2048, WS_BTO0},
    {I_WO, D * D, D, 0, D, D, -1, 0, 0, 2048, WS_BTO1},
    {I_WF1, 0, FF2, 0, FF2, FF2, I_NG, 2 * D, 0, 2048, WS_BTF10},
    {I_WF1, D * FF2, FF2, 0, FF2, FF2, I_NG, 6 * D, 0, 2048, WS_BTF11},
    {I_WF2, 0, D, 0, D, D, -1, 0, 0, FF, WS_BTF20},
    {I_WF2, FF * D, D, 0, D, D, -1, 0, 0, FF, WS_BTF21},
    {I_WINB, 0, 2084, 0, 1536, 1536, I_NG, 4 * D, 0, 2048, WS_BTB},
    {I_WINB, 0, 2084, 1572, 512, 512, I_NG, 4 * D, 1536, 2048, WS_BTB},
    {I_WINB, 0, 2084, 1536, 36, 256, I_NG, 4 * D, 3584, 2048, WS_BTB},
    {I_WKVB, 0, 1536, 0, 1536, 1536, I_KVN, 0, 2048, 2048, WS_BTB},
    {I_WMKV, 0, 1024, 0, 1024, 1024, -1, 0, 0, 2048, WS_BTM},
    {I_WMKV, D * 1024, 1024, 0, 1024, 1024, -1, 0, 1024, 2048, WS_BTM},
    {I_WC1, 0, 128, 0, 128, 128, -1, 0, 0, 2048, WS_BTC},
    {I_WC1, 2048 * 128, 128, 0, 128, 128, -1, 0, 128, 2048, WS_BTC},
    {I_WC1, 4096 * 128, 128, 0, 128, 128, -1, 0, 0, 2048, WS_BTC + (size_t)256 * 2048 * 2},
    {I_WC1, 4096 * 128 + 2048 * 128, 128, 0, 128, 128, -1, 0, 128, 2048, WS_BTC + (size_t)256 * 2048 * 2},
};
static constexpr int k_tl_end[17] = { 832, 1088, 1344, 2752, 4160, 4864, 5568, 5760, 5824, 5856, 6048, 6176, 6304, 6336, 6368, 6400, 6432 };
constexpr int TL_A0 = 832, TL_LATE0 = 832, TL_LATE1 = 6048, TL_END = 6432;
struct TrTile { bf16* dst; int k0, n0, row0, K, ncols; f32x4 v[8]; float gk[8]; };
DI void tr_load(ArgsRef a, int tile, TrTile& T, int tid) {
    int s = 0, base = 0;
#pragma unroll
    for (int i = 0; i < 16; ++i) { const bool ge = tile >= k_tl_end[i]; s += ge ? 1 : 0; base = ge ? k_tl_end[i] : base; }
    SegD sd = k_segs[0];
#pragma unroll
    for (int i = 1; i < 17; ++i) if (s == i) sd = k_segs[i];
    const int r = tile - base, ncb = (sd.ncols + 255) >> 8, kb = r / ncb, nb = r - kb * ncb, k0 = 64 * kb, n0 = 256 * nb;
    const float* W = a.in[sd.in_idx] + sd.src_off;
    const float* gain = sd.gain_idx >= 0 ? a.in[sd.gain_idx] + sd.gain_off : nullptr;
    T.dst = (bf16*)(a.ws + sd.dst); T.k0 = k0; T.n0 = n0; T.row0 = sd.row0; T.K = sd.K; T.ncols = sd.ncols;
    const int ilv = (s == 0) ? TOK : (s == 3 || s == 4) ? FF : 0;
#pragma unroll
    for (int i = 0; i < 8; ++i) {
        const int idx = i * NTHR + tid, kk = idx >> 6, c4 = (idx & 63) * 4, n = n0 + c4, g128 = n & ~127;
        const int scol = (ilv && (s != 0 || g128 < 2 * TOK)) ? ((g128 >> 7) & 1) * ilv + (g128 >> 8) * 128 + (n & 127) : n;
        const float* src = W + (size_t)(k0 + kk) * sd.ldw + sd.col0 + scol;
        if (n + 3 < sd.nvalid) T.v[i] = *(const f32x4*)src;
        else { for (int e = 0; e < 4; ++e) T.v[i][e] = (n + e < sd.nvalid) ? src[e] : 0.f; }
        T.gk[i] = gain ? gain[k0 + kk] : 1.f;
    }
}
constexpr int TR_LD = 260, TR_BUF = 64 * TR_LD * 2;
DI void tr_write(const TrTile& T, LAS unsigned char* buf, int tid) {
#pragma unroll
    for (int i = 0; i < 8; ++i) {
        const int idx = i * NTHR + tid, kk = idx >> 6, c4 = (idx & 63) * 4; const float g = T.gk[i];
        u32x2 w; w.x = pk2(T.v[i][0] * g, T.v[i][1] * g); w.y = pk2(T.v[i][2] * g, T.v[i][3] * g);
        *(LAS u32x2*)(buf + (kk * TR_LD + c4) * 2) = w;
    }
}
DI void tr_store(const TrTile& T, const LAS unsigned char* buf, int tid) {
    const LAS bf16* B = (const LAS bf16*)buf;
#pragma unroll
    for (int j = 0; j < 4; ++j) {
        const int id = j * NTHR + tid, n = id >> 3, c = id & 7;
        if (T.n0 + n < T.ncols) {
            const LAS bf16* sp = B + (8 * c) * TR_LD + n;
            u32x4 o; o.x = (unsigned)sp[0] | ((unsigned)sp[TR_LD] << 16); o.y = (unsigned)sp[2 * TR_LD] | ((unsigned)sp[3 * TR_LD] << 16);
            o.z = (unsigned)sp[4 * TR_LD] | ((unsigned)sp[5 * TR_LD] << 16); o.w = (unsigned)sp[6 * TR_LD] | ((unsigned)sp[7 * TR_LD] << 16);
            *(u32x4*)(T.dst + (size_t)(T.row0 + T.n0 + n) * T.K + T.k0 + 8 * c) = o;
        }
    }
}
#define TR_BAR() asm volatile("s_waitcnt lgkmcnt(0)\n\ts_barrier" ::: "memory")
template <class MAP>
DI void wg_transpose_run(ArgsRef a, LAS unsigned char* lds, int first, int last, int step, const MAP& map, int tid) {
    if (first >= last) return;
    __syncthreads();
    TrTile T; tr_load(a, map(first), T, tid);
    int par = 0;
    for (int t = first; t < last; t += step) {
        LAS unsigned char* buf = lds + par * TR_BUF;
        tr_write(T, buf, tid);
        const TrTile Tc = T;
        if (t + step < last) tr_load(a, map(t + step), T, tid);
        TR_BAR();
        tr_store(Tc, buf, tid);
        par ^= 1;
    }
    __syncthreads();
}
template <bool NORM> DI void row_to_bf16(const float* xrow, bf16* orow, int lane) {
    const f32x4* xr = (const f32x4*)xrow + lane;
    f32x4 v[8]; float s = 0.f;
#pragma unroll
    for (int j = 0; j < 8; ++j) { v[j] = xr[64 * j]; s += (v[j][0] * v[j][0] + v[j][1] * v[j][1]) + (v[j][2] * v[j][2] + v[j][3] * v[j][3]); }
    float rs = 1.f;
    if (NORM) rs = rsqrtf(wave_sum(s) * (1.f / D) + EPS);
    u32x2* o8 = (u32x2*)orow + lane;
#pragma unroll
    for (int j = 0; j < 8; ++j) { u32x2 w; w.x = pk2(v[j][0] * rs, v[j][1] * rs); w.y = pk2(v[j][2] * rs, v[j][3] * rs); o8[64 * j] = w; }
}
DI void p0_prologue(ArgsRef a, LAS unsigned char* lds, int gw, int ngw, int wave, int lane) {
    bf16* XN = (bf16*)(a.ws + WS_XN);
    for (int m = gw; m < MR; m += ngw) {
        const float* src = m < MPR ? a.in[I_XP] + (size_t)m * D : a.in[I_XS] + (size_t)(m - MPR) * D;
        row_to_bf16<true>(src, XN + (size_t)m * D, lane);
    }
    bf16* MB = (bf16*)(a.ws + WS_MEMPB);
    for (int m = gw; m < BP * MEML; m += ngw) row_to_bf16<false>(a.in[I_MEMP] + (size_t)m * D, MB + (size_t)m * D, lane);
    bf16* MK = (bf16*)(a.ws + WS_MK); bf16* MVT = (bf16*)(a.ws + WS_MVT);
    for (int rr = gw; rr < 2 * BS * MEML; rr += ngw) {
        const int l = rr / (BS * MEML), b = (rr / MEML) % BS, m = rr % MEML;
        const float* src = a.in[I_CMEM] + (size_t)rr * 1024;
#pragma unroll
        for (int j = 0; j < 4; ++j) {
            const int idx = 4 * lane + 256 * j, h = (idx >> 7) & 3, d = idx & 127;
            const f32x4 v = *(const f32x4*)(src + idx);
            const size_t hb = ((size_t)((l * 40 + 8 + b) * 4 + h)) * MEML * HD + (size_t)(m >> 5) * 4096;
            if (j < 2) { u32x2 w; w.x = pk2(v[0], v[1]); w.y = pk2(v[2], v[3]); *(u32x2*)(MK + hb + kf_off(m & 31, d)) = w; }
            else { bf16* p = MVT + hb + vf_off(m & 31, d);
#pragma unroll
                for (int e = 0; e < 4; ++e) p[e * 8] = f2bf(v[e]); }
        }
    }
    for (int idx = gw * 64 + lane; idx < 2 * 128 * 128; idx += ngw * 64) { const int kv = idx >> 14, d = (idx >> 7) & 127, hh = idx & 127; ((bf16*)(a.ws + WS_W2T))[idx] = f2bf(a.in[I_WC2][(size_t)kv * 16384 + hh * 128 + d]); }
    if (gw < 24) { const int c = gw * 64 + lane; const float* ll = a.in[I_LBL]; ((float*)(a.ws + WS_LB))[c] = 1.f / (1.f + __expf(ll[TOK + c] - ll[c])); }
    for (int it = gw; it < 256; it += ngw) {
        const int kv = it >> 7, h = it & 127; const float* pe = a.in[I_CPOS] + kv * 4096; const float* w1 = a.in[I_WC1] + (size_t)kv * 4096 * 128 + h;
        float s = 0.f;
        for (int i = 0; i < 64; ++i) { const int n = lane + 64 * i; s += pe[n] * w1[(size_t)n * 128]; }
        s = wave_sum(s);
        if (lane == 0) ((float*)(a.ws + WS_PRE0))[it] = s;
    }
}


#define MFMA32(a, b, c) __builtin_amdgcn_mfma_f32_32x32x16_bf16((a), (b), (c), 0, 0, 0)
DI int crow(int i, int h) { return (i & 3) + 8 * (i >> 2) + 4 * h; }
DI f32x16 zero16() { f32x16 z; for (int i = 0; i < 16; ++i) z[i] = 0.f; return z; }
DI bf16x8 packp(const f32x16& s, int st) {
    u32x4 p; p.x = pk2(s[8 * st + 0], s[8 * st + 1]); p.y = pk2(s[8 * st + 2], s[8 * st + 3]); p.z = pk2(s[8 * st + 4], s[8 * st + 5]); p.w = pk2(s[8 * st + 6], s[8 * st + 7]);
    return __builtin_bit_cast(bf16x8, p);
}
struct AttnAcc { f32x16 o[4]; float m, l; };
DI void attn_init(AttnAcc& A) { for (int i = 0; i < 4; ++i) A.o[i] = zero16(); A.m = -1e30f; A.l = 0.f; }
DI void load_qf(bf16x8 (&qf)[8], const bf16* qrow, int h) {
#pragma unroll
    for (int ks = 0; ks < 8; ++ks) qf[ks] = *(const bf16x8*)(qrow + 16 * ks + 8 * h);
}
DI f32x16 qk_tile(const bf16x8 (&qf)[8], const bf16* Kt, int lane) {
    f32x16 s = zero16();
    const bf16x8* kp = (const bf16x8*)Kt + lane;
#pragma unroll
    for (int ks = 0; ks < 8; ++ks) s = MFMA32(kp[ks * 64], qf[ks], s);
    return s;
}
DI f32x16 qk_tile_l(const LAS bf16x8* ql, const bf16* Kt, int lane) {
    f32x16 s = zero16();
    const bf16x8* kp = (const bf16x8*)Kt + lane;
#pragma unroll
    for (int ks = 0; ks < 8; ++ks) s = MFMA32(kp[ks * 64], ql[ks * 64 + lane], s);
    return s;
}
DI void pv_tile(f32x16 (&o)[4], const f32x16& p, const bf16* Vt, int lane) {
    const bf16x8* vp = (const bf16x8*)Vt + lane;
#pragma unroll
    for (int st = 0; st < 2; ++st) {
        const bf16x8 pf = packp(p, st);
#pragma unroll
        for (int db = 0; db < 4; ++db) o[db] = MFMA32(vp[(st * 4 + db) * 64], pf, o[db]);
    }
}
template <class VF>
DI void attn_step(AttnAcc& A, f32x16 s, const bf16* Vt, float slope2, float kp0, float kps, const VF& valid, int lane) {
    const int h = lane >> 5;
    float mt = -1e30f;
#pragma unroll
    for (int i = 0; i < 16; ++i) {
        const int kvl = crow(i, h);
        float v = s[i] * SCALE2 + slope2 * (kp0 + kps * (float)kvl);
        v = valid(kvl) ? v : -1e30f;
        s[i] = v; mt = fmaxf(mt, v);
    }
    mt = fmaxf(mt, __shfl_xor(mt, 32));
    const float mn = fmaxf(A.m, mt), alpha = __builtin_amdgcn_exp2f(A.m - mn);
    A.m = mn;
    float ls = 0.f;
#pragma unroll
    for (int i = 0; i < 16; ++i) { const float p = s[i] > -1e29f ? __builtin_amdgcn_exp2f(s[i] - mn) : 0.f; s[i] = p; ls += p; }
    A.l = A.l * alpha + ls;
#pragma unroll
    for (int db = 0; db < 4; ++db) A.o[db] *= alpha;
    pv_tile(A.o, s, Vt, lane);
}
DI void load8(bf16x8 (&f)[8], const bf16* tile, int lane) {
    const bf16x8* p = (const bf16x8*)tile + lane;
#pragma unroll
    for (int i = 0; i < 8; ++i) f[i] = p[i * 64];
}
template <class VF, class FF>
DI void attn_run(AttnAcc& A, const LAS bf16x8* ql, const bf16* Kb, const bf16* Vb, unsigned long long tmask, float slope2, int t0, const VF& validf, const FF& fullf, int lane) {
    if (tmask == 0ull) return;
    const int h = lane >> 5;
    int kt = __builtin_ctzll(tmask); tmask &= tmask - 1ull;
    bf16x8 kf[8]; load8(kf, Kb + (size_t)kt * 4096, lane);
    for (;;) {
        const bf16x8* vp = (const bf16x8*)(Vb + (size_t)kt * 4096) + lane;
        bf16x8 va[4], vb[4];
#pragma unroll
        for (int db = 0; db < 4; ++db) va[db] = vp[db * 64];
#pragma unroll
        for (int db = 0; db < 4; ++db) vb[db] = vp[(4 + db) * 64];
        __builtin_amdgcn_sched_barrier(0);
        const LAS bf16x8* q2 = ql + lane; asm volatile("" : "+v"(q2));
        f32x16 s = zero16();
#pragma unroll
        for (int ks = 0; ks < 8; ++ks) s = MFMA32(kf[ks], q2[ks * 64], s);
        const bool more = tmask != 0ull; int kn = kt;
        const float kb0 = slope2 * (float)(kt * 32 - t0 + 4 * h);
        const bool full = fullf(kt);
        float mt = -1e30f;
        if (full) {
#pragma unroll
            for (int i = 0; i < 16; ++i) { const float v = fmaf(s[i], SCALE2, fmaf(slope2, (float)((i & 3) + 8 * (i >> 2)), kb0)); s[i] = v; mt = fmaxf(mt, v); }
        } else {
#pragma unroll
            for (int i = 0; i < 16; ++i) { float v = fmaf(s[i], SCALE2, fmaf(slope2, (float)((i & 3) + 8 * (i >> 2)), kb0)); v = validf(kt, crow(i, h)) ? v : -1e30f; s[i] = v; mt = fmaxf(mt, v); }
        }
        if (more) { kn = __builtin_ctzll(tmask); tmask &= tmask - 1ull; load8(kf, Kb + (size_t)kn * 4096, lane); }
        __builtin_amdgcn_sched_barrier(0);
        mt = fmaxf(mt, __shfl_xor(mt, 32));
        float mn = A.m;
        if (__any(mt > A.m + 8.f)) {
            mn = fmaxf(A.m, mt);
            const float alpha = __builtin_amdgcn_exp2f(A.m - mn);
            A.m = mn; A.l *= alpha;
#pragma unroll
            for (int db = 0; db < 4; ++db) A.o[db] *= alpha;
        }
        float ls = 0.f;
        if (full) {
#pragma unroll
            for (int i = 0; i < 16; ++i) { const float p = __builtin_amdgcn_exp2f(s[i] - mn); s[i] = p; ls += p; }
        } else {
#pragma unroll
            for (int i = 0; i < 16; ++i) { const float p = s[i] > -1e29f ? __builtin_amdgcn_exp2f(s[i] - mn) : 0.f; s[i] = p; ls += p; }
        }
        A.l += ls;
        { const bf16x8 pf = packp(s, 0);
#pragma unroll
          for (int db = 0; db < 4; ++db) A.o[db] = MFMA32(va[db], pf, A.o[db]); }
        { const bf16x8 pf = packp(s, 1);
#pragma unroll
          for (int db = 0; db < 4; ++db) A.o[db] = MFMA32(vb[db], pf, A.o[db]); }
        if (!more) break;
        kt = kn;
    }
}
DI float attn_inv(const AttnAcc& A) { const float lt = A.l + __shfl_xor(A.l, 32); return lt > 0.f ? 1.f / lt : 0.f; }
DI void store_ot(bf16* orow, const f32x16 (&o)[4], int h) {
#pragma unroll
    for (int db = 0; db < 4; ++db)
#pragma unroll
        for (int c = 0; c < 4; ++c) {
            u32x2 w; w.x = pk2(o[db][4 * c], o[db][4 * c + 1]); w.y = pk2(o[db][4 * c + 2], o[db][4 * c + 3]);
            *(u32x2*)(orow + 32 * db + 8 * c + 4 * h) = w;
        }
}

DI void memattn_item(ArgsRef a, int layer, int it, LAS float* wreg, int lane) {
    const int r = lane & 31, h = lane >> 5;
    int bq, hd, row, nvalid;
    if (it < BP * MEMH * 64) { bq = it >> 8; hd = (it >> 6) & 3; const int tau = it & 63; row = bq * TP + tau * 32 + r; nvalid = 32; }
    else { const int j = it - BP * MEMH * 64; const int bs = j >> 2; hd = j & 3; bq = 8 + bs; row = MPR + bs * 4 + (r < 4 ? r : 3); nvalid = 4; }
    const bf16* MEMQ = (const bf16*)(a.ws + WS_MEMQ);
    const bf16* K = (const bf16*)(a.ws + WS_MK) + ((size_t)((layer * 40 + bq) * 4 + hd)) * MEML * HD;
    const bf16* VT = (const bf16*)(a.ws + WS_MVT) + ((size_t)((layer * 40 + bq) * 4 + hd)) * HD * MEML;
    LAS bf16x8* ql = (LAS bf16x8*)(wreg + 2048);
    { bf16x8 qf[8]; load_qf(qf, MEMQ + (size_t)row * MEMW + hd * HD, h);
#pragma unroll
      for (int ks = 0; ks < 8; ++ks) ql[ks * 64 + lane] = qf[ks]; }
    LDS_WAIT(); asm volatile("" ::: "memory");
    AttnAcc A; attn_init(A);
    attn_run(A, ql, K, VT, 0xffull, 0.f, 0, [](int, int) { return true; }, [](int) { return true; }, lane);
    const float inv = attn_inv(A);
#pragma unroll
    for (int db = 0; db < 4; ++db) A.o[db] *= inv;
    if (r < nvalid) store_ot((bf16*)(a.ws + WS_CAT) + (size_t)row * D + TOK + hd * HD, A.o, h);
    LDS_WAIT(); asm volatile("" ::: "memory");
}

DI void memattn_wg(ArgsRef a, int layer, int item, LAS unsigned char* lds, int tid) {
    const int wave = __builtin_amdgcn_readfirstlane(tid >> 6), lane = tid & 63, r = lane & 31, h = lane >> 5;
    int bq, hd, row, nvalid; bool active;
    if (item < 256) { bq = item >> 5; hd = (item >> 3) & 3; const int tau = (item & 7) * 8 + wave; row = bq * TP + tau * 32 + r; nvalid = 32; active = true; }
    else { const int j = item - 256; const int bs = j >> 2; hd = j & 3; bq = 8 + bs; row = MPR + bs * 4 + (r < 4 ? r : 3); nvalid = 4; active = wave == 0; }
    const bf16* MEMQ = (const bf16*)(a.ws + WS_MEMQ);
    const bf16* K = (const bf16*)(a.ws + WS_MK) + ((size_t)((layer * 40 + bq) * 4 + hd)) * MEML * HD;
    const bf16* VT = (const bf16*)(a.ws + WS_MVT) + ((size_t)((layer * 40 + bq) * 4 + hd)) * HD * MEML;
    __syncthreads();
    { const u32x4* kc = (const u32x4*)K; const u32x4* vc = (const u32x4*)VT;
      u32x4 tk[8], tv[8];
#pragma unroll
      for (int j = 0; j < 8; ++j) { tk[j] = kc[j * NTHR + tid]; tv[j] = vc[j * NTHR + tid]; }
#pragma unroll
      for (int j = 0; j < 8; ++j) { ((LAS u32x4*)lds)[j * NTHR + tid] = tk[j]; ((LAS u32x4*)(lds + 65536))[j * NTHR + tid] = tv[j]; } }
    bf16x8 qf[8]; load_qf(qf, MEMQ + (size_t)row * MEMW + hd * HD, h);
    __syncthreads();
    if (active) {
        const LAS bf16x8* KL = (const LAS bf16x8*)lds + lane; const LAS bf16x8* VL = (const LAS bf16x8*)(lds + 65536) + lane;
        AttnAcc A; attn_init(A);
#pragma unroll 1
        for (int kt = 0; kt < 8; ++kt) {
            f32x16 s = zero16();
#pragma unroll
            for (int ks = 0; ks < 8; ++ks) s = MFMA32(KL[(kt * 8 + ks) * 64], qf[ks], s);
            float mt = -1e30f;
#pragma unroll
            for (int i = 0; i < 16; ++i) { s[i] *= SCALE2; mt = fmaxf(mt, s[i]); }
            mt = fmaxf(mt, __shfl_xor(mt, 32));
            float mn = A.m;
            if (__any(mt > A.m + 8.f)) { mn = fmaxf(A.m, mt); const float alpha = __builtin_amdgcn_exp2f(A.m - mn); A.m = mn; A.l *= alpha;
#pragma unroll
                for (int db = 0; db < 4; ++db) A.o[db] *= alpha; }
            float ls = 0.f;
#pragma unroll
            for (int i = 0; i < 16; ++i) { const float p = __builtin_amdgcn_exp2f(s[i] - mn); s[i] = p; ls += p; }
            A.l += ls;
#pragma unroll
            for (int st = 0; st < 2; ++st) { const bf16x8 pf = packp(s, st);
#pragma unroll
                for (int db = 0; db < 4; ++db) A.o[db] = MFMA32(VL[(kt * 8 + st * 4 + db) * 64], pf, A.o[db]); }
        }
        const float inv = attn_inv(A);
#pragma unroll
        for (int db = 0; db < 4; ++db) A.o[db] *= inv;
        if (r < nvalid) store_ot((bf16*)(a.ws + WS_CAT) + (size_t)row * D + TOK + hd * HD, A.o, h);
    }
    __syncthreads();
}

DI void cmp1_item(ArgsRef a, int it, int lane) {
    const int r = lane & 31, h = lane >> 5;
    const int kv = it >> 9, mt = (it >> 3) & 63, nt = it & 7;
    const bf16* Ap = (const bf16*)(a.ws + (kv ? WS_VCMP : WS_KCMP)) + (size_t)(32 * mt + r) * 2048 + 8 * h;
    const bf16* Bp = (const bf16*)(a.ws + WS_BTC) + (size_t)kv * 256 * 2048 + (size_t)(32 * nt + r) * 2048 + 8 * h;
    f32x16 c = zero16();
#pragma unroll 8
    for (int ks = 0; ks < 128; ++ks) { const bf16x8 af = *(const bf16x8*)(Ap + 16 * ks), bfr = *(const bf16x8*)(Bp + 16 * ks); c = MFMA32(af, bfr, c); }
    float* P = (float*)(a.ws + WS_PPP) + (size_t)kv * 2048 * 256;
#pragma unroll
    for (int i = 0; i < 16; ++i) P[(size_t)(32 * mt + crow(i, h)) * 256 + 32 * nt + r] = c[i];
}
DI void cmp2_item(ArgsRef a, int it, int lane) {
    const int r = lane & 31, h = lane >> 5;
    const bool prompt = it < 128; int kv, bg, blk, nI; const float* PP;
    if (prompt) { kv = it >> 6; bg = (it >> 2) & 15; blk = it & 3; nI = 128; PP = (const float*)(a.ws + WS_PPP) + (size_t)kv * 2048 * 256; }
    else { const int j = it - 128; kv = j >> 10; bg = (j >> 4) & 63; blk = j & 15; nI = 512; PP = (const float*)(a.ws + WS_PPS) + (size_t)kv * 32768 * 256; }
    const int irow = 32 * blk + r, ic = irow < nI - 1 ? irow : nI - 2;
    const float* p0r = PP + ((size_t)bg * nI + ic) * 256 + 8 * h; const float* p1r = p0r + 256 + 128; const float* c0r = (const float*)(a.ws + WS_PRE0) + kv * 128 + 8 * h;
    bf16x8 af[8];
#pragma unroll
    for (int ks = 0; ks < 8; ++ks) {
        const f32x4 x0 = *(const f32x4*)(p0r + 16 * ks), x1 = *(const f32x4*)(p0r + 16 * ks + 4), y0 = *(const f32x4*)(p1r + 16 * ks), y1 = *(const f32x4*)(p1r + 16 * ks + 4);
        const f32x4 z0 = *(const f32x4*)(c0r + 16 * ks), z1 = *(const f32x4*)(c0r + 16 * ks + 4);
        u32x4 w; w.x = pk2(gelu_t(x0[0] + y0[0] + z0[0]), gelu_t(x0[1] + y0[1] + z0[1])); w.y = pk2(gelu_t(x0[2] + y0[2] + z0[2]), gelu_t(x0[3] + y0[3] + z0[3]));
        w.z = pk2(gelu_t(x1[0] + y1[0] + z1[0]), gelu_t(x1[1] + y1[1] + z1[1])); w.w = pk2(gelu_t(x1[2] + y1[2] + z1[2]), gelu_t(x1[3] + y1[3] + z1[3]));
        af[ks] = __builtin_bit_cast(bf16x8, w);
    }
    const bf16* W2T = (const bf16*)(a.ws + WS_W2T) + (size_t)kv * 16384;
#pragma unroll
    for (int nb = 0; nb < 4; ++nb) {
        const bf16* bp = W2T + (size_t)(32 * nb + r) * 128 + 8 * h;
        f32x16 c = zero16();
#pragma unroll
        for (int ks = 0; ks < 8; ++ks) c = MFMA32(af[ks], *(const bf16x8*)(bp + 16 * ks), c);
        const int d = 32 * nb + r;
#pragma unroll
        for (int i = 0; i < 16; ++i) {
            const int ir = 32 * blk + crow(i, h);
            if (prompt) {
                const float v = ir < NCP ? c[i] : 0.f;
                if (kv == 0) ((bf16*)(a.ws + WS_KC))[(size_t)bg * 16384 + (size_t)(ir >> 5) * 4096 + kf_off(ir & 31, d)] = f2bf(v);
                else ((bf16*)(a.ws + WS_VCT))[(size_t)bg * 16384 + (size_t)(ir >> 5) * 4096 + vf_off(ir & 31, d)] = f2bf(v);
            } else if (ir < NCS) {
                ((float*)(a.ws + (kv ? WS_VCS : WS_KCS)))[((size_t)bg * 512 + ir) * 128 + d] = c[i];
            }
        }
    }
}
template <int KS, class FN>
DI void skinny_gemm(const FN& f, const bf16* A, const bf16* Bt, int N, int K, LAS unsigned char* lds, int bx, int G, int tid, int MT = 4, int orow0 = MPR) {
    constexpr int TPW = NWAVES / KS;
    const int wave = tid >> 6, lane = tid & 63, r = lane & 31, h = lane >> 5;
    const int ntiles = MT * (N >> 5), kw = K / KS, tl = wave / KS, ksub = wave % KS;
    LAS float* red = (LAS float*)lds;
    for (int step = bx; step * TPW < ntiles; step += G) {
        const int tile = step * TPW + tl, tcl = tile < ntiles ? tile : ntiles - 1, mt = tcl % MT, nt = tcl / MT;
        const bf16* Ap = A + (size_t)(32 * mt + r) * K + ksub * kw + 8 * h;
        const bf16* Bp = Bt + (size_t)(32 * nt + r) * K + ksub * kw + 8 * h;
        f32x16 c = zero16();
        for (int k0 = 0; k0 < (kw >> 4); k0 += 16) {
            bf16x8 af[16], bfr[16];
#pragma unroll
            for (int u = 0; u < 16; ++u) { const int ks = k0 + u < (kw >> 4) ? k0 + u : (kw >> 4) - 1; af[u] = *(const bf16x8*)(Ap + 16 * ks); bfr[u] = *(const bf16x8*)(Bp + 16 * ks); }
#pragma unroll
            for (int u = 0; u < 16; ++u) if (k0 + u < (kw >> 4)) c = MFMA32(af[u], bfr[u], c);
        }
        __syncthreads();
#pragma unroll
        for (int i = 0; i < 16; ++i) red[(wave * 16 + i) * 64 + lane] = c[i];
        __syncthreads();
        for (int q = tid; q < TPW * 128; q += NTHR) {
            const int tq = q >> 7, t7 = q & 127, tile2 = step * TPW + tq;
            if (tile2 < ntiles) {
                const int row = t7 >> 2, cg = (t7 & 3) * 8, hh = (row >> 2) & 1, ii = (row & 3) + 4 * (row >> 3);
                float v[8];
#pragma unroll
                for (int e = 0; e < 8; ++e) { float s = 0.f;
#pragma unroll
                    for (int w = 0; w < KS; ++w) s += red[((tq * KS + w) * 16 + ii) * 64 + cg + e + 32 * hh];
                    v[e] = s; }
                const int mt2 = tile2 % MT, nt2 = tile2 / MT;
                f(f.kind((32 * nt2) >> 8), orow0 + 32 * mt2 + row, 32 * nt2 + cg, (f32x4){v[0], v[1], v[2], v[3]}, (f32x4){v[4], v[5], v[6], v[7]});
            }
        }
    }
    __syncthreads();
}


DI void cmpgemm_direct(ArgsRef a, LAS unsigned char* lds, int item, int tid) {
    const int wave = __builtin_amdgcn_readfirstlane(tid >> 6), lane = tid & 63, r = lane & 31, h = lane >> 5;
    const int kv = item >> 7, blk = item & 127;
    const int R = blk * 256 + wave * 32 + r, b = R >> 10, g = (R >> 9) & 1, cc = R & 511;
    const int page = ((const int*)a.in[I_PT])[b * NPAGE + (cc >> 3)];
    const float* ab = a.in[I_CKV] + ((size_t)page * PAGE + (cc & 7) * 16) * 1024 + kv * 256 + g * 128 + 8 * h;
    const bf16* bs = (const bf16*)(a.ws + WS_BTC) + (size_t)kv * 256 * 2048 + (size_t)(32 * (tid >> 6) + r) * 2048 + 8 * h;
    f32x16 acc[8];
#pragma unroll
    for (int nb = 0; nb < 8; ++nb) acc[nb] = zero16();
    f32x4 ac[4][2], an[4][2]; u32x4 bn[4];
    auto lda = [&](f32x4 (&A)[4][2], int t) {
#pragma unroll
        for (int q = 0; q < 4; ++q) { const int k0 = 64 * t + 16 * q; const float* p = ab + (size_t)(k0 >> 7) * 1024 + (k0 & 127); A[q][0] = *(const f32x4*)p; A[q][1] = *(const f32x4*)(p + 4); }
    };
    auto ldb = [&](int t) {
#pragma unroll
        for (int q = 0; q < 4; ++q) bn[q] = *(const u32x4*)(bs + 64 * t + 16 * q);
    };
    auto stb = [&](int t) {
        LAS u32x4* B = (LAS u32x4*)(lds + (t & 1) * 32768);
#pragma unroll
        for (int q = 0; q < 4; ++q) B[(q * 8 + wave) * 64 + lane] = bn[q];
    };
    __syncthreads();
    lda(ac, 0); ldb(0); stb(0);
    TR_BAR();
    for (int t = 0; t < 32; ++t) {
        if (t + 1 < 32) { lda(an, t + 1); ldb(t + 1); }
        const LAS bf16x8* B = (const LAS bf16x8*)(lds + (t & 1) * 32768) + lane;
#pragma unroll
        for (int q = 0; q < 4; ++q) {
            u32x4 w; w.x = pk2(ac[q][0][0], ac[q][0][1]); w.y = pk2(ac[q][0][2], ac[q][0][3]); w.z = pk2(ac[q][1][0], ac[q][1][1]); w.w = pk2(ac[q][1][2], ac[q][1][3]);
            const bf16x8 af = __builtin_bit_cast(bf16x8, w);
#pragma unroll
            for (int nb = 0; nb < 8; ++nb) acc[nb] = MFMA32(af, B[(q * 8 + nb) * 64], acc[nb]);
        }
        if (t + 1 < 32) { stb(t + 1);
#pragma unroll
            for (int q = 0; q < 4; ++q) { ac[q][0] = an[q][0]; ac[q][1] = an[q][1]; } }
        TR_BAR();
    }
    float* P = (float*)(a.ws + WS_PPS) + (size_t)kv * 32768 * 256 + (size_t)(blk * 256 + wave * 32) * 256;
#pragma unroll
    for (int nb = 0; nb < 8; ++nb)
#pragma unroll
        for (int i = 0; i < 16; ++i) P[(size_t)crow(i, h) * 256 + 32 * nb + r] = acc[nb][i];
    __syncthreads();
}

DI void hgrn_sample_item(ArgsRef a, LAS unsigned char* lds, int bs, int hh, int tid) {
    const int wave = tid >> 6, lane = tid & 63, vloc = lane & 15, kg = lane >> 4, v = wave * 16 + vloc;
    const bf16* QA = (const bf16*)(a.ws + WS_QA); const float* FA = (const float*)(a.ws + WS_FA); const bf16* VA = (const bf16*)(a.ws + WS_VA);
    const float* s0 = a.in[I_HST] + ((size_t)(bs * NH + hh) * HD + kg * 32) * HD + v;
    float S[32];
#pragma unroll
    for (int i = 0; i < 32; ++i) S[i] = s0[(size_t)i * HD];
    LAS float* OS = (LAS float*)lds;
#pragma unroll 1
    for (int tp = 0; tp < TS; tp += 2) {
        u32x4 qw[2][4]; f32x4 fw[2][8]; float vv[2];
#pragma unroll
        for (int u = 0; u < 2; ++u) {
            const size_t ro = (size_t)(MPR + bs * TS + tp + u) * TOK + hh * HD;
#pragma unroll
            for (int j = 0; j < 4; ++j) qw[u][j] = *(const u32x4*)(QA + ro + kg * 32 + 8 * j);
#pragma unroll
            for (int j = 0; j < 8; ++j) fw[u][j] = *(const f32x4*)(FA + ro + kg * 32 + 4 * j);
            vv[u] = bf2f(VA[ro + v]);
        }
#pragma unroll
        for (int u = 0; u < 2; ++u) {
            float acc = 0.f;
#pragma unroll
            for (int j = 0; j < 8; ++j) {
                const unsigned w0 = qw[u][j >> 1][(j & 1) * 2], w1 = qw[u][j >> 1][(j & 1) * 2 + 1];
                const float q4[4] = {bflo(w0), bfhi(w0), bflo(w1), bfhi(w1)};
#pragma unroll
                for (int e = 0; e < 4; ++e) { const float f = fw[u][j][e]; const int i = 4 * j + e; S[i] = f * S[i] + (1.f - f) * vv[u]; acc += S[i] * q4[e]; }
            }
            acc += __shfl_xor(acc, 16); acc += __shfl_xor(acc, 32);
            if (kg == 0) OS[(tp + u) * HD + v] = acc;
        }
    }
    float* so = a.out + O_HS + ((size_t)(bs * NH + hh) * HD + kg * 32) * HD + v;
#pragma unroll
    for (int i = 0; i < 32; ++i) so[(size_t)i * HD] = S[i];
    __syncthreads();
    if (wave < TS) {
        const int row = MPR + bs * TS + wave;
        const f32x2 o = *(const LAS f32x2*)(OS + wave * HD + 2 * lane);
        const float rs = rsqrtf(wave_sum(o[0] * o[0] + o[1] * o[1]) * (1.f / HD) + EPS);
        const f32x2 gn = *(const f32x2*)(a.in[I_HGN] + hh * HD + 2 * lane);
        const unsigned og = *(const unsigned*)((const bf16*)(a.ws + WS_OGA) + (size_t)row * TOK + hh * HD + 2 * lane);
        *(unsigned*)((bf16*)(a.ws + WS_CAT) + (size_t)row * D + hh * HD + 2 * lane) = pk2(o[0] * rs * gn[0] * bflo(og), o[1] * rs * gn[1] * bfhi(og));
    }
    __syncthreads();
}

constexpr int HG_BUF = 33792;
constexpr int HG_SSQ = 3 * HG_BUF;
#define HG_BAR() asm volatile("s_waitcnt lgkmcnt(0)\n\ts_barrier" ::: "memory")
DI void hgrn_mfma_item(ArgsRef a, LAS unsigned char* lds, int bh, int tid) {
    const int wave = __builtin_amdgcn_readfirstlane(tid >> 6), lane = tid & 63, r = lane & 31, hh = lane >> 5;
    const int b = bh / NH, h = bh - b * NH;
    const size_t img = (size_t)bh * 64 * 4096;
    __syncthreads();
    if (wave >= 4) {
        const int lw = wave - 4;
        const bf16* src[4] = {(const bf16*)(a.ws + WS_QP) + img, (const bf16*)(a.ws + WS_KP) + img, (const bf16*)(a.ws + WS_KT) + img, (const bf16*)(a.ws + WS_VF) + img};
        const float* dvs = (const float*)(a.ws + WS_DV) + (size_t)bh * 64 * 256;
        u32x4 R0[9], R1[9];
        auto gl = [&](u32x4 (&R)[9], int c) {
            c = c < 64 ? c : 63;
#pragma unroll
            for (int j = 0; j < 8; ++j) R[j] = *(const u32x4*)(src[j >> 1] + (size_t)c * 4096 + (size_t)(((j & 1) * 256 + lw * 64 + lane) * 8));
            R[8] = *(const u32x4*)(dvs + (size_t)c * 256 + lane * 4);
        };
        auto lw_ = [&](const u32x4 (&R)[9], int c) {
            LAS unsigned char* bufp = lds + (c % 3) * HG_BUF;
#pragma unroll
            for (int j = 0; j < 8; ++j) *(LAS u32x4*)(bufp + (j >> 1) * 8192 + ((j & 1) * 256 + lw * 64 + lane) * 16) = R[j];
            if (lw == 0) *(LAS u32x4*)(bufp + 32768 + lane * 16) = R[8];
        };
        gl(R0, 0); gl(R1, 1);
        lw_(R0, 0); gl(R0, 2);
        HG_BAR();
        for (int c = 0; c < 64; c += 2) {
            lw_(R1, c + 1); gl(R1, c + 3);
            HG_BAR();
            if (c + 2 < 64) lw_(R0, c + 2);
            gl(R0, c + 4);
            HG_BAR();
        }
    } else {
        __builtin_amdgcn_s_setprio(2);
        const int vb = wave;
        f32x16 S[4]; for (int kb = 0; kb < 4; ++kb) S[kb] = zero16();
        f32x16 Oprev = zero16(); u32x2 ogp[4] = {};
        float gn[16];
#pragma unroll
        for (int i = 0; i < 16; ++i) gn[i] = a.in[I_HGN][h * HD + 32 * vb + crow(i, hh)];
        LAS float* SSQ = (LAS float*)(lds + HG_SSQ);
        const bf16* OGA = (const bf16*)(a.ws + WS_OGA); bf16* CAT = (bf16*)(a.ws + WS_CAT);
        auto finish = [&](int cp) {
            const LAS float* sq = SSQ + (cp & 1) * 128;
            const float ss = (sq[r] + sq[32 + r]) + (sq[64 + r] + sq[96 + r]);
            const float rs = rsqrtf(ss * (1.f / HD) + EPS);
            bf16* orow = CAT + (size_t)(b * TP + cp * 32 + r) * D + h * HD + 32 * vb + 4 * hh;
#pragma unroll
            for (int c4 = 0; c4 < 4; ++c4) {
                const u32x2 g = ogp[c4];
                u32x2 w; w.x = pk2(Oprev[4 * c4] * rs * gn[4 * c4] * bflo(g.x), Oprev[4 * c4 + 1] * rs * gn[4 * c4 + 1] * bfhi(g.x));
                w.y = pk2(Oprev[4 * c4 + 2] * rs * gn[4 * c4 + 2] * bflo(g.y), Oprev[4 * c4 + 3] * rs * gn[4 * c4 + 3] * bfhi(g.y));
                *(u32x2*)(orow + 8 * c4) = w;
            }
        };
        HG_BAR();
        for (int c = 0; c < 64; ++c) {
            const LAS unsigned char* bufp = lds + (c % 3) * HG_BUF;
            const LAS bf16x8* QF = (const LAS bf16x8*)bufp + lane; const LAS bf16x8* KF = (const LAS bf16x8*)(bufp + 8192) + lane;
            const LAS bf16x8* TF = (const LAS bf16x8*)(bufp + 16384) + lane; const LAS bf16x8* VF = (const LAS bf16x8*)(bufp + 24576) + lane;
            const LAS float* dvec = (const LAS float*)(bufp + 32768);
            if (c > 0) finish(c - 1);
            { const bf16* ogr = OGA + (size_t)(b * TP + c * 32 + r) * TOK + h * HD + 32 * vb + 4 * hh;
#pragma unroll
              for (int c4 = 0; c4 < 4; ++c4) ogp[c4] = *(const u32x2*)(ogr + 8 * c4); }
            f32x16 X = zero16();
#pragma unroll
            for (int f = 0; f < 8; ++f) X = MFMA32(KF[f * 64], QF[f * 64], X);
#pragma unroll
            for (int i = 0; i < 16; ++i) X[i] = crow(i, hh) <= r ? X[i] : 0.f;
            const bf16x8 v0 = VF[(0 * 4 + vb) * 64], v1 = VF[(1 * 4 + vb) * 64];
            f32x16 O = zero16();
            O = MFMA32(v0, packp(X, 0), O); O = MFMA32(v1, packp(X, 1), O);
#pragma unroll
            for (int kb = 0; kb < 4; ++kb) {
                f32x16 T;
#pragma unroll
                for (int c4 = 0; c4 < 4; ++c4) { const f32x4 e1 = *(const LAS f32x4*)(dvec + 128 + 32 * kb + 8 * c4 + 4 * hh);
#pragma unroll
                    for (int e = 0; e < 4; ++e) T[4 * c4 + e] = S[kb][4 * c4 + e] * e1[e]; }
                O = MFMA32(packp(T, 0), QF[(kb * 2 + 0) * 64], O); O = MFMA32(packp(T, 1), QF[(kb * 2 + 1) * 64], O);
            }
            { float q = 0.f;
#pragma unroll
              for (int i = 0; i < 16; ++i) q += O[i] * O[i];
              q += __shfl_xor(q, 32);
              if (hh == 0) SSQ[(c & 1) * 128 + vb * 32 + r] = q; }
            Oprev = O;
#pragma unroll
            for (int kb = 0; kb < 4; ++kb) {
                f32x16 U = zero16();
                U = MFMA32(TF[(0 * 4 + kb) * 64], v0, U); U = MFMA32(TF[(1 * 4 + kb) * 64], v1, U);
#pragma unroll
                for (int c4 = 0; c4 < 4; ++c4) { const f32x4 dd = *(const LAS f32x4*)(dvec + 32 * kb + 8 * c4 + 4 * hh);
#pragma unroll
                    for (int e = 0; e < 4; ++e) S[kb][4 * c4 + e] = S[kb][4 * c4 + e] * dd[e] + U[4 * c4 + e]; }
            }
            HG_BAR();
        }
        finish(63);
        __builtin_amdgcn_s_setprio(0);
        float* so = a.out + O_HP + (size_t)bh * HD * HD + 32 * vb + r;
#pragma unroll
        for (int kb = 0; kb < 4; ++kb)
#pragma unroll
            for (int i = 0; i < 16; ++i) so[(size_t)(32 * kb + crow(i, hh)) * HD] = S[kb][i];
    }
    __syncthreads();
}

template <bool FIRST, bool LAST>
DI void normpass(ArgsRef a, const float* gain, int gw, int ngw, int lane) {
    const bf16* OB = (const bf16*)(a.ws + WS_OB); bf16* H = (bf16*)(a.ws + WS_H); bf16* XN = (bf16*)(a.ws + WS_XN);
    f32x4 g4[8];
#pragma unroll
    for (int j = 0; j < 8; ++j) g4[j] = ((const f32x4*)gain)[lane + 64 * j];
    u32x2 ow[8], own[8]; f32x4 hf[8], hfn[8]; u32x2 hw[8], hwn[8];
    auto ldrow = [&](int m, u32x2 (&o_)[8], f32x4 (&hf_)[8], u32x2 (&hw_)[8]) {
        const u32x2* orow = (const u32x2*)(OB + (size_t)m * D) + lane;
#pragma unroll
        for (int j = 0; j < 8; ++j) o_[j] = orow[64 * j];
        if (FIRST) { const float* hrow = m < MPR ? a.in[I_XP] + (size_t)m * D : a.in[I_XS] + (size_t)(m - MPR) * D;
#pragma unroll
            for (int j = 0; j < 8; ++j) hf_[j] = ((const f32x4*)hrow)[lane + 64 * j]; }
        else { const u32x2* hrow = (const u32x2*)(H + (size_t)m * D) + lane;
#pragma unroll
            for (int j = 0; j < 8; ++j) hw_[j] = hrow[64 * j]; }
    };
    if (gw < MR) ldrow(gw, ow, hf, hw);
    for (int m = gw; m < MR; m += ngw) {
        if (m + ngw < MR) ldrow(m + ngw, own, hfn, hwn);
        f32x4 o[8], hv[8]; float ss = 0.f;
#pragma unroll
        for (int j = 0; j < 8; ++j) { hv[j] = FIRST ? hf[j] : (f32x4){bflo(hw[j].x), bfhi(hw[j].x), bflo(hw[j].y), bfhi(hw[j].y)};
            o[j] = (f32x4){bflo(ow[j].x), bfhi(ow[j].x), bflo(ow[j].y), bfhi(ow[j].y)};
            ss += (o[j][0] * o[j][0] + o[j][1] * o[j][1]) + (o[j][2] * o[j][2] + o[j][3] * o[j][3]); }
        const float rs = rsqrtf(wave_sum(ss) * (1.f / D) + EPS);
        float s2 = 0.f;
#pragma unroll
        for (int j = 0; j < 8; ++j) { hv[j] = hv[j] + o[j] * rs * g4[j]; s2 += (hv[j][0] * hv[j][0] + hv[j][1] * hv[j][1]) + (hv[j][2] * hv[j][2] + hv[j][3] * hv[j][3]); }
        if (LAST) {
            float* y = m < MPR ? a.out + O_YP + (size_t)m * D : a.out + O_YS + (size_t)(m - MPR) * D;
#pragma unroll
            for (int j = 0; j < 8; ++j) ((f32x4*)y)[lane + 64 * j] = hv[j];
        } else {
            const float r2 = rsqrtf(wave_sum(s2) * (1.f / D) + EPS);
            u32x2* xo = (u32x2*)(XN + (size_t)m * D) + lane;
#pragma unroll
            for (int j = 0; j < 8; ++j) { u32x2 hw; hw.x = pk2(hv[j][0], hv[j][1]); hw.y = pk2(hv[j][2], hv[j][3]); ((u32x2*)(H + (size_t)m * D))[lane + 64 * j] = hw;
                u32x2 w; w.x = pk2(hv[j][0] * r2, hv[j][1] * r2); w.y = pk2(hv[j][2] * r2, hv[j][3] * r2); xo[64 * j] = w; }
        }
#pragma unroll
        for (int j = 0; j < 8; ++j) { ow[j] = own[j]; if (FIRST) hf[j] = hfn[j]; else hw[j] = hwn[j]; }
    }
}

DI f32x4 cvlo(u32x4 w) { return (f32x4){bflo(w.x), bfhi(w.x), bflo(w.y), bfhi(w.y)}; }
DI f32x4 cvhi(u32x4 w) { return (f32x4){bflo(w.z), bfhi(w.z), bflo(w.w), bfhi(w.w)}; }
DI void ffn_fixup(ArgsRef a, int layer, int gtid, int nthr) {
    const float* FIX = (const float*)(a.ws + WS_FIX); const float* HALO = (const float*)(a.ws + WS_HALO); bf16* HID = (bf16*)(a.ws + WS_HID);
    const float* wc = a.in[I_WCONV] + (size_t)layer * 3 * FF; const float* bc = a.in[I_BCONV] + (size_t)layer * FF;
    constexpr int C8 = FF / 8;
    for (int it = gtid; it < 512 * C8; it += nthr) {
        const int ri = it / C8, c8 = (it - ri * C8) * 8, blk = ri >> 1, i = ri & 1, row = blk * 64 + i, t = row & (TP - 1);
        const float* fp = FIX + ((size_t)ri * 2) * FF + c8;
        f32x4 cl = *(const f32x4*)(bc + c8), ch = *(const f32x4*)(bc + c8 + 4);
        cl += *(const f32x4*)(wc + 2 * FF + c8) * *(const f32x4*)fp; ch += *(const f32x4*)(wc + 2 * FF + c8 + 4) * *(const f32x4*)(fp + 4);
        if (t >= 1) { const float* p1 = i == 0 ? HALO + ((size_t)((blk - 1) * 2 + 1)) * FF + c8 : FIX + ((size_t)(blk * 2) * 2) * FF + c8;
            cl += *(const f32x4*)(wc + FF + c8) * *(const f32x4*)p1; ch += *(const f32x4*)(wc + FF + c8 + 4) * *(const f32x4*)(p1 + 4); }
        if (t >= 2) { const float* p0 = HALO + ((size_t)((blk - 1) * 2 + i)) * FF + c8;
            cl += *(const f32x4*)(wc + c8) * *(const f32x4*)p0; ch += *(const f32x4*)(wc + c8 + 4) * *(const f32x4*)(p0 + 4); }
        const f32x4 gl = *(const f32x4*)(fp + FF), gh = *(const f32x4*)(fp + FF + 4);
#pragma unroll
        for (int e = 0; e < 4; ++e) { cl[e] = gelu_t(cl[e]) * gl[e]; ch[e] = gelu_t(ch[e]) * gh[e]; }
        *(u32x4*)(HID + (size_t)row * FF + c8) = pack8(cl, ch);
    }
}
DI void gating_pass(ArgsRef a, int layer, int gtid, int nthr) {
    const bf16* AB = (const bf16*)(a.ws + WS_AB); bf16* HID = (bf16*)(a.ws + WS_HID);
    const float* wc = a.in[I_WCONV] + (size_t)layer * 3 * FF; const float* bc = a.in[I_BCONV] + (size_t)layer * FF;
    constexpr int C8 = FF / 8;
    for (int it = gtid; it < MSR * C8; it += nthr) {
        const int row = MPR + it / C8, c8 = (it % C8) * 8;
        const bool prm = row < MPR; const int t = prm ? (row & (TP - 1)) : ((row - MPR) & 3);
        const bf16* ar = AB + (size_t)row * FF2 + c8;
        const u32x4 wa = *(const u32x4*)ar, wb = *(const u32x4*)(ar + FF);
        f32x4 e2l = cvlo(wa), e2h = cvhi(wa), e1l, e1h, e0l, e0h;
        const float* cb = prm ? nullptr : a.in[I_CCONV] + ((size_t)(layer * BS + ((row - MPR) >> 2)) * 2) * FF + c8;
        if (t >= 1) { const u32x4 w = *(const u32x4*)(ar - FF2); e1l = cvlo(w); e1h = cvhi(w); }
        else if (prm) { e1l = (f32x4){0.f, 0.f, 0.f, 0.f}; e1h = e1l; }
        else { e1l = *(const f32x4*)(cb + FF); e1h = *(const f32x4*)(cb + FF + 4); }
        if (t >= 2) { const u32x4 w = *(const u32x4*)(ar - 2 * FF2); e0l = cvlo(w); e0h = cvhi(w); }
        else if (prm) { e0l = (f32x4){0.f, 0.f, 0.f, 0.f}; e0h = e0l; }
        else { e0l = *(const f32x4*)(cb + (size_t)t * FF); e0h = *(const f32x4*)(cb + (size_t)t * FF + 4); }
        const f32x4 w0l = *(const f32x4*)(wc + c8), w0h = *(const f32x4*)(wc + c8 + 4), w1l = *(const f32x4*)(wc + FF + c8), w1h = *(const f32x4*)(wc + FF + c8 + 4);
        const f32x4 w2l = *(const f32x4*)(wc + 2 * FF + c8), w2h = *(const f32x4*)(wc + 2 * FF + c8 + 4), bl = *(const f32x4*)(bc + c8), bh = *(const f32x4*)(bc + c8 + 4);
        f32x4 cl = bl + w0l * e0l + w1l * e1l + w2l * e2l, ch = bh + w0h * e0h + w1h * e1h + w2h * e2h;
        const f32x4 gbl = cvlo(wb), gbh = cvhi(wb);
#pragma unroll
        for (int e = 0; e < 4; ++e) { cl[e] = gelu_t(cl[e]) * gbl[e]; ch[e] = gelu_t(ch[e]) * gbh[e]; }
        *(u32x4*)(HID + (size_t)row * FF + c8) = pack8(cl, ch);
    }
}

DI float alibi_slope2(int head) { return exp2f(-8.f * (float)(head + 1) / 12.f) * LOG2E; }

DI void nsa_cmp_wg(ArgsRef a, LAS unsigned char* lds, int p, int tid) {
    const int wave = __builtin_amdgcn_readfirstlane(tid >> 6), lane = tid & 63;
    const int r = lane & 31, h = lane >> 5;
    const int bg = p >> 3, jq = (p & 7) * 4 + (wave & 3), tau = wave < 4 ? 63 - jq : jq, ntile = (tau >> 4) + 1, b = bg >> 1, g = bg & 1, t0 = tau * 32, row = b * TP + t0 + r, qpos = t0 + r;
    const bf16* QB = (const bf16*)(a.ws + WS_QB); const float* GATES = (const float*)(a.ws + WS_GATES);
    bf16* OCMP = (bf16*)(a.ws + WS_OCMP);
    __syncthreads();
    { const u32x4* kc = (const u32x4*)((const bf16*)(a.ws + WS_KC) + (size_t)bg * 16384); const u32x4* vc = (const u32x4*)((const bf16*)(a.ws + WS_VCT) + (size_t)bg * 16384);
      u32x4 tk[4], tv[4];
#pragma unroll
      for (int j = 0; j < 4; ++j) { tk[j] = kc[j * NTHR + tid]; tv[j] = vc[j * NTHR + tid]; }
#pragma unroll
      for (int j = 0; j < 4; ++j) { ((LAS u32x4*)lds)[j * NTHR + tid] = tk[j]; ((LAS u32x4*)(lds + 32768))[j * NTHR + tid] = tv[j]; } }
    __syncthreads();
    const LAS bf16x8* KL = (const LAS bf16x8*)lds + lane; const LAS bf16x8* VL = (const LAS bf16x8*)(lds + 32768) + lane;
    LAS float* CL = (LAS float*)(lds + 65536 + wave * 8192);
    for (int u = ntile * 512 + lane; u < 2048; u += 64) CL[u] = 0.f;
    for (int hr = 0; hr < HPG; ++hr) {
        const int head = g * HPG + hr; const float slope2 = alibi_slope2(head);
        bf16x8 qf[8]; load_qf(qf, QB + (size_t)row * TOK + head * HD, h);
        float m = -1e30f, l = 0.f;
#pragma unroll 1
        for (int kt = 0; kt < ntile; ++kt) {
            f32x16 s = zero16();
#pragma unroll
            for (int ks = 0; ks < 8; ++ks) s = MFMA32(KL[(kt * 8 + ks) * 64], qf[ks], s);
            float mt = -1e30f;
#pragma unroll
            for (int i = 0; i < 16; ++i) {
                const int n = 32 * kt + crow(i, h), kp = 16 * n + 31;
                float v = s[i] * SCALE2 + slope2 * (float)(kp - t0);
                v = (n < NCP && kp <= qpos) ? v : -1e30f;
                s[i] = v; mt = fmaxf(mt, v);
            }
            mt = fmaxf(mt, __shfl_xor(mt, 32));
            const float mn = fmaxf(m, mt); float ls = 0.f;
#pragma unroll
            for (int i = 0; i < 16; ++i) ls += s[i] > -1e29f ? __builtin_amdgcn_exp2f(s[i] - mn) : 0.f;
            l = l * __builtin_amdgcn_exp2f(m - mn) + ls; m = mn;
        }
        l += __shfl_xor(l, 32);
        const float inv = l > 0.f ? 1.f / l : 0.f;
        f32x16 o[4];
#pragma unroll
        for (int db = 0; db < 4; ++db) o[db] = zero16();
#pragma unroll 1
        for (int kt = 0; kt < ntile; ++kt) {
            f32x16 s = zero16();
#pragma unroll
            for (int ks = 0; ks < 8; ++ks) s = MFMA32(KL[(kt * 8 + ks) * 64], qf[ks], s);
#pragma unroll
            for (int i = 0; i < 16; ++i) {
                const int n = 32 * kt + crow(i, h), kp = 16 * n + 31;
                const float v = s[i] * SCALE2 + slope2 * (float)(kp - t0);
                s[i] = (n < NCP && kp <= qpos) ? __builtin_amdgcn_exp2f(v - m) * inv : 0.f;
            }
#pragma unroll
            for (int c = 0; c < 4; ++c) {
                const float co = (s[4 * c] + s[4 * c + 1]) + (s[4 * c + 2] + s[4 * c + 3]), la = s[4 * c + 3];
                LAS float* cp = CL + ((kt * 4 + c) * 2) * 64 + lane;
                if (hr == 0) { cp[0] = co; cp[64] = la; } else { cp[0] += co; cp[64] += la; }
            }
#pragma unroll
            for (int st = 0; st < 2; ++st) { const bf16x8 pf = packp(s, st);
#pragma unroll
                for (int db = 0; db < 4; ++db) o[db] = MFMA32(VL[(kt * 8 + st * 4 + db) * 64], pf, o[db]); }
        }
        const float g0 = GATES[(size_t)row * 40 + head * 3 + 0];
#pragma unroll
        for (int db = 0; db < 4; ++db) o[db] *= g0;
        store_ot(OCMP + (size_t)row * TOK + head * HD, o, h);
    }
    LDS_WAIT(); asm volatile("" ::: "memory");
    float core[16], last[16];
#pragma unroll
    for (int idx = 0; idx < 16; ++idx) {
        core[idx] = CL[(idx * 2) * 64 + lane]; last[idx] = CL[(idx * 2 + 1) * 64 + lane];
    }
    LDS_WAIT(); asm volatile("" ::: "memory");
    const int cur = qpos >> 6;
    float sc[16], osc[16];
#pragma unroll
    for (int idx = 0; idx < 16; ++idx) {
        const float x = __shfl_xor(last[idx], 32);
        float xp = 0.f; if (idx > 0) xp = __shfl_xor(last[idx > 0 ? idx - 1 : 0], 32);
        const float prev = h ? x : xp;
        const int j = 2 * idx + h;
        const bool valid = j <= cur, forced = (j == 0) || (j == cur) || (j == cur - 1);
        sc[idx] = valid ? (core[idx] + prev) + (forced ? 1e4f : 0.f) : -1e30f;
    }
#pragma unroll
    for (int idx = 0; idx < 16; ++idx) osc[idx] = __shfl_xor(sc[idx], 32);
    unsigned mask = 0u;
#pragma unroll
    for (int idx = 0; idx < 16; ++idx) {
        const int j = 2 * idx + h; const float me = sc[idx]; int rank = 0;
#pragma unroll
        for (int k = 0; k < 16; ++k) {
            const int j1 = 2 * k + h, j2 = 2 * k + 1 - h;
            rank += (sc[k] > me || (sc[k] == me && j1 < j)) ? 1 : 0;
            rank += (osc[k] > me || (osc[k] == me && j2 < j)) ? 1 : 0;
        }
        if (rank < 16 && j <= cur) mask |= 1u << j;
    }
    mask |= __shfl_xor(mask, 32);
    if (h == 0) ((unsigned*)(a.ws + WS_SELM))[(size_t)row * 2 + g] = mask;
}

DI void nsa_selwin_item(ArgsRef a, int it, LAS float* stash, int lane) {
    const int r = lane & 31, h = lane >> 5;
    const int hr = it % HPG, bg = (it / HPG) & 15, tau = 63 - it / (HPG * 16);
    const int b = bg >> 1, g = bg & 1, head = g * HPG + hr, t0 = tau * 32, row = b * TP + t0 + r, qpos = t0 + r;
    const float slope2 = alibi_slope2(head);
    const bf16* QB = (const bf16*)(a.ws + WS_QB); const float* GATES = (const float*)(a.ws + WS_GATES);
    const size_t kvo = (size_t)bg * TP * HD;
    const bf16* KSEL = (const bf16*)(a.ws + WS_KSEL) + kvo; const bf16* VSELT = (const bf16*)(a.ws + WS_VSELT) + kvo;
    const bf16* KWIN = (const bf16*)(a.ws + WS_KWIN) + kvo; const bf16* VWINT = (const bf16*)(a.ws + WS_VWINT) + kvo;
    LAS bf16x8* ql = (LAS bf16x8*)(stash + 2048);
    { bf16x8 qf[8]; load_qf(qf, QB + (size_t)row * TOK + head * HD, h);
#pragma unroll
      for (int ks = 0; ks < 8; ++ks) ql[ks * 64 + lane] = qf[ks]; }
    LDS_WAIT(); asm volatile("" ::: "memory");
    LAS unsigned* stu = (LAS unsigned*)stash;
    const unsigned selm = ((const unsigned*)(a.ws + WS_SELM))[(size_t)row * 2 + g];
    unsigned um = selm;
#pragma unroll
    for (int o = 1; o < 64; o <<= 1) um |= __shfl_xor(um, o);
    um = __builtin_amdgcn_readfirstlane(um);
    unsigned long long x = um;
    x = (x | (x << 16)) & 0x0000FFFF0000FFFFull; x = (x | (x << 8)) & 0x00FF00FF00FF00FFull; x = (x | (x << 4)) & 0x0F0F0F0F0F0F0F0Full;
    x = (x | (x << 2)) & 0x3333333333333333ull; x = (x | (x << 1)) & 0x5555555555555555ull;
    const unsigned long long causal = tau >= 63 ? ~0ull : ((1ull << (tau + 1)) - 1ull);
    const unsigned long long tsel = (x | (x << 1)) & causal;
    const int wlo = tau > 16 ? tau - 16 : 0;
    const unsigned long long twin = causal & ~((1ull << wlo) - 1ull);
    {
        AttnAcc A; attn_init(A);
        attn_run(A, ql, KSEL, VSELT, tsel, slope2, t0, [&](int kt, int kvl) { return ((selm >> (kt >> 1)) & 1u) && (kt * 32 + kvl <= qpos); },
                 [&](int kt) { return kt < tau && __all((selm >> (kt >> 1)) & 1u); }, lane);
        const float g1 = GATES[(size_t)row * 40 + head * 3 + 1] * attn_inv(A);
#pragma unroll
        for (int db = 0; db < 4; ++db)
#pragma unroll
            for (int i = 0; i < 16; i += 2) stu[(db * 8 + (i >> 1)) * 64 + lane] = pk2(A.o[db][i] * g1, A.o[db][i + 1] * g1);
    }
    f32x16 out[4];
    {
        AttnAcc A; attn_init(A);
        attn_run(A, ql, KWIN, VWINT, twin, slope2, t0, [&](int kt, int kvl) { const int dist = qpos - (kt * 32 + kvl); return dist >= 0 && dist < 512; },
                 [&](int kt) { return kt < tau && kt > tau - 16; }, lane);
        const float g2 = GATES[(size_t)row * 40 + head * 3 + 2] * attn_inv(A);
        LDS_WAIT();
#pragma unroll
        for (int db = 0; db < 4; ++db)
#pragma unroll
            for (int i = 0; i < 16; i += 2) { const unsigned w = stu[(db * 8 + (i >> 1)) * 64 + lane]; out[db][i] = bflo(w) + A.o[db][i] * g2; out[db][i + 1] = bfhi(w) + A.o[db][i + 1] * g2; }
    }
    const bf16* oc = (const bf16*)(a.ws + WS_OCMP) + (size_t)row * TOK + head * HD;
    bf16* orow = (bf16*)(a.ws + WS_CAT) + (size_t)row * D + head * HD;
#pragma unroll
    for (int db = 0; db < 4; ++db)
#pragma unroll
        for (int c = 0; c < 4; ++c) {
            const int d = 32 * db + 8 * c + 4 * h;
            const u32x2 w = *(const u32x2*)(oc + d);
            u32x2 o; o.x = pk2(out[db][4 * c] + bflo(w.x), out[db][4 * c + 1] + bfhi(w.x)); o.y = pk2(out[db][4 * c + 2] + bflo(w.y), out[db][4 * c + 3] + bfhi(w.y));
            *(u32x2*)(orow + d) = o;
        }
}

constexpr int SCLD = 1040;
template <int NQ, class KP, class VP, class BF>
DI void wg_attend(LAS float* Qs, LAS float* SC, LAS float* RED, int nkeys, const KP& kptr, const VP& vptr, const BF& bias, int tid) {
    const int wave = tid >> 6, lane = tid & 63;
    {
        const int ks = tid >> 3, sub = tid & 7;
        for (int n0 = 0; n0 < nkeys; n0 += 128) {
            f32x4 k4[2][4]; int nn[2]; bool act[2];
#pragma unroll
            for (int u = 0; u < 2; ++u) { nn[u] = n0 + 64 * u + ks; act[u] = nn[u] < nkeys; const float* kp = kptr(act[u] ? nn[u] : nkeys - 1);
#pragma unroll
                for (int i = 0; i < 4; ++i) k4[u][i] = *(const f32x4*)(kp + 4 * sub + 32 * i); }
#pragma unroll
            for (int u = 0; u < 2; ++u) {
                float part[NQ];
#pragma unroll
                for (int j = 0; j < NQ; ++j) part[j] = 0.f;
#pragma unroll
                for (int i = 0; i < 4; ++i)
#pragma unroll
                    for (int j = 0; j < NQ; ++j) { const f32x4 q4 = *(const LAS f32x4*)(Qs + j * 128 + 4 * sub + 32 * i); part[j] += (k4[u][i][0] * q4[0] + k4[u][i][1] * q4[1]) + (k4[u][i][2] * q4[2] + k4[u][i][3] * q4[3]); }
#pragma unroll
                for (int j = 0; j < NQ; ++j) { float p = part[j]; p += __shfl_xor(p, 1); p += __shfl_xor(p, 2); p += __shfl_xor(p, 4);
                    if (sub == 0 && act[u]) { const float bb = bias(j, nn[u]); SC[j * SCLD + nn[u]] = bb > -1e29f ? p * SCALE2 + bb : -1e30f; } }
            }
        }
    }
    __syncthreads();
    for (int j = wave; j < NQ; j += NWAVES) {
        float m = -1e30f;
        for (int n = lane; n < nkeys; n += 64) m = fmaxf(m, SC[j * SCLD + n]);
        m = wave_max(m);
        float l = 0.f;
        for (int n = lane; n < nkeys; n += 64) { const float s = SC[j * SCLD + n]; const float p = s > -1e29f ? __builtin_amdgcn_exp2f(s - m) : 0.f; SC[j * SCLD + n] = p; l += p; }
        l = wave_sum(l);
        const float inv = l > 0.f ? 1.f / l : 0.f;
        for (int n = lane; n < nkeys; n += 64) SC[j * SCLD + n] *= inv;
    }
    __syncthreads();
    {
        const int part = tid >> 5, dq = tid & 31;
        f32x4 acc[NQ];
#pragma unroll
        for (int j = 0; j < NQ; ++j) acc[j] = (f32x4){0.f, 0.f, 0.f, 0.f};
        for (int n0 = part; n0 < nkeys; n0 += 128) {
            f32x4 v4[8];
#pragma unroll
            for (int u = 0; u < 8; ++u) { const int n = n0 + 16 * u; v4[u] = *(const f32x4*)(vptr(n < nkeys ? n : nkeys - 1) + 4 * dq); }
#pragma unroll
            for (int u = 0; u < 8; ++u) { const int n = n0 + 16 * u;
                if (n < nkeys) {
#pragma unroll
                    for (int j = 0; j < NQ; ++j) acc[j] += SC[j * SCLD + n] * v4[u]; } }
        }
#pragma unroll
        for (int j = 0; j < NQ; ++j) *(LAS f32x4*)(RED + ((part * NQ + j) * 128 + 4 * dq)) = acc[j];
    }
    __syncthreads();
    for (int o = tid; o < NQ * 128; o += NTHR) {
        float s = 0.f;
#pragma unroll
        for (int p = 1; p < 16; ++p) s += RED[p * NQ * 128 + o];
        RED[o] += s;
    }
    __syncthreads();
}
constexpr int SN_Q = 0, SN_SC = 768, SN_RED = SN_SC + 6 * SCLD, SN_IMP = SN_RED + 16 * 6 * 128, SN_PS = SN_IMP + 520, SN_IDX = SN_PS + 136;
static_assert((SN_IDX + 64) * 4 <= RING_BYTES, "sample NSA LDS map");

DI void sn_load_q(ArgsRef a, LAS float* Qs, int srow, int g, int tid) {
    const bf16* QB = (const bf16*)(a.ws + WS_QB) + (size_t)(MPR + srow) * TOK + g * HPG * HD;
    for (int o = tid; o < HPG * HD; o += NTHR) Qs[o] = bf2f(QB[o]);
}
DI void sn_cmp_item(ArgsRef a, LAS unsigned char* lds, int it, int tid) {
    const int b = it >> 3, g = (it >> 2) & 1, t = it & 3, srow = b * 4 + t, qpos = PAST + t;
    LAS float* L = (LAS float*)lds; LAS float* Qs = L + SN_Q; LAS float* SC = L + SN_SC; LAS float* RED = L + SN_RED; LAS float* IMP = L + SN_IMP; LAS float* PS = L + SN_PS;
    __syncthreads();
    sn_load_q(a, Qs, srow, g, tid);
    __syncthreads();
    const float* kc = (const float*)(a.ws + WS_KCS) + (size_t)(b * 2 + g) * 512 * 128; const float* vc = (const float*)(a.ws + WS_VCS) + (size_t)(b * 2 + g) * 512 * 128;
    wg_attend<HPG>(Qs, SC, RED, NCS, [&](int n) { return kc + (size_t)n * 128; }, [&](int n) { return vc + (size_t)n * 128; },
                   [&](int j, int n) { const int kp = 16 * n + 31; return kp <= qpos ? -alibi_slope2(g * HPG + j) * (float)(qpos - kp) : -1e30f; }, tid);
    const float* GATES = (const float*)(a.ws + WS_GATES) + (size_t)(MPR + srow) * 40;
    float* SOC = (float*)(a.ws + WS_SOC) + (size_t)srow * TOK + g * HPG * HD;
    for (int o = tid; o < HPG * HD; o += NTHR) SOC[o] = RED[o] * GATES[(g * HPG + (o >> 7)) * 3 + 0];
    for (int n = tid; n < 520; n += NTHR) { float s = 0.f; if (n < NCS) { for (int j = 0; j < HPG; ++j) s += SC[j * SCLD + n]; } IMP[n] = s; }
    __syncthreads();
    if (tid < NSS) { const int j = tid; float s = 0.f;
        for (int n = 4 * j - 1; n <= 4 * j + 3; ++n) if (n >= 0 && n < NCS) s += IMP[n];
        const bool forced = (j == 0) || (j == NSS - 1) || (j == NSS - 2);
        PS[j] = s + (forced ? 1e4f : 0.f); }
    __syncthreads();
    if (tid < NSS) { const float me = PS[tid]; int rank = 0;
        for (int k = 0; k < NSS; ++k) { const float o = PS[k]; rank += (o > me || (o == me && k < tid)) ? 1 : 0; }
        if (rank < 16) ((int*)(a.ws + WS_SIDX))[(size_t)(srow * 2 + g) * 16 + rank] = tid; }
}
DI void sn_selwin_item(ArgsRef a, LAS unsigned char* lds, int it, int tid) {
    const int b = it >> 3, g = (it >> 2) & 1, t = it & 3, srow = b * 4 + t, qpos = PAST + t;
    LAS float* L = (LAS float*)lds; LAS float* Qs = L + SN_Q; LAS float* SC = L + SN_SC; LAS float* RED = L + SN_RED; LAS int* IDX = (LAS int*)(L + SN_IDX);
    __syncthreads();
    sn_load_q(a, Qs, srow, g, tid);
    if (tid < 16) { const int blk = ((const int*)(a.ws + WS_SIDX))[(size_t)(srow * 2 + g) * 16 + tid]; IDX[tid] = blk;
        IDX[16 + tid] = blk < 128 ? ((const int*)a.in[I_PT])[b * NPAGE + (blk >> 1)] : 0; }
    __syncthreads();
    const float* ckv = a.in[I_CKV]; const float* nkv = a.out + O_KVS + (size_t)(b * 4) * 1024;
    auto selrow = [&](int n, int kind) -> const float* {
        const int sb = n >> 6, s = n & 63, blk = IDX[sb];
        if (blk < 128) return ckv + ((size_t)IDX[16 + sb] * PAGE + (blk & 1) * 64 + s) * 1024 + kind * 256 + g * 128;
        return nkv + (size_t)(s < 4 ? s : 3) * 1024 + kind * 256 + g * 128;
    };
    wg_attend<HPG>(Qs, SC, RED, 1024, [&](int n) { return selrow(n, 2); }, [&](int n) { return selrow(n, 3); },
                   [&](int j, int n) { const int kp = IDX[n >> 6] * 64 + (n & 63); return kp <= qpos ? -alibi_slope2(g * HPG + j) * (float)(qpos - kp) : -1e30f; }, tid);
    const float* GATES = (const float*)(a.ws + WS_GATES) + (size_t)(MPR + srow) * 40;
    float acc[2];
    { const float* SOC = (const float*)(a.ws + WS_SOC) + (size_t)srow * TOK + g * HPG * HD;
      for (int q = 0; q < 2; ++q) { const int o = tid + q * NTHR; acc[q] = o < HPG * HD ? SOC[o] + RED[o] * GATES[(g * HPG + (o >> 7)) * 3 + 1] : 0.f; } }
    __syncthreads();
    const float* cw = a.in[I_CWIN] + (size_t)b * 512 * 512; const float* nw = a.out + O_WS + (size_t)(b * 4) * 512;
    auto winrow = [&](int n, int kind) -> const float* { return n < 512 ? cw + (size_t)n * 512 + kind * 256 + g * 128 : nw + (size_t)(n - 512) * 512 + kind * 256 + g * 128; };
    wg_attend<HPG>(Qs, SC, RED, 516, [&](int n) { return winrow(n, 0); }, [&](int n) { return winrow(n, 1); },
                   [&](int j, int n) { const int dist = qpos - (PAST - 512 + n); return (dist >= 0 && dist < 512) ? -alibi_slope2(g * HPG + j) * (float)dist : -1e30f; }, tid);
    bf16* CAT = (bf16*)(a.ws + WS_CAT) + (size_t)(MPR + srow) * D + g * HPG * HD;
    for (int q = 0; q < 2; ++q) { const int o = tid + q * NTHR; if (o < HPG * HD) CAT[o] = f2bf(acc[q] + RED[o] * GATES[(g * HPG + (o >> 7)) * 3 + 2]); }
}

constexpr int SM_O = 0, SM_Q = RING_BYTES + 2048, SM_ML = SM_Q + 8192, SM_LIST = SM_ML + 2048, SM_MEMB = SM_LIST + 256, SM_UB = SM_MEMB + 544, SM_PG = SM_UB + 32;
static_assert(SM_PG + 256 <= LDS_BYTES && MISC_OFF + 256 <= RING_BYTES + 2048, "sample NSA (MFMA) LDS map");
DI void sn_selwin_mfma(ArgsRef a, LAS unsigned char* lds, int bg, int tid) {
    const int wave = __builtin_amdgcn_readfirstlane(tid >> 6), lane = tid & 63, r = lane & 31, h = lane >> 5;
    const int b = bg >> 1, g = bg & 1, t = r >> 3, js = r & 7, j = js < HPG ? js : HPG - 1, head = g * HPG + j, srow = b * 4 + t, qpos = PAST + t;
    LAS bf16x8* ql = (LAS bf16x8*)(lds + SM_Q); LAS int* LIST = (LAS int*)(lds + SM_LIST); LAS unsigned* MEMB = (LAS unsigned*)(lds + SM_MEMB); LAS unsigned* UB = (LAS unsigned*)(lds + SM_UB);
    LAS int* PG = (LAS int*)(lds + SM_PG); LAS float* ML = (LAS float*)(lds + SM_ML); LAS float* OB = (LAS float*)(lds + SM_O);
    __syncthreads();
    if (wave == 0) LIST[lane] = ((const int*)(a.ws + WS_SIDX))[(size_t)((b * 4 + (lane >> 4)) * 2 + g) * 16 + (lane & 15)];
    if (wave == 1) PG[lane] = ((const int*)a.in[I_PT])[b * NPAGE + lane];
    if (wave == 2) { bf16x8 qf[8]; load_qf(qf, (const bf16*)(a.ws + WS_QB) + (size_t)(MPR + srow) * TOK + head * HD, h);
#pragma unroll
        for (int ks = 0; ks < 8; ++ks) ql[ks * 64 + lane] = qf[ks]; }
    __syncthreads();
    if (tid < 136) { unsigned m = 0u; for (int e = 0; e < 64; ++e) m |= (LIST[e] == tid) ? (1u << (e >> 4)) : 0u; MEMB[tid] = m; }
    __syncthreads();
    if (tid < 8) { unsigned u = 0u; for (int e = 0; e < 32; ++e) { const int blk = 32 * tid + e; u |= (blk < 136 && MEMB[blk] != 0u) ? (1u << e) : 0u; } UB[tid] = u; }
    __syncthreads();
    const float slope2 = alibi_slope2(head);
    auto run_tile = [&](AttnAcc& A, const float* kb, const float* vb, int stride, int nvalid, int pos0, bool member, int maxdist) {
        asm volatile("" : "+s"(stride), "+s"(nvalid) :: "memory");
        {
            LAS unsigned* vl = (LAS unsigned*)(lds + wave * 16384);
            const float* vbl = vb + (unsigned)(h * stride + 4 * r);
            const int lastpair = (nvalid >> 1) - 1;
#pragma unroll
            for (int i = 0; i < 16; ++i) { const int i2 = i < lastpair ? i : lastpair;
                __builtin_amdgcn_global_load_lds((const unsigned*)(vbl + (size_t)(2 * i2 * stride)), vl + i * 256, 16, 0, 0); }
        }
        f32x16 s = zero16();
        { const int kr = r < nvalid ? r : nvalid - 1; const float* kp = kb + (unsigned)(kr * stride + 8 * h);
#pragma unroll
          for (int hk = 0; hk < 2; ++hk) {
              f32x4 kq[4][2];
#pragma unroll
              for (int ks = 0; ks < 4; ++ks) { kq[ks][0] = *(const f32x4*)(kp + 64 * hk + 16 * ks); kq[ks][1] = *(const f32x4*)(kp + 64 * hk + 16 * ks + 4); }
              bf16x8 kf[4];
#pragma unroll
              for (int ks = 0; ks < 4; ++ks) { u32x4 w; w.x = pk2(kq[ks][0][0], kq[ks][0][1]); w.y = pk2(kq[ks][0][2], kq[ks][0][3]); w.z = pk2(kq[ks][1][0], kq[ks][1][1]); w.w = pk2(kq[ks][1][2], kq[ks][1][3]);
                  kf[ks] = __builtin_bit_cast(bf16x8, w); }
              __builtin_amdgcn_sched_barrier(0);
#pragma unroll
              for (int ks = 0; ks < 4; ++ks) s = MFMA32(kf[ks], ql[(4 * hk + ks) * 64 + lane], s);
          } }
        float mt = -1e30f;
#pragma unroll
        for (int i = 0; i < 16; ++i) { const int key = crow(i, h), dist = qpos - (pos0 + key);
            float v = fmaf(s[i], SCALE2, -slope2 * (float)dist);
            v = (member && dist >= 0 && dist < maxdist && key < nvalid) ? v : -1e30f; s[i] = v; mt = fmaxf(mt, v); }
        mt = fmaxf(mt, __shfl_xor(mt, 32));
        float mn = A.m;
        if (__any(mt > A.m + 8.f)) { mn = fmaxf(A.m, mt); const float alpha = __builtin_amdgcn_exp2f(A.m - mn); A.m = mn; A.l *= alpha;
#pragma unroll
            for (int db = 0; db < 4; ++db) A.o[db] *= alpha; }
        float ls = 0.f;
#pragma unroll
        for (int i = 0; i < 16; ++i) { const float p = s[i] > -1e29f ? __builtin_amdgcn_exp2f(s[i] - mn) : 0.f; s[i] = p; ls += p; }
        A.l += ls;
        asm volatile("s_waitcnt vmcnt(0)" ::: "memory");
        { const LAS float* vr = (const LAS float*)(lds + wave * 16384) + 4 * h * 128 + r;
#pragma unroll
          for (int st = 0; st < 2; ++st) { const bf16x8 pf = packp(s, st);
#pragma unroll
            for (int db = 0; db < 4; ++db) { float x[8];
#pragma unroll
                for (int jj = 0; jj < 8; ++jj) x[jj] = vr[(16 * st + 8 * (jj >> 2) + (jj & 3)) * 128 + 32 * db];
                u32x4 w; w.x = pk2(x[0], x[1]); w.y = pk2(x[2], x[3]); w.z = pk2(x[4], x[5]); w.w = pk2(x[6], x[7]);
                A.o[db] = MFMA32(__builtin_bit_cast(bf16x8, w), pf, A.o[db]); } } }
        asm volatile("s_waitcnt lgkmcnt(0)" ::: "memory");
    };
    auto merge = [&](AttnAcc& A, float (&res)[8]) {
        __syncthreads();
        if (wave >= 4) { LAS float* o = OB + (wave - 4) * 4096 + lane; ML[(wave - 4) * 128 + lane] = A.m; ML[(wave - 4) * 128 + 64 + lane] = A.l;
#pragma unroll
            for (int db = 0; db < 4; ++db)
#pragma unroll
                for (int i = 0; i < 16; ++i) o[(db * 16 + i) * 64] = A.o[db][i]; }
        __syncthreads();
        if (wave < 4) { const LAS float* o = OB + wave * 4096 + lane; const float mb = ML[wave * 128 + lane], lb = ML[wave * 128 + 64 + lane];
            const float M = fmaxf(A.m, mb), sa = __builtin_amdgcn_exp2f(A.m - M), sb = __builtin_amdgcn_exp2f(mb - M);
            A.m = M; A.l = A.l * sa + lb * sb;
#pragma unroll
            for (int db = 0; db < 4; ++db)
#pragma unroll
                for (int i = 0; i < 16; ++i) A.o[db][i] = A.o[db][i] * sa + o[(db * 16 + i) * 64] * sb; }
        __syncthreads();
        if (wave < 4) { LAS float* o = OB + wave * 4096 + lane; ML[wave * 128 + lane] = A.m; ML[wave * 128 + 64 + lane] = A.l;
#pragma unroll
            for (int db = 0; db < 4; ++db)
#pragma unroll
                for (int i = 0; i < 16; ++i) o[(db * 16 + i) * 64] = A.o[db][i]; }
        __syncthreads();
        { float M = -1e30f, sc[4], L = 0.f;
#pragma unroll
          for (int w2 = 0; w2 < 4; ++w2) M = fmaxf(M, ML[w2 * 128 + lane]);
#pragma unroll
          for (int w2 = 0; w2 < 4; ++w2) { sc[w2] = __builtin_amdgcn_exp2f(ML[w2 * 128 + lane] - M); L += ML[w2 * 128 + 64 + lane] * sc[w2]; }
          L += __shfl_xor(L, 32);
          const float inv = L > 0.f ? 1.f / L : 0.f;
          const int base = ((wave >> 1) * 16 + 8 * (wave & 1)) * 64 + lane;
#pragma unroll
          for (int e = 0; e < 8; ++e) { float o = 0.f;
#pragma unroll
              for (int w2 = 0; w2 < 4; ++w2) o += OB[w2 * 4096 + base + e * 64] * sc[w2];
              res[e] = o * inv; } }
        __syncthreads();
    };
    {
        AttnAcc A; attn_init(A);
        const float* ckv = a.in[I_CKV]; const float* nkv = a.out + O_KVS + (size_t)(b * 4) * 1024 + 512 + g * 128;
        int cnt = 0;
        for (int w5 = 0; w5 < 5; ++w5) {
            unsigned bits = __builtin_amdgcn_readfirstlane(UB[w5]);
            while (bits) {
                const int blk = 32 * w5 + __builtin_ctz(bits); bits &= bits - 1u;
                const bool member = (MEMB[blk] >> t) & 1u;
                const int page = __builtin_amdgcn_readfirstlane(PG[blk < 128 ? blk >> 1 : 0]);
                const int nt = blk < 128 ? 2 : 1;
#pragma unroll 1
                for (int hf = 0; hf < nt; ++hf, ++cnt) if ((cnt & 7) == wave) {
                    const float* kb = blk < 128 ? ckv + ((size_t)page * PAGE + (blk & 1) * 64 + hf * 32) * 1024 + 512 + g * 128 : nkv;
                    run_tile(A, kb, kb + 256, 1024, blk < 128 ? 32 : 4, blk * 64 + hf * 32, member, 1 << 30);
                }
            }
        }
        float rsel[8];
        merge(A, rsel);
        if (js < HPG) {
            const float g1 = ((const float*)(a.ws + WS_GATES))[(size_t)(MPR + srow) * 40 + head * 3 + 1];
            float* soc = (float*)(a.ws + WS_SOC) + (size_t)srow * TOK + head * HD + 32 * (wave >> 1) + 16 * (wave & 1) + 4 * h;
#pragma unroll
            for (int q = 0; q < 2; ++q) { f32x4 c = *(const f32x4*)(soc + 8 * q);
#pragma unroll
                for (int e = 0; e < 4; ++e) c[e] += rsel[4 * q + e] * g1;
                *(f32x4*)(soc + 8 * q) = c; }
        }
    }
    {
        float rwin[8];
        AttnAcc A; attn_init(A);
        const float* cw = a.in[I_CWIN] + (size_t)b * 512 * 512 + g * 128; const float* nw = a.out + O_WS + (size_t)(b * 4) * 512 + g * 128;
#pragma unroll 1
        for (int wt = 7 - wave; wt < 17; wt += 8) {
            const float* kb = wt < 16 ? cw + (size_t)(32 * wt) * 512 : nw;
            run_tile(A, kb, kb + 256, 512, wt < 16 ? 32 : 4, PAST - 512 + 32 * wt, true, 512);
        }
        merge(A, rwin);
        if (js < HPG) {
            const float* GATES = (const float*)(a.ws + WS_GATES) + (size_t)(MPR + srow) * 40 + head * 3;
            const float g2 = GATES[2];
            const int d0 = 32 * (wave >> 1) + 16 * (wave & 1) + 4 * h;
            const float* soc = (const float*)(a.ws + WS_SOC) + (size_t)srow * TOK + head * HD + d0;
            bf16* cat = (bf16*)(a.ws + WS_CAT) + (size_t)(MPR + srow) * D + head * HD + d0;
#pragma unroll
            for (int q = 0; q < 2; ++q) { const f32x4 c = *(const f32x4*)(soc + 8 * q);
                u32x2 w; w.x = pk2(c[0] + rwin[4 * q] * g2, c[1] + rwin[4 * q + 1] * g2);
                w.y = pk2(c[2] + rwin[4 * q + 2] * g2, c[3] + rwin[4 * q + 3] * g2);
                *(u32x2*)(cat + 8 * q) = w; }
        }
    }
    __syncthreads();
}

constexpr int CW_Q13 = 4000;
constexpr int CW_BAR = 4096;
static_assert((CW_BAR + XCD_BAR_WORDS) * 4 <= (int)CTL_BYTES, "control block");

#define GEMM_CALL(FN, fnobj, Aoff, Boff, Mrows, Ncols, Kdim, cperm) do { \
    pg8::Gemm g_{(const pg8::bf16_t*)(a.ws + (Aoff)), (const pg8::bf16_t*)(a.ws + (Boff)), (Mrows), (Ncols), (Kdim)}; \
    pg8::StaticOrder S_; S_.init((Mrows), (Ncols), G, (cperm)); \
    EpiFn<FN> E_{fnobj}; \
    pg8::gemm_phase<EpiFn<FN>, pg8::StaticOrder, true, true>(lds, g_, S_, E_); } while (0)

__global__ void __launch_bounds__(NTHR, 2) yoco_fwd(Args a_) {
    extern __shared__ __attribute__((aligned(16))) unsigned char lds_raw[];
    LAS unsigned char* lds = (LAS unsigned char*)lds_raw;
    const int tid0 = threadIdx.x, wave0 = __builtin_amdgcn_readfirstlane(tid0 >> 6);
    const int G = gridDim.x, bx = blockIdx.x, ngw = G * NWAVES;
    volatile LAS unsigned* MISC = (volatile LAS unsigned*)(lds + MISC_OFF);
    for (int u = tid0; u < (LDS_BYTES - RING_BYTES) / 4; u += NTHR) ((LAS unsigned*)(lds + RING_BYTES))[u] = 0u;
    __syncthreads();
    XcdBarrier bar = xcd_barrier_post((unsigned*)(a_.ws + WS_CTL) + CW_BAR, MISC + 8);
#define PH ArgsRef a = *phase_args(); float* out = a.out; (void)out; int tid = tid0, wave = wave0; asm volatile("" : "+v"(tid)); asm volatile("" : "+s"(wave)); const int lane = tid & 63, gw = bx * NWAVES + wave; (void)lane; (void)gw;

    { PH wg_transpose_run(a, lds, bx, TL_A0 + (TL_END - TL_LATE1), G, [](int t) { return t < TL_A0 ? t : t - TL_A0 + TL_LATE1; }, tid); }
    { PH p0_prologue(a, lds, gw, ngw, wave, lane); }
    xcd_barrier(bar);
    { PH for (int it = bx; it < 256; it += G) cmpgemm_direct(a, lds, it, tid); }

    { PH
        FnA fa{(bf16*)(a.ws + WS_QA), (float*)(a.ws + WS_FA), (bf16*)(a.ws + WS_VA), (bf16*)(a.ws + WS_OGA), (bf16*)(a.ws + WS_MEMQ), (const float*)(a.ws + WS_LB)};
        EpiA ea{(bf16*)(a.ws + WS_QP), (bf16*)(a.ws + WS_KP), (bf16*)(a.ws + WS_KT), (bf16*)(a.ws + WS_VF), (float*)(a.ws + WS_DV), (bf16*)(a.ws + WS_OGA), (bf16*)(a.ws + WS_MEMQ), (const float*)(a.ws + WS_LB), fa};
        { pg8::Gemm g_{(const pg8::bf16_t*)(a.ws + WS_XN), (const pg8::bf16_t*)(a.ws + WS_BTA), MPAD, NA, 2048};
          pg8::StaticOrder S_; S_.init(MPAD, NA, G, bx);
          pg8::gemm_phase<EpiA, pg8::StaticOrder, true, true>(lds, g_, S_, ea); }
    }
    { PH
        FnM fm{out, (bf16*)(a.ws + WS_MK), (bf16*)(a.ws + WS_MVT)};
        GEMM_CALL(FnM, fm, WS_MEMPB, WS_BTM, 2048, 2048, 2048, (bx + 64) % G);
    }
    xcd_barrier(bar);

    { PH
        const bool split = G > 96;
        if (!split || bx < 96) { for (int k = bx; k < BP * NH; k += (split ? 96 : G)) hgrn_mfma_item(a, lds, k, tid); }
        if (!split || bx >= 96) {
            const int w2 = split ? bx - 96 : bx, nw = split ? G - 96 : G;
            for (int k = w2; k < BS * NH; k += nw) hgrn_sample_item(a, lds, k / NH, k % NH, tid);
            for (int it = w2; it < 256 + BS * MEMH; it += nw) memattn_wg(a, 0, it, lds, tid);
        }
    }
    __syncthreads();
    { PH
        constexpr int NREC = TL_LATE0 + 288;
        auto idm = [](int t) { return t; };
        if (G > 96) { if (bx < 96) wg_transpose_run(a, lds, TL_LATE0 + bx, NREC, 96, idm, tid);
                      else wg_transpose_run(a, lds, NREC + (bx - 96), TL_LATE1, G - 96, idm, tid); }
        else wg_transpose_run(a, lds, TL_LATE0 + bx, TL_LATE1, G, idm, tid);
    }
    xcd_barrier(bar);

    { PH FnO fo{(bf16*)(a.ws + WS_OB), D}; GEMM_CALL(FnO, fo, WS_CAT, WS_BTO0, MPR, D, 2048, bx);
      skinny_gemm<8>(fo, (const bf16*)(a.ws + WS_CAT) + (size_t)MPR * 2048, (const bf16*)(a.ws + WS_BTO0), D, 2048, lds, bx, G, tid); }
    xcd_barrier(bar);
    { PH normpass<true, false>(a, a.in[I_NG] + 1 * D, gw, ngw, lane); }
    xcd_barrier(bar);
    { PH EpiF1 ef{(bf16*)(a.ws + WS_HID), (float*)(a.ws + WS_FIX), (float*)(a.ws + WS_HALO), out, a.in[I_WCONV] + (size_t)0 * 3 * FF, a.in[I_BCONV] + (size_t)0 * FF, 0};
      { pg8::Gemm g_{(const pg8::bf16_t*)(a.ws + WS_XN), (const pg8::bf16_t*)(a.ws + WS_BTF10), MPR, FF2, 2048}; pg8::StaticOrder S_; S_.init(MPR, FF2, G, bx);
        pg8::gemm_phase<EpiF1, pg8::StaticOrder, true, true>(lds, g_, S_, ef); }
      FnF1 ff{(bf16*)(a.ws + WS_AB), out, 0};
      skinny_gemm<8>(ff, (const bf16*)(a.ws + WS_XN) + (size_t)MPR * 2048, (const bf16*)(a.ws + WS_BTF10), FF2, 2048, lds, bx, G, tid); }
    xcd_barrier(bar);
    { PH ffn_fixup(a, 0, bx * NTHR + tid, G * NTHR); gating_pass(a, 0, bx * NTHR + tid, G * NTHR); }
    xcd_barrier(bar);
    { PH FnO fo{(bf16*)(a.ws + WS_OB), D}; GEMM_CALL(FnO, fo, WS_HID, WS_BTF20, MPR, D, FF, bx);
      skinny_gemm<8>(fo, (const bf16*)(a.ws + WS_HID) + (size_t)MPR * FF, (const bf16*)(a.ws + WS_BTF20), D, FF, lds, bx, G, tid); }
    xcd_barrier(bar);
    { PH normpass<false, false>(a, a.in[I_NG] + 3 * D, gw, ngw, lane); }
    xcd_barrier(bar);

    { PH
        FnB fb{(bf16*)(a.ws + WS_QB), (bf16*)(a.ws + WS_MEMQ), (float*)(a.ws + WS_GATES), out, (bf16*)(a.ws + WS_KCMP), (bf16*)(a.ws + WS_VCMP),
               (bf16*)(a.ws + WS_KSEL), (bf16*)(a.ws + WS_VSELT), (bf16*)(a.ws + WS_KWIN), (bf16*)(a.ws + WS_VWINT)};
        GEMM_CALL(FnB, fb, WS_XN, WS_BTB, MPAD, NBM, 2048, bx);
    }
    xcd_barrier(bar);

    { PH FnC fk{(float*)(a.ws + WS_PPP), 256};
      skinny_gemm<8>(fk, (const bf16*)(a.ws + WS_KCMP), (const bf16*)(a.ws + WS_BTC), 256, 2048, lds, bx, G, tid, 64, 0); }
    { PH FnC fv{(float*)(a.ws + WS_PPP) + (size_t)2048 * 256, 256};
      skinny_gemm<8>(fv, (const bf16*)(a.ws + WS_VCMP), (const bf16*)(a.ws + WS_BTC) + (size_t)256 * 2048, 256, 2048, lds, (bx + G / 2) % G, G, tid, 64, 0); }
    { PH for (int it = bx; it < 256 + BS * MEMH; it += G) memattn_wg(a, 1, it, lds, tid); }
    { PH for (int it = 128 + gw; it < 128 + 2048; it += ngw) cmp2_item(a, it, lane); }
    xcd_barrier(bar);
    { PH for (int it = gw; it < 128; it += ngw) cmp2_item(a, it, lane); }
    xcd_barrier(bar);
    { PH for (int w = bx; w < 128; w += G) nsa_cmp_wg(a, lds, w, tid); }
    { PH for (int w = (bx + G - 128 % G) % G; w < 128; w += G) { sn_cmp_item(a, lds, 2 * w, tid); sn_cmp_item(a, lds, 2 * w + 1, tid); } }
    xcd_barrier(bar);
    { PH for (int it = bx; it < BS * 2; it += G) sn_selwin_mfma(a, lds, it, tid); }
    __syncthreads();
    { PH
        LAS unsigned* TK = (LAS unsigned*)(lds + RING_BYTES + 1024);
        unsigned* qctr = (unsigned*)(a.ws + WS_CTL) + CW_Q13;
        int grp = bx, par = 0;
        while (grp < 6144 / NWAVES) {
            unsigned nx = 0u;
            if (tid == 0) nx = atomicAdd(qctr, 1u);
            nsa_selwin_item(a, grp * NWAVES + wave, (LAS float*)(lds + wave * 16384), lane);
            if (tid == 0) TK[par] = nx;
            __syncthreads();
            grp = G + (int)TK[par]; par ^= 1;
        }
    }
    xcd_barrier(bar);

    { PH FnO fo{(bf16*)(a.ws + WS_OB), D}; GEMM_CALL(FnO, fo, WS_CAT, WS_BTO1, MPR, D, 2048, bx);
      skinny_gemm<8>(fo, (const bf16*)(a.ws + WS_CAT) + (size_t)MPR * 2048, (const bf16*)(a.ws + WS_BTO1), D, 2048, lds, bx, G, tid); }
    xcd_barrier(bar);
    { PH normpass<false, false>(a, a.in[I_NG] + 5 * D, gw, ngw, lane); }
    xcd_barrier(bar);
    { PH EpiF1 ef{(bf16*)(a.ws + WS_HID), (float*)(a.ws + WS_FIX), (float*)(a.ws + WS_HALO), out, a.in[I_WCONV] + (size_t)1 * 3 * FF, a.in[I_BCONV] + (size_t)1 * FF, 1};
      { pg8::Gemm g_{(const pg8::bf16_t*)(a.ws + WS_XN), (const pg8::bf16_t*)(a.ws + WS_BTF11), MPR, FF2, 2048}; pg8::StaticOrder S_; S_.init(MPR, FF2, G, bx);
        pg8::gemm_phase<EpiF1, pg8::StaticOrder, true, true>(lds, g_, S_, ef); }
      FnF1 ff{(bf16*)(a.ws + WS_AB), out, 1};
      skinny_gemm<8>(ff, (const bf16*)(a.ws + WS_XN) + (size_t)MPR * 2048, (const bf16*)(a.ws + WS_BTF11), FF2, 2048, lds, bx, G, tid); }
    xcd_barrier(bar);
    { PH ffn_fixup(a, 1, bx * NTHR + tid, G * NTHR); gating_pass(a, 1, bx * NTHR + tid, G * NTHR); }
    xcd_barrier(bar);
    { PH FnO fo{(bf16*)(a.ws + WS_OB), D}; GEMM_CALL(FnO, fo, WS_HID, WS_BTF21, MPR, D, FF, bx);
      skinny_gemm<8>(fo, (const bf16*)(a.ws + WS_HID) + (size_t)MPR * FF, (const bf16*)(a.ws + WS_BTF21), D, FF, lds, bx, G, tid); }
    xcd_barrier(bar);
    { PH normpass<false, true>(a, a.in[I_NG] + 7 * D, gw, ngw, lane); }
}

extern "C" void kernel_launch(void* const* d_in, const int* in_sizes, int n_in, void* d_out, int out_size, void* d_ws, size_t ws_size, hipStream_t stream) {
    static int grid = 0;
    if (grid == 0) {
        if (n_in != 25 || out_size != (int)O_END || ws_size < WS_END) { fprintf(stderr, "kernel_launch: unexpected shapes (n_in %d out %d ws %zu, need ws %zu)\n", n_in, out_size, ws_size, (size_t)WS_END); grid = -1; return; }
        int dev = 0, cus = 0, per_cu = 0;
        if (hipGetDevice(&dev) != hipSuccess || hipDeviceGetAttribute(&cus, hipDeviceAttributeMultiprocessorCount, dev) != hipSuccess) { grid = -1; return; }
        if (hipFuncSetAttribute((const void*)yoco_fwd, hipFuncAttributeMaxDynamicSharedMemorySize, LDS_BYTES) != hipSuccess) { fprintf(stderr, "kernel_launch: hipFuncSetAttribute failed\n"); grid = -1; return; }
        if (hipOccupancyMaxActiveBlocksPerMultiprocessor(&per_cu, (const void*)yoco_fwd, NTHR, LDS_BYTES) != hipSuccess || per_cu < 1)
            fprintf(stderr, "kernel_launch: note: occupancy query reports %d workgroups per CU\n", per_cu);
        (void)hipGetLastError();
        grid = cus;
    }
    if (grid < 0) return;
    if (hipMemsetAsync((char*)d_ws + WS_CTL + (size_t)CW_Q13 * 4, 0, (size_t)(CW_BAR - CW_Q13 + XCD_BAR_WORDS) * 4, stream) != hipSuccess) { fprintf(stderr, "kernel_launch: memset failed\n"); return; }
    Args a{};
    for (int i = 0; i < 25; ++i) a.in[i] = (const float*)d_in[i];
    a.out = (float*)d_out; a.ws = (unsigned char*)d_ws;
    hipLaunchKernelGGL(yoco_fwd, dim3(grid), dim3(NTHR), LDS_BYTES, stream, a);
    const hipError_t le = hipPeekAtLastError();
    if (le != hipSuccess) fprintf(stderr, "kernel_launch: launch failed: %s\n", hipGetErrorName(le));
}
```

```cpp
#include <hip/hip_runtime.h>
#include <cstdio>
#include <cstdint>

#define DI __device__ __forceinline__
#define GAS __attribute__((address_space(1)))
#define LAS __attribute__((address_space(3)))
typedef unsigned short bf16;
typedef short bf16x8 __attribute__((ext_vector_type(8)));
typedef short s16x4 __attribute__((ext_vector_type(4)));
typedef float f32x2 __attribute__((ext_vector_type(2)));
typedef float f32x4 __attribute__((ext_vector_type(4)));
typedef float f32x16 __attribute__((ext_vector_type(16)));
typedef unsigned u32x2 __attribute__((ext_vector_type(2)));
typedef unsigned u32x4 __attribute__((ext_vector_type(4)));
typedef __bf16 hbf2 __attribute__((ext_vector_type(2)));

constexpr int D = 2048, BP = 8, TP = 2048, BS = 32, TS = 4, PAST = 8192, PAGE = 128, NPAGE = PAST / PAGE;
constexpr int MPR = BP * TP;
constexpr int MSR = BS * TS;
constexpr int MR = MPR + MSR;
constexpr int MPAD = 16640;
constexpr int TOK = 1536, MEMW = 512, HD = 128, NH = 12, GB = 2, HPG = 6, MEMH = 4, MEML = 256;
constexpr int NA = 4 * TOK + MEMW;
constexpr int NBM = 3840;
constexpr int FF = 5632, FF2 = 2 * FF;
constexpr int NCP = 127, NCS = 511, NSP = 32, NSS = 129;
constexpr float EPS = 1e-6f;
constexpr float LOG2E = 1.4426950408889634f;
constexpr float SCALE2 = 0.08838834764831845f * LOG2E;

constexpr size_t O_YP = 0;
constexpr size_t O_YS = O_YP + (size_t)MPR * D;
constexpr size_t O_HP = O_YS + (size_t)MSR * D;
constexpr size_t O_HS = O_HP + (size_t)BP * NH * HD * HD;
constexpr size_t O_CP = O_HS + (size_t)BS * NH * HD * HD;
constexpr size_t O_CS = O_CP + (size_t)2 * BP * 2 * FF;
constexpr size_t O_MP = O_CS + (size_t)2 * BS * 2 * FF;
constexpr size_t O_KVP = O_MP + (size_t)2 * BP * MEML * 1024;
constexpr size_t O_KVS = O_KVP + (size_t)MPR * 1024;
constexpr size_t O_WP = O_KVS + (size_t)MSR * 1024;
constexpr size_t O_WS = O_WP + (size_t)BP * 512 * 512;
constexpr size_t O_END = O_WS + (size_t)MSR * 512;
static_assert(O_END == 65847296, "d_out size");

constexpr size_t alup(size_t x) { return (x + 4095) & ~(size_t)4095; }
constexpr size_t WS_CTL = 0, CTL_BYTES = 1u << 20;
constexpr size_t WS_BTA = CTL_BYTES;
constexpr size_t WS_BTO0 = WS_BTA + alup((size_t)NA * D * 2);
constexpr size_t WS_BTO1 = WS_BTO0 + alup((size_t)D * D * 2);
constexpr size_t WS_BTF10 = WS_BTO1 + alup((size_t)D * D * 2);
constexpr size_t WS_BTF11 = WS_BTF10 + alup((size_t)FF2 * D * 2);
constexpr size_t WS_BTF20 = WS_BTF11 + alup((size_t)FF2 * D * 2);
constexpr size_t WS_BTF21 = WS_BTF20 + alup((size_t)D * FF * 2);
constexpr size_t WS_BTB = WS_BTF21 + alup((size_t)D * FF * 2);
constexpr size_t WS_BTM = WS_BTB + alup((size_t)NBM * D * 2);
constexpr size_t WS_BTC = WS_BTM + alup((size_t)D * D * 2);
constexpr size_t WS_LB = WS_BTC + alup((size_t)2 * 256 * 2048 * 2);
constexpr size_t WS_PRE0 = WS_LB + alup(1536 * 4);
constexpr size_t WS_XN = WS_PRE0 + alup(256 * 4);
constexpr size_t WS_MEMPB = WS_XN + alup((size_t)MPAD * D * 2);
constexpr size_t WS_QA = WS_MEMPB + alup((size_t)2048 * D * 2);
constexpr size_t WS_FA = WS_QA + alup((size_t)MPAD * TOK * 2);
constexpr size_t WS_VA = WS_FA + alup((size_t)MPAD * TOK * 4);
constexpr size_t WS_OGA = WS_VA + alup((size_t)MPAD * TOK * 2);
constexpr size_t WS_MEMQ = WS_OGA + alup((size_t)MPAD * TOK * 2);
constexpr size_t WS_ORAW = WS_MEMQ + alup((size_t)MPAD * MEMW * 2);
constexpr size_t WS_CAT = WS_ORAW + alup((size_t)MPAD * TOK * 4);
constexpr size_t WS_OB = WS_CAT + alup((size_t)MPAD * D * 2);
constexpr size_t WS_H = WS_OB + alup((size_t)MPAD * D * 2);
constexpr size_t WS_AB = WS_H + alup((size_t)MPAD * D * 4);
constexpr size_t WS_HID = WS_AB + alup((size_t)MPAD * FF2 * 2);
constexpr size_t WS_QB = WS_HID + alup((size_t)MPAD * FF * 2);
constexpr size_t WS_GATES = WS_QB + alup((size_t)MPAD * TOK * 2);
constexpr size_t KVB = (size_t)BP * GB * TP * HD * 2;
constexpr size_t WS_KCMP = WS_GATES + alup((size_t)MPAD * 40 * 4);
constexpr size_t WS_VCMP = WS_KCMP + alup(KVB);
constexpr size_t WS_KSEL = WS_VCMP + alup(KVB);
constexpr size_t WS_VSELT = WS_KSEL + alup(KVB);
constexpr size_t WS_KWIN = WS_VSELT + alup(KVB);
constexpr size_t WS_VWINT = WS_KWIN + alup(KVB);
constexpr size_t WS_CAK = WS_VWINT + alup(KVB);
constexpr size_t WS_CAV = WS_CAK + alup((size_t)32768 * 2048 * 2);
constexpr size_t WS_PPP = WS_CAV + alup((size_t)32768 * 2048 * 2);
constexpr size_t WS_PPS = WS_PPP + alup((size_t)2 * 2048 * 256 * 4);
constexpr size_t WS_KC = WS_PPS + alup((size_t)2 * 32768 * 256 * 4);
constexpr size_t WS_VCT = WS_KC + alup((size_t)16 * 128 * 128 * 2);
constexpr size_t WS_KCS = WS_VCT + alup((size_t)16 * 128 * 128 * 2);
constexpr size_t WS_VCS = WS_KCS + alup((size_t)64 * 512 * 128 * 4);
constexpr size_t WS_MK = WS_VCS + alup((size_t)64 * 512 * 128 * 4);
constexpr size_t WS_MVT = WS_MK + alup((size_t)2 * 40 * 4 * 256 * 128 * 2);
constexpr size_t WS_OCMP = WS_MVT + alup((size_t)2 * 40 * 4 * 256 * 128 * 2);
constexpr size_t WS_SELM = WS_OCMP + alup((size_t)MPAD * TOK * 2);
constexpr size_t WS_SOC = WS_SELM + alup((size_t)MPR * 2 * 4);
constexpr size_t WS_SIDX = WS_SOC + alup((size_t)MSR * TOK * 4);
constexpr size_t WS_DV = WS_SIDX + alup((size_t)MSR * 2 * 16 * 4);
constexpr size_t WS_FIX = WS_DV + alup((size_t)96 * 64 * 256 * 4);
constexpr size_t WS_HALO = WS_FIX + alup((size_t)256 * 2 * 2 * FF * 4);
constexpr size_t WS_W2T = WS_HALO + alup((size_t)256 * 2 * FF * 4);
constexpr size_t WS_END = WS_W2T + alup((size_t)2 * 128 * 128 * 2);
constexpr size_t WS_QP = WS_QA, WS_KP = WS_FA, WS_KT = WS_FA + (size_t)MPR * TOK * 2, WS_VF = WS_VA;

constexpr int NWAVES = 8, NTHR = 512;
constexpr int LDS_BYTES = 147456;
constexpr int RING_BYTES = 131072;
constexpr int MISC_OFF = RING_BYTES + 320;

DI unsigned pk2(float lo, float hi) { hbf2 v = __builtin_convertvector((f32x2){lo, hi}, hbf2); return __builtin_bit_cast(unsigned, v); }
DI bf16 f2bf(float f) { return (bf16)(pk2(f, 0.f) & 0xffffu); }
DI float bf2f(bf16 v) { return __uint_as_float((unsigned)v << 16); }
DI float bflo(unsigned w) { return __uint_as_float(w << 16); }
DI float bfhi(unsigned w) { return __uint_as_float(w & 0xffff0000u); }
DI float sigm(float x) { return __builtin_amdgcn_rcpf(1.f + __builtin_amdgcn_exp2f(-LOG2E * x)); }
DI float gelu_t(float x) { const float z = 1.5957691216f * (x + 0.044715f * x * x * x); return x * sigm(z); }
DI float wave_sum(float v) {
#pragma unroll
    for (int o = 1; o < 64; o <<= 1) v += __shfl_xor(v, o);
    return v;
}
DI float wave_max(float v) {
#pragma unroll
    for (int o = 1; o < 64; o <<= 1) v = fmaxf(v, __shfl_xor(v, o));
    return v;
}
#define LDS_WAIT() asm volatile("s_waitcnt lgkmcnt(0)" ::: "memory")
#define VM_WAIT() asm volatile("s_waitcnt vmcnt(0)" ::: "memory")
DI int kf_off(int r, int d) { return (((d >> 4) * 64 + r + 32 * ((d >> 3) & 1)) << 3) + (d & 7); }
DI int vf_off(int kvl, int d) { return ((((kvl >> 4) * 4 + (d >> 5)) * 64 + (d & 31) + 32 * ((kvl >> 2) & 1)) << 3) + ((((kvl >> 3) & 1) << 2) | (kvl & 3)); }
namespace pg8 {
#define PG8_LAS __attribute__((address_space(3)))
typedef unsigned short bf16_t;
typedef short bf16x8 __attribute__((ext_vector_type(8)));
typedef float f32x4 __attribute__((ext_vector_type(4)));
typedef unsigned u32x4 __attribute__((ext_vector_type(4)));
constexpr int BM = 256, BK = 64, HALF = 128, HTB = HALF * BK * 2  , STAGE_BYTES = 8 * HTB, NXCD = 8, WGM = 8;

__host__ __device__ __forceinline__ int lds_byte(int r, int c) { const int st = (r >> 4) * 2 + (c >> 5), rr = r & 15, cc = c & 31, ob = rr * 64 + cc * 2; return st * 1024 + (ob ^ (((ob >> 9) & 1) << 5)); }
__host__ __device__ __forceinline__ void stage_rc(int b, int& R, int& C) { const int st = b / 1024, sb = b % 1024, swz = sb ^ (((sb >> 9) & 1) << 5); R = (st >> 1) * 16 + swz / 64; C = (st & 1) * 32 + (swz % 64) / 2; }
__host__ __device__ __forceinline__ int perm32(int rho) { const int n = rho >> 4, i = rho & 15; return 8 * (i >> 2) + 4 * n + (i & 3); }

struct Unit { int pm, pn; };
struct Gemm { const bf16_t* A; const bf16_t* Bt; int M, N, K; };

struct StaticOrder {
    int nM, nN, nwg, G, c;
    __host__ __device__ void init(int M, int N, int G_, int c_) { nM = M / BM; nN = N / BM; nwg = nM * nN; G = G_; c = c_; }
    __host__ __device__ __forceinline__ bool next(int i, Unit& u) const {
        const long L = (long)i * G + c; if (L >= nwg) return false;
        int wgid = (int)L; { const int q = nwg / NXCD, r = nwg % NXCD, xcd = wgid % NXCD, off = wgid / NXCD; wgid = (xcd < r ? xcd * (q + 1) : r * (q + 1) + (xcd - r) * q) + off; }
        const int nig = WGM * nN, gid = wgid / nig, fm = gid * WGM, gsz = (nM - fm) < WGM ? (nM - fm) : WGM;
        u.pm = fm + ((wgid % nig) % gsz); u.pn = (wgid % nig) / gsz; return true;
    }
    __device__ __forceinline__ void a_ready(const Unit&) const {}
    __device__ __forceinline__ void done(const Unit&) const {}
};

template <class Epi, class Sched, bool ALIGN_EPI = false, bool SP2 = false>
__device__ __forceinline__ void gemm_phase(PG8_LAS unsigned char* lds, const Gemm g, const Sched& S, const Epi& E) {
    const int tid = threadIdx.x, wid = __builtin_amdgcn_readfirstlane(tid >> 6), lane = tid & 63, wr = wid >> 2, wc = wid & 3, fr = lane & 15, fq = lane >> 4;
    const int K = g.K, nt = K / BK;
    unsigned voffA[2], voffB[2];
#pragma unroll
    for (int i = 0; i < 2; ++i) { int R, C; stage_rc(tid * 16 + i * 8192, R, C); const int Rb = Epi::PERM ? ((R & ~31) + perm32(R & 31)) : R;
        voffA[i] = (unsigned)(R * K + C) * 2u; voffB[i] = (unsigned)(Rb * K + C) * 2u; }
    const size_t kstep = (size_t)(BK * 2);
    const size_t hstep = (size_t)HALF * K * 2;
    const size_t tstep = 2 * hstep;
    const unsigned ldsw = (unsigned)wid * 1024u;
    const int aoff = lds_byte(wr * 64 + fr, fq * 8), boff = lds_byte(wc * 32 + fr, fq * 8);
#define PG8_SA(b, h) (((b) * 2 + (h)) * HTB)
#define PG8_SB(b, h) ((4 + (b) * 2 + (h)) * HTB)
#define PG8_STAGE(bufoff, gbase, voff) do { _Pragma("unroll") for (int _i = 0; _i < 2; ++_i) \
        __builtin_amdgcn_global_load_lds((const unsigned*)((const char*)(gbase) + (voff)[_i]), (PG8_LAS unsigned*)(lds + (bufoff) + ldsw + _i * 8192), 16, 0, 0); } while (0)
#define PG8_LDA(dst, b, h) do { _Pragma("unroll") for (int m = 0; m < 4; ++m) _Pragma("unroll") for (int k = 0; k < 2; ++k) dst[m][k] = *(const PG8_LAS bf16x8*)(lds + PG8_SA(b, h) + aoff + m * 2048 + k * 1024); } while (0)
#define PG8_LDB(dst, b, h) do { _Pragma("unroll") for (int n = 0; n < 2; ++n) _Pragma("unroll") for (int k = 0; k < 2; ++k) dst[n][k] = *(const PG8_LAS bf16x8*)(lds + PG8_SB(b, h) + boff + n * 2048 + k * 1024); } while (0)
#define PG8_MMA(ai, bj, At, Bt) do { __builtin_amdgcn_s_setprio(1); _Pragma("unroll") for (int m = 0; m < 4; ++m) _Pragma("unroll") for (int n = 0; n < 2; ++n) _Pragma("unroll") for (int k = 0; k < 2; ++k) \
        acc[ai][bj][m][n] = __builtin_amdgcn_mfma_f32_16x16x32_bf16(Bt[n][k], At[m][k], acc[ai][bj][m][n], 0, 0, 0); __builtin_amdgcn_s_setprio(0); } while (0)
#define PG8_WAIT_V(n) asm volatile("s_waitcnt vmcnt(" #n ")" ::: "memory")
#define PG8_WAIT_L(n) asm volatile("s_waitcnt lgkmcnt(" #n ")" ::: "memory")
#define PG8_BAR __builtin_amdgcn_s_barrier()
#define PG8_SCHED __builtin_amdgcn_sched_barrier(0)
    Unit cur, nxt; int ui = 0;
    if (!S.next(0, cur)) return;
    f32x4 acc[2][2][4][2];
#pragma unroll
    for (int a = 0; a < 2; ++a)
#pragma unroll
        for (int b = 0; b < 2; ++b)
#pragma unroll
            for (int m = 0; m < 4; ++m)
#pragma unroll
                for (int n = 0; n < 2; ++n) acc[a][b][m][n] = (f32x4){0.f, 0.f, 0.f, 0.f};
    bf16x8 At[4][2], B0[2][2], B1[2][2];
    const char* cA = (const char*)g.A + (size_t)cur.pm * tstep; const char* cB = (const char*)g.Bt + (size_t)cur.pn * tstep;
    S.a_ready(cur);
    if constexpr (SP2) {
        PG8_STAGE(PG8_SB(0, 0), cB, voffB); PG8_STAGE(PG8_SB(0, 1), cB + hstep, voffB); PG8_STAGE(PG8_SA(0, 0), cA, voffA); PG8_STAGE(PG8_SA(0, 1), cA + hstep, voffA);
        if (wr == 1) PG8_BAR;
        PG8_WAIT_V(2); PG8_BAR;
        PG8_STAGE(PG8_SB(1, 0), cB + kstep, voffB); PG8_STAGE(PG8_SA(1, 0), cA + kstep, voffA); PG8_STAGE(PG8_SB(1, 1), cB + hstep + kstep, voffB);
        PG8_WAIT_V(6); PG8_BAR;
    } else {
        PG8_STAGE(PG8_SB(0, 0), cB, voffB); PG8_STAGE(PG8_SA(0, 0), cA, voffA); PG8_STAGE(PG8_SB(0, 1), cB + hstep, voffB); PG8_STAGE(PG8_SA(0, 1), cA + hstep, voffA);
        if (wr == 1) PG8_BAR;
        PG8_WAIT_V(4); PG8_BAR;
        PG8_STAGE(PG8_SB(1, 0), cB + kstep, voffB); PG8_STAGE(PG8_SA(1, 0), cA + kstep, voffA); PG8_STAGE(PG8_SB(1, 1), cB + hstep + kstep, voffB);
        PG8_WAIT_V(6); PG8_BAR;
    }
    for (;;) {
        const bool has_next = S.next(ui + 1, nxt);
        const char* nA = has_next ? (const char*)g.A + (size_t)nxt.pm * tstep : cA; const char* nB = has_next ? (const char*)g.Bt + (size_t)nxt.pn * tstep : cB;
        for (int t = 0; t < nt; t += 2) {
            const bool last = (t == nt - 2);
            const char* a1 = cA + (size_t)(t + 1) * kstep;
            const char* a2 = last ? nA : cA + (size_t)(t + 2) * kstep; const char* b2 = last ? nB : cB + (size_t)(t + 2) * kstep;
            const char* a3 = a2 + kstep; const char* b3 = b2 + kstep;
            if (last && has_next) S.a_ready(nxt);
            if constexpr (SP2) {
            PG8_LDB(B0, 0, 0); PG8_LDB(B1, 0, 1); PG8_SCHED; PG8_LDA(At, 0, 0); PG8_STAGE(PG8_SA(1, 1), a1 + hstep, voffA);
            PG8_WAIT_V(8); PG8_WAIT_L(0); PG8_BAR; PG8_MMA(0, 0, At, B0); PG8_MMA(0, 1, At, B1); PG8_BAR; PG8_SCHED;
            PG8_LDA(At, 0, 1); PG8_STAGE(PG8_SB(0, 0), b2, voffB); PG8_STAGE(PG8_SB(0, 1), b2 + hstep, voffB); PG8_STAGE(PG8_SA(0, 0), a2, voffA);
            PG8_WAIT_V(8); PG8_WAIT_L(0); PG8_BAR; PG8_MMA(1, 0, At, B0); PG8_MMA(1, 1, At, B1); PG8_BAR; PG8_SCHED;
            PG8_LDB(B0, 1, 0); PG8_LDB(B1, 1, 1); PG8_SCHED; PG8_LDA(At, 1, 0); PG8_STAGE(PG8_SA(0, 1), a2 + hstep, voffA);
            PG8_WAIT_V(8); PG8_WAIT_L(0); PG8_BAR; PG8_MMA(0, 0, At, B0); PG8_MMA(0, 1, At, B1); PG8_BAR; PG8_SCHED;
            PG8_LDA(At, 1, 1); PG8_STAGE(PG8_SB(1, 0), b3, voffB); PG8_STAGE(PG8_SB(1, 1), b3 + hstep, voffB); PG8_STAGE(PG8_SA(1, 0), a3, voffA);
            PG8_WAIT_V(8); PG8_WAIT_L(0); PG8_BAR; PG8_MMA(1, 0, At, B0); PG8_MMA(1, 1, At, B1); PG8_BAR; PG8_SCHED;
            } else {
            PG8_LDB(B0, 0, 0); PG8_SCHED; PG8_LDA(At, 0, 0); PG8_STAGE(PG8_SA(1, 1), a1 + hstep, voffA);
            PG8_WAIT_L(8); PG8_BAR; PG8_WAIT_L(0); PG8_MMA(0, 0, At, B0); PG8_BAR; PG8_SCHED;
            PG8_LDB(B1, 0, 1); PG8_STAGE(PG8_SB(0, 0), b2, voffB);
            PG8_BAR; PG8_WAIT_L(0); PG8_MMA(0, 1, At, B1); PG8_BAR;
            PG8_LDA(At, 0, 1); PG8_STAGE(PG8_SA(0, 0), a2, voffA);
            PG8_BAR; PG8_WAIT_L(0); PG8_MMA(1, 0, At, B0); PG8_BAR; PG8_SCHED;
            PG8_STAGE(PG8_SB(0, 1), b2 + hstep, voffB);
            PG8_WAIT_V(6); PG8_BAR; PG8_MMA(1, 1, At, B1); PG8_BAR;
            PG8_LDB(B0, 1, 0); PG8_SCHED; PG8_LDA(At, 1, 0); PG8_STAGE(PG8_SA(0, 1), a2 + hstep, voffA);
            PG8_WAIT_L(8); PG8_BAR; PG8_WAIT_L(0); PG8_MMA(0, 0, At, B0); PG8_BAR; PG8_SCHED;
            PG8_LDB(B1, 1, 1); PG8_STAGE(PG8_SB(1, 0), b3, voffB);
            PG8_BAR; PG8_WAIT_L(0); PG8_MMA(0, 1, At, B1); PG8_BAR;
            PG8_LDA(At, 1, 1); PG8_STAGE(PG8_SA(1, 0), a3, voffA);
            PG8_BAR; PG8_WAIT_L(0); PG8_MMA(1, 0, At, B0); PG8_BAR; PG8_SCHED;
            PG8_STAGE(PG8_SB(1, 1), b3 + hstep, voffB);
            PG8_WAIT_V(6); PG8_BAR; PG8_MMA(1, 1, At, B1); PG8_BAR;
            }
        }
        if constexpr (ALIGN_EPI) { if (wr == 0) PG8_BAR; }
        if constexpr (!Epi::AFTER_DRAIN) { E(acc, cur, wr, wc, fr, fq); S.done(cur); }
        if (!has_next) break;
#pragma unroll
        for (int a = 0; a < 2; ++a)
#pragma unroll
            for (int b = 0; b < 2; ++b)
#pragma unroll
                for (int m = 0; m < 4; ++m)
#pragma unroll
                    for (int n = 0; n < 2; ++n) acc[a][b][m][n] = (f32x4){0.f, 0.f, 0.f, 0.f};
        cur = nxt; cA = nA; cB = nB; ++ui;
        if constexpr (ALIGN_EPI) { if (wr == 1) PG8_BAR; }
    }
    PG8_WAIT_V(0);
    if constexpr (!ALIGN_EPI) { if (wr == 0) PG8_BAR; }
    PG8_BAR;
    if constexpr (Epi::AFTER_DRAIN) { E.fused(acc, cur, wr, wc, fr, fq, lds, wid, lane); S.done(cur); }
#undef PG8_SA
#undef PG8_SB
#undef PG8_STAGE
#undef PG8_LDA
#undef PG8_LDB
#undef PG8_MMA
#undef PG8_WAIT_V
#undef PG8_WAIT_L
#undef PG8_BAR
#undef PG8_SCHED
}
}
#define XB_TMO      128
#define XB_XCNT(j)  (256  + 64 * (j))
#define XB_XSUB(j)  (1280 + 64 * (j))
#define XB_XGEN(j)  (2304 + 64 * (j))
#define XB_TOP      3328
#define XB_TOPGEN   3392
#define XCD_BAR_WORDS 3456
#define XB_SPIN_CAP (1u << 18)

__device__ __forceinline__ unsigned xb_ld(unsigned* p)              { return __hip_atomic_load(p, __ATOMIC_RELAXED, __HIP_MEMORY_SCOPE_AGENT); }
__device__ __forceinline__ unsigned xb_add(unsigned* p, unsigned v) { return __hip_atomic_fetch_add(p, v, __ATOMIC_RELAXED, __HIP_MEMORY_SCOPE_AGENT); }
__device__ __forceinline__ unsigned xb_xcc_id() { return (unsigned)__builtin_amdgcn_s_getreg((3 << 11) | 20) & 0xFu; }
#define XB_SPIN(cond, bar) do { unsigned _sp = 0; while (cond) { __builtin_amdgcn_s_sleep(1); \
    if ((++_sp & 255u) == 0u) { if (xb_ld(&(bar)[XB_TMO])) break; if (_sp > XB_SPIN_CAP) { atomicAdd(&(bar)[XB_TMO], 1u); break; } } } } while (0)

struct XcdBarrier {
    unsigned* bar; unsigned x;
    volatile LAS unsigned* st;
};

__device__ __forceinline__ XcdBarrier xcd_barrier_post(unsigned* bar, volatile LAS unsigned* st) {
    XcdBarrier b; b.bar = bar; b.x = xb_xcc_id(); b.st = st;
    if (threadIdx.x == 0) (void)xb_add(&bar[XB_XCNT(b.x)], 1u);
    return b;
}
__device__ __forceinline__ void xcd_barrier_complete(unsigned* bar, unsigned x, unsigned& nloc, unsigned& nx) {
    const unsigned G = gridDim.x * gridDim.y * gridDim.z;
    unsigned sum, cnt, mine, sp = 0u;
    for (;;) {
        sum = 0u; cnt = 0u; mine = 0u;
#pragma unroll
        for (unsigned j = 0; j < 16; ++j) { const unsigned c = xb_ld(&bar[XB_XCNT(j)]); sum += c; cnt += (c > 0u) ? 1u : 0u; mine = (j == x) ? c : mine; }
        if (sum == G) break;
        __builtin_amdgcn_s_sleep(1);
        if ((++sp & 255u) == 0u) { if (xb_ld(&bar[XB_TMO])) break; if (sp > XB_SPIN_CAP) { atomicAdd(&bar[XB_TMO], 1u); break; } }
    }
    nloc = mine > 0u ? mine : 1u; nx = cnt > 0u ? cnt : 1u;
}

__device__ __forceinline__ void xcd_barrier(const XcdBarrier& b) {
    asm volatile("s_waitcnt vmcnt(0)" ::: "memory");
    __syncthreads();
    if (threadIdx.x == 0) {
        unsigned* bar = b.bar;
        __builtin_amdgcn_s_waitcnt(0);
        unsigned nloc = b.st[0], nx = b.st[1];
        if (nloc == 0u) { xcd_barrier_complete(bar, b.x, nloc, nx); b.st[0] = nloc; b.st[1] = nx; }
        const unsigned old = xb_add(&bar[XB_XSUB(b.x)], 1u);
        const unsigned gen = old / nloc;
        if (old + 1u == (gen + 1u) * nloc) {
            __builtin_amdgcn_fence(__ATOMIC_RELEASE, "agent");
            asm volatile("s_waitcnt vmcnt(0)" ::: "memory");
            const unsigned og = xb_add(&bar[XB_TOP], 1u);
            const unsigned tg = og / nx;
            if (og + 1u == (tg + 1u) * nx) xb_add(&bar[XB_TOPGEN], 1u);
            else XB_SPIN(xb_ld(&bar[XB_TOPGEN]) == tg, bar);
            __builtin_amdgcn_fence(__ATOMIC_ACQUIRE, "agent");
            xb_add(&bar[XB_XGEN(b.x)], 1u);
            asm volatile("s_waitcnt vmcnt(0)" ::: "memory");
        } else {
            XB_SPIN(xb_ld(&bar[XB_XGEN(b.x)]) == gen, bar);
            __builtin_amdgcn_fence(__ATOMIC_ACQUIRE, "agent");
            asm volatile("s_waitcnt vmcnt(0)" ::: "memory");
        }
    }
    __syncthreads();
}

template <class F> struct EpiFn {
    static constexpr bool PERM = true, AFTER_DRAIN = false;
    F f;
    DI void operator()(const f32x4 (&acc)[2][2][4][2], const pg8::Unit& u, int wr, int wc, int fr, int fq) const {
        const int row0 = u.pm * 256 + wr * 64 + fr, col0 = u.pn * 256 + wc * 32 + 8 * fq;
        const int kind = f.kind(u.pn);
#pragma unroll
        for (int ai = 0; ai < 2; ++ai)
#pragma unroll
            for (int m = 0; m < 4; ++m)
#pragma unroll
                for (int bj = 0; bj < 2; ++bj) f(kind, row0 + ai * 128 + m * 16, col0 + bj * 128, acc[ai][bj][m][0], acc[ai][bj][m][1]);
    }
};
DI u32x4 pack8(f32x4 a, f32x4 b) { u32x4 w; w.x = pk2(a[0], a[1]); w.y = pk2(a[2], a[3]); w.z = pk2(b[0], b[1]); w.w = pk2(b[2], b[3]); return w; }
DI void st8f(float* p, f32x4 a, f32x4 b) { *(f32x4*)p = a; *(f32x4*)(p + 4) = b; }

struct FnA {
    bf16* qa; float* fa; bf16* va; bf16* oga; bf16* memq; const float* lb;
    DI int kind(int pn) const { return pn < 12 ? 0 : pn < 18 ? 2 : pn < 24 ? 3 : 4; }
    DI void operator()(int kind, int row, int col, f32x4 v0, f32x4 v1) const {
        if (kind == 0) {
            const int ch = (col >> 8) * HD + (col & 127);
            if (((col >> 7) & 1) == 0) {
#pragma unroll
                for (int e = 0; e < 4; ++e) { v0[e] = v0[e] * sigm(v0[e]); v1[e] = v1[e] * sigm(v1[e]); }
                *(u32x4*)(qa + (size_t)row * TOK + ch) = pack8(v0, v1);
            } else {
                const f32x4 l0 = *(const f32x4*)(lb + ch), l1 = *(const f32x4*)(lb + ch + 4);
#pragma unroll
                for (int e = 0; e < 4; ++e) { v0[e] = l0[e] + (1.f - l0[e]) * sigm(v0[e]); v1[e] = l1[e] + (1.f - l1[e]) * sigm(v1[e]); }
                st8f(fa + (size_t)row * TOK + ch, v0, v1);
            }
        } else if (kind == 2) {
            *(u32x4*)(va + (size_t)row * TOK + (col - 2 * TOK)) = pack8(v0, v1);
        } else if (kind == 3) {
#pragma unroll
            for (int e = 0; e < 4; ++e) { v0[e] = sigm(v0[e]); v1[e] = sigm(v1[e]); }
            *(u32x4*)(oga + (size_t)row * TOK + (col - 3 * TOK)) = pack8(v0, v1);
        } else {
            *(u32x4*)(memq + (size_t)row * MEMW + (col - 4 * TOK)) = pack8(v0, v1);
        }
    }
};
template <int CTRL> DI float dpp_mov0(float x) { return __builtin_bit_cast(float, __builtin_amdgcn_update_dpp(0, __builtin_bit_cast(int, x), CTRL, 0xf, 0xf, false)); }
DI float row_scan16(float x) { x += dpp_mov0<0x111>(x); x += dpp_mov0<0x112>(x); x += dpp_mov0<0x114>(x); x += dpp_mov0<0x118>(x); return x; }
struct EpiA {
    static constexpr bool PERM = true, AFTER_DRAIN = false;
    bf16* qp; bf16* kp; bf16* kt; bf16* vf; float* dv; bf16* oga; bf16* memq; const float* lb; FnA fs;
    DI void operator()(const f32x4 (&acc)[2][2][4][2], const pg8::Unit& u, int wr, int wc, int fr, int fq) const {
        const int pn = u.pn;
        if (u.pm >= MPR / 256) {
            const int row0 = u.pm * 256 + wr * 64 + fr, col0 = pn * 256 + wc * 32 + 8 * fq, kind = fs.kind(pn);
#pragma unroll
            for (int ai = 0; ai < 2; ++ai)
#pragma unroll
                for (int m = 0; m < 4; ++m)
#pragma unroll
                    for (int bj = 0; bj < 2; ++bj) fs(kind, row0 + ai * 128 + m * 16, col0 + bj * 128, acc[ai][bj][m][0], acc[ai][bj][m][1]);
        } else if (pn < 12) {
            const int k0 = 32 * wc + 8 * fq;
            const f32x4 l0 = *(const f32x4*)(lb + pn * HD + k0), l1 = *(const f32x4*)(lb + pn * HD + k0 + 4);
#pragma unroll
            for (int ai = 0; ai < 2; ++ai)
#pragma unroll
                for (int mp = 0; mp < 2; ++mp) {
                    const int grow0 = u.pm * 256 + ai * 128 + wr * 64 + mp * 32, bh = (grow0 >> 11) * NH + pn, c = (grow0 & (TP - 1)) >> 5;
                    const size_t cb = ((size_t)bh * 64 + c) * 4096;
                    const size_t rowoff = (size_t)(wc * 2 + ((fq >> 1) & 1)) * 512 + (fq & 1) * 4;
#pragma unroll
                    for (int eh = 0; eh < 2; ++eh) {
                        float q1[2][4], k1[2][4], k2[2][4];
#pragma unroll
                        for (int e4 = 0; e4 < 4; ++e4) {
                            const float lbv = eh ? l1[e4] : l0[e4];
                            float qv[2], kk[2], sc[2];
#pragma unroll
                            for (int mo = 0; mo < 2; ++mo) {
                                const float uq = acc[ai][0][2 * mp + mo][eh][e4], uf = acc[ai][1][2 * mp + mo][eh][e4];
                                qv[mo] = uq * sigm(uq);
                                const float f = lbv + (1.f - lbv) * sigm(uf);
                                kk[mo] = 1.f - f;
                                sc[mo] = row_scan16(__builtin_amdgcn_logf(f));
                            }
                            const float tot0 = __shfl(sc[0], 15, 16), tot1 = __shfl(sc[1], 15, 16);
                            const float b0 = sc[0], b1 = tot0 + sc[1], r = tot0, b31 = tot0 + tot1;
                            q1[0][e4] = qv[0] * __builtin_amdgcn_exp2f(b0 - r); q1[1][e4] = qv[1] * __builtin_amdgcn_exp2f(b1 - r);
                            k1[0][e4] = kk[0] * __builtin_amdgcn_exp2f(r - b0); k1[1][e4] = kk[1] * __builtin_amdgcn_exp2f(r - b1);
                            k2[0][e4] = kk[0] * __builtin_amdgcn_exp2f(b31 - b0); k2[1][e4] = kk[1] * __builtin_amdgcn_exp2f(b31 - b1);
                            if (fr == 0) { float* dp = dv + ((size_t)bh * 64 + c) * 256 + k0 + 4 * eh + e4; dp[0] = __builtin_amdgcn_exp2f(b31); dp[128] = __builtin_amdgcn_exp2f(r); }
                        }
#pragma unroll
                        for (int mo = 0; mo < 2; ++mo) {
                            const int tt = 16 * mo + fr;
                            const size_t o = cb + rowoff + (size_t)(tt + 32 * eh) * 8;
                            u32x2 w; w.x = pk2(q1[mo][0], q1[mo][1]); w.y = pk2(q1[mo][2], q1[mo][3]); *(u32x2*)(qp + o) = w;
                            w.x = pk2(k1[mo][0], k1[mo][1]); w.y = pk2(k1[mo][2], k1[mo][3]); *(u32x2*)(kp + o) = w;
                            bf16* tp = kt + cb + vf_off(tt, k0 + 4 * eh);
#pragma unroll
                            for (int e4 = 0; e4 < 4; ++e4) tp[e4 * 8] = f2bf(k2[mo][e4]);
                        }
                    }
                }
        } else {
            const int row0 = u.pm * 256 + wr * 64 + fr, col0 = pn * 256 + wc * 32 + 8 * fq;
#pragma unroll
            for (int ai = 0; ai < 2; ++ai)
#pragma unroll
                for (int m = 0; m < 4; ++m)
#pragma unroll
                    for (int bj = 0; bj < 2; ++bj) {
                        const int row = row0 + ai * 128 + m * 16, col = col0 + bj * 128; f32x4 v0 = acc[ai][bj][m][0], v1 = acc[ai][bj][m][1];
                        if (pn < 18) {
                            const int hv = (col - 2 * TOK) >> 7, vd = col & 127, t = row & (TP - 1);
                            bf16* p = vf + ((size_t)((row >> 11) * NH + hv) * 64 + (t >> 5)) * 4096 + vf_off(t & 31, vd);
#pragma unroll
                            for (int e = 0; e < 4; ++e) { p[e * 8] = f2bf(v0[e]); p[(e + 4) * 8] = f2bf(v1[e]); }
                        } else if (pn < 24) {
#pragma unroll
                            for (int e = 0; e < 4; ++e) { v0[e] = sigm(v0[e]); v1[e] = sigm(v1[e]); }
                            *(u32x4*)(oga + (size_t)row * TOK + (col - 3 * TOK)) = pack8(v0, v1);
                        } else {
                            *(u32x4*)(memq + (size_t)row * MEMW + (col - 4 * TOK)) = pack8(v0, v1);
                        }
                    }
        }
    }
};
struct FnM {
    float* out; bf16* mk; bf16* mvt;
    DI int kind(int pn) const { return (pn & 3) >> 1; }
    DI void operator()(int kind, int row, int col, f32x4 v0, f32x4 v1) const {
        const int b = row >> 8, m = row & 255, l = col >> 10, c = col & 1023, h = (c >> 7) & 3, d = c & 127;
        st8f(out + O_MP + ((size_t)((l * BP + b) * MEML + m)) * 1024 + c, v0, v1);
        const size_t hb = ((size_t)((l * 40 + b) * 4 + h)) * MEML * HD + (size_t)(m >> 5) * 4096;
        if (kind == 0) {
            *(u32x4*)(mk + hb + kf_off(m & 31, d)) = pack8(v0, v1);
        } else {
            bf16* p = mvt + hb + vf_off(m & 31, d);
#pragma unroll
            for (int e = 0; e < 4; ++e) { p[e * 8] = f2bf(v0[e]); p[(e + 4) * 8] = f2bf(v1[e]); }
        }
    }
};
struct FnC {
    float* o; int ld;
    DI int kind(int) const { return 0; }
    DI void operator()(int, int row, int col, f32x4 v0, f32x4 v1) const { st8f(o + (size_t)row * ld + col, v0, v1); }
};
struct FnO {
    bf16* o; int ld;
    DI int kind(int) const { return 0; }
    DI void operator()(int, int row, int col, f32x4 v0, f32x4 v1) const { *(u32x4*)(o + (size_t)row * ld + col) = pack8(v0, v1); }
};
struct FnF1 {
    bf16* ab; float* out; int layer;
    DI int kind(int) const { return 0; }
    DI void operator()(int, int row, int col, f32x4 v0, f32x4 v1) const {
        const int half = (col >> 7) & 1, n = (col >> 8) * 128 + (col & 127);
        *(u32x4*)(ab + (size_t)row * FF2 + half * FF + n) = pack8(v0, v1);
        if (half == 0 && row >= MPR && row < MR) { const int rs = row - MPR, t = rs & 3; if (t >= 2) st8f(out + O_CS + ((size_t)((layer * BS + (rs >> 2)) * 2 + (t - 2))) * FF + n, v0, v1); }
    }
};
template <int CTRL> DI float dpp_ror(float x) { return __builtin_bit_cast(float, __builtin_amdgcn_update_dpp(0, __builtin_bit_cast(int, x), CTRL, 0xf, 0xf, false)); }
struct EpiF1 {
    static constexpr bool PERM = true, AFTER_DRAIN = false;
    bf16* hid; float* fix; float* halo; float* out; const float* wconv; const float* bconv; int layer;
    DI void operator()(const f32x4 (&acc)[2][2][4][2], const pg8::Unit& u, int wr, int wc, int fr, int fq) const {
        const int n0 = u.pn * 128 + wc * 32 + 8 * fq;
        f32x4 w0[2], w1[2], w2[2], bb[2];
#pragma unroll
        for (int eh = 0; eh < 2; ++eh) { w0[eh] = *(const f32x4*)(wconv + n0 + 4 * eh); w1[eh] = *(const f32x4*)(wconv + FF + n0 + 4 * eh); w2[eh] = *(const f32x4*)(wconv + 2 * FF + n0 + 4 * eh); bb[eh] = *(const f32x4*)(bconv + n0 + 4 * eh); }
#pragma unroll
        for (int ai = 0; ai < 2; ++ai) {
            const int rowb = u.pm * 256 + ai * 128 + wr * 64, blk = rowb >> 6;
            f32x4 p1[2] = {(f32x4){0.f, 0.f, 0.f, 0.f}, (f32x4){0.f, 0.f, 0.f, 0.f}}, p2[2] = {(f32x4){0.f, 0.f, 0.f, 0.f}, (f32x4){0.f, 0.f, 0.f, 0.f}};
#pragma unroll
            for (int m = 0; m < 4; ++m) {
                const int row = rowb + m * 16 + fr;
                f32x4 h[2];
#pragma unroll
                for (int eh = 0; eh < 2; ++eh) {
                    f32x4 c1, c2;
#pragma unroll
                    for (int e = 0; e < 4; ++e) { const float av = acc[ai][0][m][eh][e]; c1[e] = dpp_ror<0x121>(av); c2[e] = dpp_ror<0x122>(av); }
#pragma unroll
                    for (int e = 0; e < 4; ++e) {
                        const float e1 = fr >= 1 ? c1[e] : p1[eh][e], e0 = fr >= 2 ? c2[e] : p2[eh][e];
                        const float cc = bb[eh][e] + w0[eh][e] * e0 + w1[eh][e] * e1 + w2[eh][e] * acc[ai][0][m][eh][e];
                        h[eh][e] = gelu_t(cc) * acc[ai][1][m][eh][e];
                    }
                    p1[eh] = c1; p2[eh] = c2;
                }
                if (m == 0 && fr < 2) {
                    float* fp = fix + ((size_t)(blk * 2 + fr) * 2) * FF + n0;
                    st8f(fp, acc[ai][0][0][0], acc[ai][0][0][1]); st8f(fp + FF, acc[ai][1][0][0], acc[ai][1][0][1]);
                } else {
                    *(u32x4*)(hid + (size_t)row * FF + n0) = pack8(h[0], h[1]);
                }
                if (m == 3 && fr >= 14) {
                    st8f(halo + ((size_t)(blk * 2 + (fr - 14))) * FF + n0, acc[ai][0][3][0], acc[ai][0][3][1]);
                    const int t = row & (TP - 1);
                    if (t >= TP - 2) st8f(out + O_CP + ((size_t)((layer * BP + (row >> 11)) * 2 + (t - (TP - 2)))) * FF + n0, acc[ai][0][3][0], acc[ai][0][3][1]);
                }
            }
        }
    }
};
struct FnB {
    bf16* qb; bf16* memq; float* gates; float* out; bf16* kcmp; bf16* vcmp; bf16* ksel; bf16* vselt; bf16* kwin; bf16* vwint;
    DI int kind(int pn) const { return pn < 6 ? 0 : pn < 8 ? 1 : pn < 14 ? 2 + (pn - 8) : 8; }
    DI void operator()(int kind, int row, int col, f32x4 v0, f32x4 v1) const {
        if (kind == 0) { *(u32x4*)(qb + (size_t)row * TOK + col) = pack8(v0, v1); }
        else if (kind == 1) { *(u32x4*)(memq + (size_t)row * MEMW + (col - TOK)) = pack8(v0, v1); }
        else if (kind == 8) {
            const int c = col - 3584;
            if (c < 36) {
#pragma unroll
                for (int e = 0; e < 4; ++e) { v0[e] = sigm(v0[e]); v1[e] = sigm(v1[e]); }
                st8f(gates + (size_t)row * 40 + c, v0, v1);
            }
        } else {
            const int kk = kind - 2, cp = col - 2048, g = (col >> 7) & 1, d = col & 127;
            if (row < MPR) {
                const int b = row >> 11, t = row & (TP - 1);
                if (kk < 4) st8f(out + O_KVP + (size_t)row * 1024 + cp, v0, v1);
                else if (t >= TP - 512) st8f(out + O_WP + ((size_t)(b * 512 + (t - (TP - 512)))) * 512 + (cp - 1024), v0, v1);
                const size_t gb = (size_t)(b * GB + g) * TP * HD;
                if (kk == 3 || kk == 5) {
                    bf16* p = (kk == 3 ? vselt : vwint) + gb + (size_t)(t >> 5) * 4096 + vf_off(t & 31, d);
#pragma unroll
                    for (int e = 0; e < 4; ++e) { p[e * 8] = f2bf(v0[e]); p[(e + 4) * 8] = f2bf(v1[e]); }
                } else if (kk < 2) {
                    *(u32x4*)((kk == 0 ? kcmp : vcmp) + gb + (size_t)t * HD + d) = pack8(v0, v1);
                } else {
                    *(u32x4*)((kk == 2 ? ksel : kwin) + gb + (size_t)(t >> 5) * 4096 + kf_off(t & 31, d)) = pack8(v0, v1);
                }
            } else if (row < MR) {
                const int rs = row - MPR;
                if (kk < 4) st8f(out + O_KVS + (size_t)rs * 1024 + cp, v0, v1);
                else st8f(out + O_WS + (size_t)rs * 512 + (cp - 1024), v0, v1);
            }
        }
    }
};

struct Args { const float* in[25]; float* out; unsigned char* ws; };
typedef const __attribute__((address_space(4))) Args& ArgsRef;
DI const __attribute__((address_space(4))) Args* phase_args() { const __attribute__((address_space(4))) Args* p = (const __attribute__((address_space(4))) Args*)__builtin_amdgcn_kernarg_segment_ptr(); asm volatile("" : "+s"(p)); return p; }
enum { I_XP = 0, I_XS, I_MEMP, I_HST, I_CCONV, I_CMEM, I_CKV, I_CWIN, I_PT, I_NG, I_WINA, I_LBL, I_HGN, I_WINB, I_WO, I_WMKV, I_KVN, I_WKVB, I_CPOS, I_WC1, I_WC2, I_WF1, I_WCONV, I_BCONV, I_WF2 };

struct SegD { int in_idx, src_off, ldw, col0, nvalid, ncols, gain_idx, gain_off, row0, K; unsigned long long dst; };
static constexpr SegD k_segs[17] = {
    {I_WINA, 0, NA, 0, NA, NA, I_NG, 0, 0, 2048, WS_BTA},
    {I_WO, 0, D, 0, D, D, -1, 0, 0, 2048, WS_BTO0},
    {I_WO, D * D, D, 0, D, D, -1, 0, 0, 2048, WS_BTO1},
    {I_WF1, 0, FF2, 0, FF2, FF2, I_NG, 2 * D, 0, 2048, WS_BTF10},
    {I_WF1, D * FF2, FF2, 0, FF2, FF2, I_NG, 6 * D, 0, 2048, WS_BTF11},
    {I_WF2, 0, D, 0, D, D, -1, 0, 0, FF, WS_BTF20},
    {I_WF2, FF * D, D, 0, D, D, -1, 0, 0, FF, WS_BTF21},
    {I_WINB, 0, 2084, 0, 1536, 1536, I_NG, 4 * D, 0, 2048, WS_BTB},
    {I_WINB, 0, 2084, 1572, 512, 512, I_NG, 4 * D, 1536, 2048, WS_BTB},
    {I_WINB, 0, 2084, 1536, 36, 256, I_NG, 4 * D, 3584, 2048, WS_BTB},
    {I_WKVB, 0, 1536, 0, 1536, 1536, I_KVN, 0, 2048, 2048, WS_BTB},
    {I_WMKV, 0, 1024, 0, 1024, 1024, -1, 0, 0, 2048, WS_BTM},
    {I_WMKV, D * 1024, 1024, 0, 1024, 1024, -1, 0, 1024, 2048, WS_BTM},
    {I_WC1, 0, 128, 0, 128, 128, -1, 0, 0, 2048, WS_BTC},
    {I_WC1, 2048 * 128, 128, 0, 128, 128, -1, 0, 128, 2048, WS_BTC},
    {I_WC1, 4096 * 128, 128, 0, 128, 128, -1, 0, 0, 2048, WS_BTC + (size_t)256 * 2048 * 2},
    {I_WC1, 4096 * 128 + 2048 * 128, 128, 0, 128, 128, -1, 0, 128, 2048, WS_BTC + (size_t)256 * 2048 * 2},
};
static constexpr int k_tl_end[17] = { 832, 1088, 1344, 2752, 4160, 4864, 5568, 5760, 5824, 5856, 6048, 6176, 6304, 6336, 6368, 6400, 6432 };
constexpr int TL_A0 = 832, TL_LATE0 = 832, TL_LATE1 = 6048, TL_END = 6432;
struct TrTile { bf16* dst; int k0, n0, row0, K, ncols; f32x4 v[8]; float gk[8]; };
DI void tr_load(ArgsRef a, int tile, TrTile& T, int tid) {
    int s = 0, base = 0;
#pragma unroll
    for (int i = 0; i < 16; ++i) { const bool ge = tile >= k_tl_end[i]; s += ge ? 1 : 0; base = ge ? k_tl_end[i] : base; }
    SegD sd = k_segs[0];
#pragma unroll
    for (int i = 1; i < 17; ++i) if (s == i) sd = k_segs[i];
    const int r = tile - base, ncb = (sd.ncols + 255) >> 8, kb = r / ncb, nb = r - kb * ncb, k0 = 64 * kb, n0 = 256 * nb;
    const float* W = a.in[sd.in_idx] + sd.src_off;
    const float* gain = sd.gain_idx >= 0 ? a.in[sd.gain_idx] + sd.gain_off : nullptr;
    T.dst = (bf16*)(a.ws + sd.dst); T.k0 = k0; T.n0 = n0; T.row0 = sd.row0; T.K = sd.K; T.ncols = sd.ncols;
    const int ilv = (s == 0) ? TOK : (s == 3 || s == 4) ? FF : 0;
#pragma unroll
    for (int i = 0; i < 8; ++i) {
        const int idx = i * NTHR + tid, kk = idx >> 6, c4 = (idx & 63) * 4, n = n0 + c4, g128 = n & ~127;
        const int scol = (ilv && (s != 0 || g128 < 2 * TOK)) ? ((g128 >> 7) & 1) * ilv + (g128 >> 8) * 128 + (n & 127) : n;
        const float* src = W + (size_t)(k0 + kk) * sd.ldw + sd.col0 + scol;
        if (n + 3 < sd.nvalid) T.v[i] = *(const f32x4*)src;
        else { for (int e = 0; e < 4; ++e) T.v[i][e] = (n + e < sd.nvalid) ? src[e] : 0.f; }
        T.gk[i] = gain ? gain[k0 + kk] : 1.f;
    }
}
constexpr int TR_LD = 260, TR_BUF = 64 * TR_LD * 2;
DI void tr_write(const TrTile& T, LAS unsigned char* buf, int tid) {
#pragma unroll
    for (int i = 0; i < 8; ++i) {
        const int idx = i * NTHR + tid, kk = idx >> 6, c4 = (idx & 63) * 4; const float g = T.gk[i];
        u32x2 w; w.x = pk2(T.v[i][0] * g, T.v[i][1] * g); w.y = pk2(T.v[i][2] * g, T.v[i][3] * g);
        *(LAS u32x2*)(buf + (kk * TR_LD + c4) * 2) = w;
    }
}
DI void tr_store(const TrTile& T, const LAS unsigned char* buf, int tid) {
    const LAS bf16* B = (const LAS bf16*)buf;
#pragma unroll
    for (int j = 0; j < 4; ++j) {
        const int id = j * NTHR + tid, n = id >> 3, c = id & 7;
        if (T.n0 + n < T.ncols) {
            const LAS bf16* sp = B + (8 * c) * TR_LD + n;
            u32x4 o; o.x = (unsigned)sp[0] | ((unsigned)sp[TR_LD] << 16); o.y = (unsigned)sp[2 * TR_LD] | ((unsigned)sp[3 * TR_LD] << 16);
            o.z = (unsigned)sp[4 * TR_LD] | ((unsigned)sp[5 * TR_LD] << 16); o.w = (unsigned)sp[6 * TR_LD] | ((unsigned)sp[7 * TR_LD] << 16);
            *(u32x4*)(T.dst + (size_t)(T.row0 + T.n0 + n) * T.K + T.k0 + 8 * c) = o;
        }
    }
}
#define TR_BAR() asm volatile("s_waitcnt lgkmcnt(0)\n\ts_barrier" ::: "memory")
template <class MAP>
DI void wg_transpose_run(ArgsRef a, LAS unsigned char* lds, int first, int last, int step, const MAP& map, int tid) {
    if (first >= last) return;
    __syncthreads();
    TrTile T; tr_load(a, map(first), T, tid);
    int par = 0;
    for (int t = first; t < last; t += step) {
        LAS unsigned char* buf = lds + par * TR_BUF;
        tr_write(T, buf, tid);
        const TrTile Tc = T;
        if (t + step < last) tr_load(a, map(t + step), T, tid);
        TR_BAR();
        tr_store(Tc, buf, tid);
        par ^= 1;
    }
    __syncthreads();
}
template <bool NORM> DI void row_to_bf16(const float* xrow, bf16* orow, int lane) {
    const f32x4* xr = (const f32x4*)xrow + lane;
    f32x4 v[8]; float s = 0.f;
#pragma unroll
    for (int j = 0; j < 8; ++j) { v[j] = xr[64 * j]; s += (v[j][0] * v[j][0] + v[j][1] * v[j][1]) + (v[j][2] * v[j][2] + v[j][3] * v[j][3]); }
    float rs = 1.f;
    if (NORM) rs = rsqrtf(wave_sum(s) * (1.f / D) + EPS);
    u32x2* o8 = (u32x2*)orow + lane;
#pragma unroll
    for (int j = 0; j < 8; ++j) { u32x2 w; w.x = pk2(v[j][0] * rs, v[j][1] * rs); w.y = pk2(v[j][2] * rs, v[j][3] * rs); o8[64 * j] = w; }
}
DI void p0_prologue(ArgsRef a, LAS unsigned char* lds, int gw, int ngw, int wave, int lane) {
    bf16* XN = (bf16*)(a.ws + WS_XN);
    for (int m = gw; m < MR; m += ngw) {
        const float* src = m < MPR ? a.in[I_XP] + (size_t)m * D : a.in[I_XS] + (size_t)(m - MPR) * D;
        row_to_bf16<true>(src, XN + (size_t)m * D, lane);
    }
    bf16* MB = (bf16*)(a.ws + WS_MEMPB);
    for (int m = gw; m < BP * MEML; m += ngw) row_to_bf16<false>(a.in[I_MEMP] + (size_t)m * D, MB + (size_t)m * D, lane);
    bf16* MK = (bf16*)(a.ws + WS_MK); bf16* MVT = (bf16*)(a.ws + WS_MVT);
    for (int rr = gw; rr < 2 * BS * MEML; rr += ngw) {
        const int l = rr / (BS * MEML), b = (rr / MEML) % BS, m = rr % MEML;
        const float* src = a.in[I_CMEM] + (size_t)rr * 1024;
#pragma unroll
        for (int j = 0; j < 4; ++j) {
            const int idx = 4 * lane + 256 * j, h = (idx >> 7) & 3, d = idx & 127;
            const f32x4 v = *(const f32x4*)(src + idx);
            const size_t hb = ((size_t)((l * 40 + 8 + b) * 4 + h)) * MEML * HD + (size_t)(m >> 5) * 4096;
            if (j < 2) { u32x2 w; w.x = pk2(v[0], v[1]); w.y = pk2(v[2], v[3]); *(u32x2*)(MK + hb + kf_off(m & 31, d)) = w; }
            else { bf16* p = MVT + hb + vf_off(m & 31, d);
#pragma unroll
                for (int e = 0; e < 4; ++e) p[e * 8] = f2bf(v[e]); }
        }
    }
    for (int idx = gw * 64 + lane; idx < 2 * 128 * 128; idx += ngw * 64) { const int kv = idx >> 14, d = (idx >> 7) & 127, hh = idx & 127; ((bf16*)(a.ws + WS_W2T))[idx] = f2bf(a.in[I_WC2][(size_t)kv * 16384 + hh * 128 + d]); }
    if (gw < 24) { const int c = gw * 64 + lane; const float* ll = a.in[I_LBL]; ((float*)(a.ws + WS_LB))[c] = 1.f / (1.f + __expf(ll[TOK + c] - ll[c])); }
    for (int it = gw; it < 256; it += ngw) {
        const int kv = it >> 7, h = it & 127; const float* pe = a.in[I_CPOS] + kv * 4096; const float* w1 = a.in[I_WC1] + (size_t)kv * 4096 * 128 + h;
        float s = 0.f;
        for (int i = 0; i < 64; ++i) { const int n = lane + 64 * i; s += pe[n] * w1[(size_t)n * 128]; }
        s = wave_sum(s);
        if (lane == 0) ((float*)(a.ws + WS_PRE0))[it] = s;
    }
}


#define MFMA32(a, b, c) __builtin_amdgcn_mfma_f32_32x32x16_bf16((a), (b), (c), 0, 0, 0)
DI int crow(int i, int h) { return (i & 3) + 8 * (i >> 2) + 4 * h; }
DI f32x16 zero16() { f32x16 z; for (int i = 0; i < 16; ++i) z[i] = 0.f; return z; }
DI bf16x8 packp(const f32x16& s, int st) {
    u32x4 p; p.x = pk2(s[8 * st + 0], s[8 * st + 1]); p.y = pk2(s[8 * st + 2], s[8 * st + 3]); p.z = pk2(s[8 * st + 4], s[8 * st + 5]); p.w = pk2(s[8 * st + 6], s[8 * st + 7]);
    return __builtin_bit_cast(bf16x8, p);
}
struct AttnAcc { f32x16 o[4]; float m, l; };
DI void attn_init(AttnAcc& A) { for (int i = 0; i < 4; ++i) A.o[i] = zero16(); A.m = -1e30f; A.l = 0.f; }
DI void load_qf(bf16x8 (&qf)[8], const bf16* qrow, int h) {
#pragma unroll
    for (int ks = 0; ks < 8; ++ks) qf[ks] = *(const bf16x8*)(qrow + 16 * ks + 8 * h);
}
DI f32x16 qk_tile(const bf16x8 (&qf)[8], const bf16* Kt, int lane) {
    f32x16 s = zero16();
    const bf16x8* kp = (const bf16x8*)Kt + lane;
#pragma unroll
    for (int ks = 0; ks < 8; ++ks) s = MFMA32(kp[ks * 64], qf[ks], s);
    return s;
}
DI f32x16 qk_tile_l(const LAS bf16x8* ql, const bf16* Kt, int lane) {
    f32x16 s = zero16();
    const bf16x8* kp = (const bf16x8*)Kt + lane;
#pragma unroll
    for (int ks = 0; ks < 8; ++ks) s = MFMA32(kp[ks * 64], ql[ks * 64 + lane], s);
    return s;
}
DI void pv_tile(f32x16 (&o)[4], const f32x16& p, const bf16* Vt, int lane) {
    const bf16x8* vp = (const bf16x8*)Vt + lane;
#pragma unroll
    for (int st = 0; st < 2; ++st) {
        const bf16x8 pf = packp(p, st);
#pragma unroll
        for (int db = 0; db < 4; ++db) o[db] = MFMA32(vp[(st * 4 + db) * 64], pf, o[db]);
    }
}
template <class VF>
DI void attn_step(AttnAcc& A, f32x16 s, const bf16* Vt, float slope2, float kp0, float kps, const VF& valid, int lane) {
    const int h = lane >> 5;
    float mt = -1e30f;
#pragma unroll
    for (int i = 0; i < 16; ++i) {
        const int kvl = crow(i, h);
        float v = s[i] * SCALE2 + slope2 * (kp0 + kps * (float)kvl);
        v = valid(kvl) ? v : -1e30f;
        s[i] = v; mt = fmaxf(mt, v);
    }
    mt = fmaxf(mt, __shfl_xor(mt, 32));
    const float mn = fmaxf(A.m, mt), alpha = __builtin_amdgcn_exp2f(A.m - mn);
    A.m = mn;
    float ls = 0.f;
#pragma unroll
    for (int i = 0; i < 16; ++i) { const float p = s[i] > -1e29f ? __builtin_amdgcn_exp2f(s[i] - mn) : 0.f; s[i] = p; ls += p; }
    A.l = A.l * alpha + ls;
#pragma unroll
    for (int db = 0; db < 4; ++db) A.o[db] *= alpha;
    pv_tile(A.o, s, Vt, lane);
}
DI void load8(bf16x8 (&f)[8], const bf16* tile, int lane) {
    const bf16x8* p = (const bf16x8*)tile + lane;
#pragma unroll
    for (int i = 0; i < 8; ++i) f[i] = p[i * 64];
}
template <class VF, class FF>
DI void attn_run(AttnAcc& A, const LAS bf16x8* ql, const bf16* Kb, const bf16* Vb, unsigned long long tmask, float slope2, int t0, const VF& validf, const FF& fullf, int lane) {
    if (tmask == 0ull) return;
    const int h = lane >> 5;
    int kt = __builtin_ctzll(tmask); tmask &= tmask - 1ull;
    bf16x8 kf[8]; load8(kf, Kb + (size_t)kt * 4096, lane);
    for (;;) {
        const bf16x8* vp = (const bf16x8*)(Vb + (size_t)kt * 4096) + lane;
        bf16x8 va[4], vb[4];
#pragma unroll
        for (int db = 0; db < 4; ++db) va[db] = vp[db * 64];
#pragma unroll
        for (int db = 0; db < 4; ++db) vb[db] = vp[(4 + db) * 64];
        __builtin_amdgcn_sched_barrier(0);
        const LAS bf16x8* q2 = ql + lane; asm volatile("" : "+v"(q2));
        f32x16 s = zero16();
#pragma unroll
        for (int ks = 0; ks < 8; ++ks) s = MFMA32(kf[ks], q2[ks * 64], s);
        const bool more = tmask != 0ull; int kn = kt;
        const float kb0 = slope2 * (float)(kt * 32 - t0 + 4 * h);
        const bool full = fullf(kt);
        float mt = -1e30f;
        if (full) {
#pragma unroll
            for (int i = 0; i < 16; ++i) { const float v = fmaf(s[i], SCALE2, fmaf(slope2, (float)((i & 3) + 8 * (i >> 2)), kb0)); s[i] = v; mt = fmaxf(mt, v); }
        } else {
#pragma unroll
            for (int i = 0; i < 16; ++i) { float v = fmaf(s[i], SCALE2, fmaf(slope2, (float)((i & 3) + 8 * (i >> 2)), kb0)); v = validf(kt, crow(i, h)) ? v : -1e30f; s[i] = v; mt = fmaxf(mt, v); }
        }
        if (more) { kn = __builtin_ctzll(tmask); tmask &= tmask - 1ull; load8(kf, Kb + (size_t)kn * 4096, lane); }
        __builtin_amdgcn_sched_barrier(0);
        mt = fmaxf(mt, __shfl_xor(mt, 32));
        float mn = A.m;
        if (__any(mt > A.m + 8.f)) {
            mn = fmaxf(A.m, mt);
            const float alpha = __builtin_amdgcn_exp2f(A.m - mn);
            A.m = mn; A.l *= alpha;
#pragma unroll
            for (int db = 0; db < 4; ++db) A.o[db] *= alpha;
        }
        float ls = 0.f;
        if (full) {
#pragma unroll
            for (int i = 0; i < 16; ++i) { const float p = __builtin_amdgcn_exp2f(s[i] - mn); s[i] = p; ls += p; }
        } else {
#pragma unroll
            for (int i = 0; i < 16; ++i) { const float p = s[i] > -1e29f ? __builtin_amdgcn_exp2f(s[i] - mn) : 0.f; s[i] = p; ls += p; }
        }
        A.l += ls;
        { const bf16x8 pf = packp(s, 0);
#pragma unroll
          for (int db = 0; db < 4; ++db) A.o[db] = MFMA32(va[db], pf, A.o[db]); }
        { const bf16x8 pf = packp(s, 1);
#pragma unroll
          for (int db = 0; db < 4; ++db) A.o[db] = MFMA32(vb[db], pf, A.o[db]); }
        if (!more) break;
        kt = kn;
    }
}
DI float attn_inv(const AttnAcc& A) { const float lt = A.l + __shfl_xor(A.l, 32); return lt > 0.f ? 1.f / lt : 0.f; }
DI void store_ot(bf16* orow, const f32x16 (&o)[4], int h) {
#pragma unroll
    for (int db = 0; db < 4; ++db)
#pragma unroll
        for (int c = 0; c < 4; ++c) {
            u32x2 w; w.x = pk2(o[db][4 * c], o[db][4 * c + 1]); w.y = pk2(o[db][4 * c + 2], o[db][4 * c + 3]);
            *(u32x2*)(orow + 32 * db + 8 * c + 4 * h) = w;
        }
}

DI void memattn_item(ArgsRef a, int layer, int it, LAS float* wreg, int lane) {
    const int r = lane & 31, h = lane >> 5;
    int bq, hd, row, nvalid;
    if (it < BP * MEMH * 64) { bq = it >> 8; hd = (it >> 6) & 3; const int tau = it & 63; row = bq * TP + tau * 32 + r; nvalid = 32; }
    else { const int j = it - BP * MEMH * 64; const int bs = j >> 2; hd = j & 3; bq = 8 + bs; row = MPR + bs * 4 + (r < 4 ? r : 3); nvalid = 4; }
    const bf16* MEMQ = (const bf16*)(a.ws + WS_MEMQ);
    const bf16* K = (const bf16*)(a.ws + WS_MK) + ((size_t)((layer * 40 + bq) * 4 + hd)) * MEML * HD;
    const bf16* VT = (const bf16*)(a.ws + WS_MVT) + ((size_t)((layer * 40 + bq) * 4 + hd)) * HD * MEML;
    LAS bf16x8* ql = (LAS bf16x8*)(wreg + 2048);
    { bf16x8 qf[8]; load_qf(qf, MEMQ + (size_t)row * MEMW + hd * HD, h);
#pragma unroll
      for (int ks = 0; ks < 8; ++ks) ql[ks * 64 + lane] = qf[ks]; }
    LDS_WAIT(); asm volatile("" ::: "memory");
    AttnAcc A; attn_init(A);
    attn_run(A, ql, K, VT, 0xffull, 0.f, 0, [](int, int) { return true; }, [](int) { return true; }, lane);
    const float inv = attn_inv(A);
#pragma unroll
    for (int db = 0; db < 4; ++db) A.o[db] *= inv;
    if (r < nvalid) store_ot((bf16*)(a.ws + WS_CAT) + (size_t)row * D + TOK + hd * HD, A.o, h);
    LDS_WAIT(); asm volatile("" ::: "memory");
}

DI void memattn_wg(ArgsRef a, int layer, int item, LAS unsigned char* lds, int tid) {
    const int wave = __builtin_amdgcn_readfirstlane(tid >> 6), lane = tid & 63, r = lane & 31, h = lane >> 5;
    int bq, hd, row, nvalid; bool active;
    if (item < 256) { bq = item >> 5; hd = (item >> 3) & 3; const int tau = (item & 7) * 8 + wave; row = bq * TP + tau * 32 + r; nvalid = 32; active = true; }
    else { const int j = item - 256; const int bs = j >> 2; hd = j & 3; bq = 8 + bs; row = MPR + bs * 4 + (r < 4 ? r : 3); nvalid = 4; active = wave == 0; }
    const bf16* MEMQ = (const bf16*)(a.ws + WS_MEMQ);
    const bf16* K = (const bf16*)(a.ws + WS_MK) + ((size_t)((layer * 40 + bq) * 4 + hd)) * MEML * HD;
    const bf16* VT = (const bf16*)(a.ws + WS_MVT) + ((size_t)((layer * 40 + bq) * 4 + hd)) * HD * MEML;
    __syncthreads();
    { const u32x4* kc = (const u32x4*)K; const u32x4* vc = (const u32x4*)VT;
      u32x4 tk[8], tv[8];
#pragma unroll
      for (int j = 0; j < 8; ++j) { tk[j] = kc[j * NTHR + tid]; tv[j] = vc[j * NTHR + tid]; }
#pragma unroll
      for (int j = 0; j < 8; ++j) { ((LAS u32x4*)lds)[j * NTHR + tid] = tk[j]; ((LAS u32x4*)(lds + 65536))[j * NTHR + tid] = tv[j]; } }
    bf16x8 qf[8]; load_qf(qf, MEMQ + (size_t)row * MEMW + hd * HD, h);
    __syncthreads();
    if (active) {
        const LAS bf16x8* KL = (const LAS bf16x8*)lds + lane; const LAS bf16x8* VL = (const LAS bf16x8*)(lds + 65536) + lane;
        AttnAcc A; attn_init(A);
#pragma unroll 1
        for (int kt = 0; kt < 8; ++kt) {
            f32x16 s = zero16();
#pragma unroll
            for (int ks = 0; ks < 8; ++ks) s = MFMA32(KL[(kt * 8 + ks) * 64], qf[ks], s);
            float mt = -1e30f;
#pragma unroll
            for (int i = 0; i < 16; ++i) { s[i] *= SCALE2; mt = fmaxf(mt, s[i]); }
            mt = fmaxf(mt, __shfl_xor(mt, 32));
            float mn = A.m;
            if (__any(mt > A.m + 8.f)) { mn = fmaxf(A.m, mt); const float alpha = __builtin_amdgcn_exp2f(A.m - mn); A.m = mn; A.l *= alpha;
#pragma unroll
                for (int db = 0; db < 4; ++db) A.o[db] *= alpha; }
            float ls = 0.f;
#pragma unroll
            for (int i = 0; i < 16; ++i) { const float p = __builtin_amdgcn_exp2f(s[i] - mn); s[i] = p; ls += p; }
            A.l += ls;
#pragma unroll
            for (int st = 0; st < 2; ++st) { const bf16x8 pf = packp(s, st);
#pragma unroll
                for (int db = 0; db < 4; ++db) A.o[db] = MFMA32(VL[(kt * 8 + st * 4 + db) * 64], pf, A.o[db]); }
        }
        const float inv = attn_inv(A);
#pragma unroll
        for (int db = 0; db < 4; ++db) A.o[db] *= inv;
        if (r < nvalid) store_ot((bf16*)(a.ws + WS_CAT) + (size_t)row * D + TOK + hd * HD, A.o, h);
    }
    __syncthreads();
}

DI void cmp1_item(ArgsRef a, int it, int lane) {
    const int r = lane & 31, h = lane >> 5;
    const int kv = it >> 9, mt = (it >> 3) & 63, nt = it & 7;
    const bf16* Ap = (const bf16*)(a.ws + (kv ? WS_VCMP : WS_KCMP)) + (size_t)(32 * mt + r) * 2048 + 8 * h;
    const bf16* Bp = (const bf16*)(a.ws + WS_BTC) + (size_t)kv * 256 * 2048 + (size_t)(32 * nt + r) * 2048 + 8 * h;
    f32x16 c = zero16();
#pragma unroll 8
    for (int ks = 0; ks < 128; ++ks) { const bf16x8 af = *(const bf16x8*)(Ap + 16 * ks), bfr = *(const bf16x8*)(Bp + 16 * ks); c = MFMA32(af, bfr, c); }
    float* P = (float*)(a.ws + WS_PPP) + (size_t)kv * 2048 * 256;
#pragma unroll
    for (int i = 0; i < 16; ++i) P[(size_t)(32 * mt + crow(i, h)) * 256 + 32 * nt + r] = c[i];
}
DI void cmp2_item(ArgsRef a, int it, int lane) {
    const int r = lane & 31, h = lane >> 5;
    const bool prompt = it < 128; int kv, bg, blk, nI; const float* PP;
    if (prompt) { kv = it >> 6; bg = (it >> 2) & 15; blk = it & 3; nI = 128; PP = (const float*)(a.ws + WS_PPP) + (size_t)kv * 2048 * 256; }
    else { const int j = it - 128; kv = j >> 10; bg = (j >> 4) & 63; blk = j & 15; nI = 512; PP = (const float*)(a.ws + WS_PPS) + (size_t)kv * 32768 * 256; }
    const int irow = 32 * blk + r, ic = irow < nI - 1 ? irow : nI - 2;
    const float* p0r = PP + ((size_t)bg * nI + ic) * 256 + 8 * h; const float* p1r = p0r + 256 + 128; const float* c0r = (const float*)(a.ws + WS_PRE0) + kv * 128 + 8 * h;
    bf16x8 af[8];
#pragma unroll
    for (int ks = 0; ks < 8; ++ks) {
        const f32x4 x0 = *(const f32x4*)(p0r + 16 * ks), x1 = *(const f32x4*)(p0r + 16 * ks + 4), y0 = *(const f32x4*)(p1r + 16 * ks), y1 = *(const f32x4*)(p1r + 16 * ks + 4);
        const f32x4 z0 = *(const f32x4*)(c0r + 16 * ks), z1 = *(const f32x4*)(c0r + 16 * ks + 4);
        u32x4 w; w.x = pk2(gelu_t(x0[0] + y0[0] + z0[0]), gelu_t(x0[1] + y0[1] + z0[1])); w.y = pk2(gelu_t(x0[2] + y0[2] + z0[2]), gelu_t(x0[3] + y0[3] + z0[3]));
        w.z = pk2(gelu_t(x1[0] + y1[0] + z1[0]), gelu_t(x1[1] + y1[1] + z1[1])); w.w = pk2(gelu_t(x1[2] + y1[2] + z1[2]), gelu_t(x1[3] + y1[3] + z1[3]));
        af[ks] = __builtin_bit_cast(bf16x8, w);
    }
    const bf16* W2T = (const bf16*)(a.ws + WS_W2T) + (size_t)kv * 16384;
#pragma unroll
    for (int nb = 0; nb < 4; ++nb) {
        const bf16* bp = W2T + (size_t)(32 * nb + r) * 128 + 8 * h;
        f32x16 c = zero16();
#pragma unroll
        for (int ks = 0; ks < 8; ++ks) c = MFMA32(af[ks], *(const bf16x8*)(bp + 16 * ks), c);
        const int d = 32 * nb + r;
#pragma unroll
        for (int i = 0; i < 16; ++i) {
            const int ir = 32 * blk + crow(i, h);
            if (prompt) {
                const float v = ir < NCP ? c[i] : 0.f;
                if (kv == 0) ((bf16*)(a.ws + WS_KC))[(size_t)bg * 16384 + (size_t)(ir >> 5) * 4096 + kf_off(ir & 31, d)] = f2bf(v);
                else ((bf16*)(a.ws + WS_VCT))[(size_t)bg * 16384 + (size_t)(ir >> 5) * 4096 + vf_off(ir & 31, d)] = f2bf(v);
            } else if (ir < NCS) {
                ((float*)(a.ws + (kv ? WS_VCS : WS_KCS)))[((size_t)bg * 512 + ir) * 128 + d] = c[i];
            }
        }
    }
}
template <int KS, class FN>
DI void skinny_gemm(const FN& f, const bf16* A, const bf16* Bt, int N, int K, LAS unsigned char* lds, int bx, int G, int tid, int MT = 4, int orow0 = MPR) {
    constexpr int TPW = NWAVES / KS;
    const int wave = tid >> 6, lane = tid & 63, r = lane & 31, h = lane >> 5;
    const int ntiles = MT * (N >> 5), kw = K / KS, tl = wave / KS, ksub = wave % KS;
    LAS float* red = (LAS float*)lds;
    for (int step = bx; step * TPW < ntiles; step += G) {
        const int tile = step * TPW + tl, tcl = tile < ntiles ? tile : ntiles - 1, mt = tcl % MT, nt = tcl / MT;
        const bf16* Ap = A + (size_t)(32 * mt + r) * K + ksub * kw + 8 * h;
        const bf16* Bp = Bt + (size_t)(32 * nt + r) * K + ksub * kw + 8 * h;
        f32x16 c = zero16();
        for (int k0 = 0; k0 < (kw >> 4); k0 += 16) {
            bf16x8 af[16], bfr[16];
#pragma unroll
            for (int u = 0; u < 16; ++u) { const int ks = k0 + u < (kw >> 4) ? k0 + u : (kw >> 4) - 1; af[u] = *(const bf16x8*)(Ap + 16 * ks); bfr[u] = *(const bf16x8*)(Bp + 16 * ks); }
#pragma unroll
            for (int u = 0; u < 16; ++u) if (k0 + u < (kw >> 4)) c = MFMA32(af[u], bfr[u], c);
        }
        __syncthreads();
#pragma unroll
        for (int i = 0; i < 16; ++i) red[(wave * 16 + i) * 64 + lane] = c[i];
        __syncthreads();
        for (int q = tid; q < TPW * 128; q += NTHR) {
            const int tq = q >> 7, t7 = q & 127, tile2 = step * TPW + tq;
            if (tile2 < ntiles) {
                const int row = t7 >> 2, cg = (t7 & 3) * 8, hh = (row >> 2) & 1, ii = (row & 3) + 4 * (row >> 3);
                float v[8];
#pragma unroll
                for (int e = 0; e < 8; ++e) { float s = 0.f;
#pragma unroll
                    for (int w = 0; w < KS; ++w) s += red[((tq * KS + w) * 16 + ii) * 64 + cg + e + 32 * hh];
                    v[e] = s; }
                const int mt2 = tile2 % MT, nt2 = tile2 / MT;
                f(f.kind((32 * nt2) >> 8), orow0 + 32 * mt2 + row, 32 * nt2 + cg, (f32x4){v[0], v[1], v[2], v[3]}, (f32x4){v[4], v[5], v[6], v[7]});
            }
        }
    }
    __syncthreads();
}


DI void cmpgemm_direct(ArgsRef a, LAS unsigned char* lds, int item, int tid) {
    const int wave = __builtin_amdgcn_readfirstlane(tid >> 6), lane = tid & 63, r = lane & 31, h = lane >> 5;
    const int kv = item >> 7, blk = item & 127;
    const int R = blk * 256 + wave * 32 + r, b = R >> 10, g = (R >> 9) & 1, cc = R & 511;
    const int page = ((const int*)a.in[I_PT])[b * NPAGE + (cc >> 3)];
    const float* ab = a.in[I_CKV] + ((size_t)page * PAGE + (cc & 7) * 16) * 1024 + kv * 256 + g * 128 + 8 * h;
    const bf16* bs = (const bf16*)(a.ws + WS_BTC) + (size_t)kv * 256 * 2048 + (size_t)(32 * (tid >> 6) + r) * 2048 + 8 * h;
    f32x16 acc[8];
#pragma unroll
    for (int nb = 0; nb < 8; ++nb) acc[nb] = zero16();
    f32x4 ac[4][2], an[4][2]; u32x4 bn[4];
    auto lda = [&](f32x4 (&A)[4][2], int t) {
#pragma unroll
        for (int q = 0; q < 4; ++q) { const int k0 = 64 * t + 16 * q; const float* p = ab + (size_t)(k0 >> 7) * 1024 + (k0 & 127); A[q][0] = *(const f32x4*)p; A[q][1] = *(const f32x4*)(p + 4); }
    };
    auto ldb = [&](int t) {
#pragma unroll
        for (int q = 0; q < 4; ++q) bn[q] = *(const u32x4*)(bs + 64 * t + 16 * q);
    };
    auto stb = [&](int t) {
        LAS u32x4* B = (LAS u32x4*)(lds + (t & 1) * 32768);
#pragma unroll
        for (int q = 0; q < 4; ++q) B[(q * 8 + wave) * 64 + lane] = bn[q];
    };
    __syncthreads();
    lda(ac, 0); ldb(0); stb(0);
    TR_BAR();
    for (int t = 0; t < 32; ++t) {
        if (t + 1 < 32) { lda(an, t + 1); ldb(t + 1); }
        const LAS bf16x8* B = (const LAS bf16x8*)(lds + (t & 1) * 32768) + lane;
#pragma unroll
        for (int q = 0; q < 4; ++q) {
            u32x4 w; w.x = pk2(ac[q][0][0], ac[q][0][1]); w.y = pk2(ac[q][0][2], ac[q][0][3]); w.z = pk2(ac[q][1][0], ac[q][1][1]); w.w = pk2(ac[q][1][2], ac[q][1][3]);
            const bf16x8 af = __builtin_bit_cast(bf16x8, w);
#pragma unroll
            for (int nb = 0; nb < 8; ++nb) acc[nb] = MFMA32(af, B[(q * 8 + nb) * 64], acc[nb]);
        }
        if (t + 1 < 32) { stb(t + 1);
#pragma unroll
            for (int q = 0; q < 4; ++q) { ac[q][0] = an[q][0]; ac[q][1] = an[q][1]; } }
        TR_BAR();
    }
    float* P = (float*)(a.ws + WS_PPS) + (size_t)kv * 32768 * 256 + (size_t)(blk * 256 + wave * 32) * 256;
#pragma unroll
    for (int nb = 0; nb < 8; ++nb)
#pragma unroll
        for (int i = 0; i < 16; ++i) P[(size_t)crow(i, h) * 256 + 32 * nb + r] = acc[nb][i];
    __syncthreads();
}

DI void hgrn_sample_item(ArgsRef a, LAS unsigned char* lds, int bs, int hh, int tid) {
    const int wave = tid >> 6, lane = tid & 63, vloc = lane & 15, kg = lane >> 4, v = wave * 16 + vloc;
    const bf16* QA = (const bf16*)(a.ws + WS_QA); const float* FA = (const float*)(a.ws + WS_FA); const bf16* VA = (const bf16*)(a.ws + WS_VA);
    const float* s0 = a.in[I_HST] + ((size_t)(bs * NH + hh) * HD + kg * 32) * HD + v;
    float S[32];
#pragma unroll
    for (int i = 0; i < 32; ++i) S[i] = s0[(size_t)i * HD];
    LAS float* OS = (LAS float*)lds;
#pragma unroll 1
    for (int tp = 0; tp < TS; tp += 2) {
        u32x4 qw[2][4]; f32x4 fw[2][8]; float vv[2];
#pragma unroll
        for (int u = 0; u < 2; ++u) {
            const size_t ro = (size_t)(MPR + bs * TS + tp + u) * TOK + hh * HD;
#pragma unroll
            for (int j = 0; j < 4; ++j) qw[u][j] = *(const u32x4*)(QA + ro + kg * 32 + 8 * j);
#pragma unroll
            for (int j = 0; j < 8; ++j) fw[u][j] = *(const f32x4*)(FA + ro + kg * 32 + 4 * j);
            vv[u] = bf2f(VA[ro + v]);
        }
#pragma unroll
        for (int u = 0; u < 2; ++u) {
            float acc = 0.f;
#pragma unroll
            for (int j = 0; j < 8; ++j) {
                const unsigned w0 = qw[u][j >> 1][(j & 1) * 2], w1 = qw[u][j >> 1][(j & 1) * 2 + 1];
                const float q4[4] = {bflo(w0), bfhi(w0), bflo(w1), bfhi(w1)};
#pragma unroll
                for (int e = 0; e < 4; ++e) { const float f = fw[u][j][e]; const int i = 4 * j + e; S[i] = f * S[i] + (1.f - f) * vv[u]; acc += S[i] * q4[e]; }
            }
            acc += __shfl_xor(acc, 16); acc += __shfl_xor(acc, 32);
            if (kg == 0) OS[(tp + u) * HD + v] = acc;
        }
    }
    float* so = a.out + O_HS + ((size_t)(bs * NH + hh) * HD + kg * 32) * HD + v;
#pragma unroll
    for (int i = 0; i < 32; ++i) so[(size_t)i * HD] = S[i];
    __syncthreads();
    if (wave < TS) {
        const int row = MPR + bs * TS + wave;
        const f32x2 o = *(const LAS f32x2*)(OS + wave * HD + 2 * lane);
        const float rs = rsqrtf(wave_sum(o[0] * o[0] + o[1] * o[1]) * (1.f / HD) + EPS);
        const f32x2 gn = *(const f32x2*)(a.in[I_HGN] + hh * HD + 2 * lane);
        const unsigned og = *(const unsigned*)((const bf16*)(a.ws + WS_OGA) + (size_t)row * TOK + hh * HD + 2 * lane);
        *(unsigned*)((bf16*)(a.ws + WS_CAT) + (size_t)row * D + hh * HD + 2 * lane) = pk2(o[0] * rs * gn[0] * bflo(og), o[1] * rs * gn[1] * bfhi(og));
    }
    __syncthreads();
}

constexpr int HG_BUF = 33792;
constexpr int HG_SSQ = 3 * HG_BUF;
#define HG_BAR() asm volatile("s_waitcnt lgkmcnt(0)\n\ts_barrier" ::: "memory")
DI void hgrn_mfma_item(ArgsRef a, LAS unsigned char* lds, int bh, int tid) {
    const int wave = __builtin_amdgcn_readfirstlane(tid >> 6), lane = tid & 63, r = lane & 31, hh = lane >> 5;
    const int b = bh / NH, h = bh - b * NH;
    const size_t img = (size_t)bh * 64 * 4096;
    __syncthreads();
    if (wave >= 4) {
        const int lw = wave - 4;
        const bf16* src[4] = {(const bf16*)(a.ws + WS_QP) + img, (const bf16*)(a.ws + WS_KP) + img, (const bf16*)(a.ws + WS_KT) + img, (const bf16*)(a.ws + WS_VF) + img};
        const float* dvs = (const float*)(a.ws + WS_DV) + (size_t)bh * 64 * 256;
        u32x4 R0[9], R1[9];
        auto gl = [&](u32x4 (&R)[9], int c) {
            c = c < 64 ? c : 63;
#pragma unroll
            for (int j = 0; j < 8; ++j) R[j] = *(const u32x4*)(src[j >> 1] + (size_t)c * 4096 + (size_t)(((j & 1) * 256 + lw * 64 + lane) * 8));
            R[8] = *(const u32x4*)(dvs + (size_t)c * 256 + lane * 4);
        };
        auto lw_ = [&](const u32x4 (&R)[9], int c) {
            LAS unsigned char* bufp = lds + (c % 3) * HG_BUF;
#pragma unroll
            for (int j = 0; j < 8; ++j) *(LAS u32x4*)(bufp + (j >> 1) * 8192 + ((j & 1) * 256 + lw * 64 + lane) * 16) = R[j];
            if (lw == 0) *(LAS u32x4*)(bufp + 32768 + lane * 16) = R[8];
        };
        gl(R0, 0); gl(R1, 1);
        lw_(R0, 0); gl(R0, 2);
        HG_BAR();
        for (int c = 0; c < 64; c += 2) {
            lw_(R1, c + 1); gl(R1, c + 3);
            HG_BAR();
            if (c + 2 < 64) lw_(R0, c + 2);
            gl(R0, c + 4);
            HG_BAR();
        }
    } else {
        const int vb = wave;
        f32x16 S[4]; for (int kb = 0; kb < 4; ++kb) S[kb] = zero16();
        f32x16 Oprev = zero16(); u32x2 ogp[4] = {};
        float gn[16];
#pragma unroll
        for (int i = 0; i < 16; ++i) gn[i] = a.in[I_HGN][h * HD + 32 * vb + crow(i, hh)];
        LAS float* SSQ = (LAS float*)(lds + HG_SSQ);
        const bf16* OGA = (const bf16*)(a.ws + WS_OGA); bf16* CAT = (bf16*)(a.ws + WS_CAT);
        auto finish = [&](int cp) {
            const LAS float* sq = SSQ + (cp & 1) * 128;
            const float ss = (sq[r] + sq[32 + r]) + (sq[64 + r] + sq[96 + r]);
            const float rs = rsqrtf(ss * (1.f / HD) + EPS);
            bf16* orow = CAT + (size_t)(b * TP + cp * 32 + r) * D + h * HD + 32 * vb + 4 * hh;
#pragma unroll
            for (int c4 = 0; c4 < 4; ++c4) {
                const u32x2 g = ogp[c4];
                u32x2 w; w.x = pk2(Oprev[4 * c4] * rs * gn[4 * c4] * bflo(g.x), Oprev[4 * c4 + 1] * rs * gn[4 * c4 + 1] * bfhi(g.x));
                w.y = pk2(Oprev[4 * c4 + 2] * rs * gn[4 * c4 + 2] * bflo(g.y), Oprev[4 * c4 + 3] * rs * gn[4 * c4 + 3] * bfhi(g.y));
                *(u32x2*)(orow + 8 * c4) = w;
            }
        };
        HG_BAR();
        for (int c = 0; c < 64; ++c) {
            const LAS unsigned char* bufp = lds + (c % 3) * HG_BUF;
            const LAS bf16x8* QF = (const LAS bf16x8*)bufp + lane; const LAS bf16x8* KF = (const LAS bf16x8*)(bufp + 8192) + lane;
            const LAS bf16x8* TF = (const LAS bf16x8*)(bufp + 16384) + lane; const LAS bf16x8* VF = (const LAS bf16x8*)(bufp + 24576) + lane;
            const LAS float* dvec = (const LAS float*)(bufp + 32768);
            if (c > 0) finish(c - 1);
            { const bf16* ogr = OGA + (size_t)(b * TP + c * 32 + r) * TOK + h * HD + 32 * vb + 4 * hh;
#pragma unroll
              for (int c4 = 0; c4 < 4; ++c4) ogp[c4] = *(const u32x2*)(ogr + 8 * c4); }
            f32x16 X = zero16();
#pragma unroll
            for (int f = 0; f < 8; ++f) X = MFMA32(KF[f * 64], QF[f * 64], X);
#pragma unroll
            for (int i = 0; i < 16; ++i) X[i] = crow(i, hh) <= r ? X[i] : 0.f;
            const bf16x8 v0 = VF[(0 * 4 + vb) * 64], v1 = VF[(1 * 4 + vb) * 64];
            f32x16 O = zero16();
            O = MFMA32(v0, packp(X, 0), O); O = MFMA32(v1, packp(X, 1), O);
#pragma unroll
            for (int kb = 0; kb < 4; ++kb) {
                f32x16 T;
#pragma unroll
                for (int c4 = 0; c4 < 4; ++c4) { const f32x4 e1 = *(const LAS f32x4*)(dvec + 128 + 32 * kb + 8 * c4 + 4 * hh);
#pragma unroll
                    for (int e = 0; e < 4; ++e) T[4 * c4 + e] = S[kb][4 * c4 + e] * e1[e]; }
                O = MFMA32(packp(T, 0), QF[(kb * 2 + 0) * 64], O); O = MFMA32(packp(T, 1), QF[(kb * 2 + 1) * 64], O);
            }
            { float q = 0.f;
#pragma unroll
              for (int i = 0; i < 16; ++i) q += O[i] * O[i];
              q += __shfl_xor(q, 32);
              if (hh == 0) SSQ[(c & 1) * 128 + vb * 32 + r] = q; }
            Oprev = O;
#pragma unroll
            for (int kb = 0; kb < 4; ++kb) {
                f32x16 U = zero16();
                U = MFMA32(TF[(0 * 4 + kb) * 64], v0, U); U = MFMA32(TF[(1 * 4 + kb) * 64], v1, U);
#pragma unroll
                for (int c4 = 0; c4 < 4; ++c4) { const f32x4 dd = *(const LAS f32x4*)(dvec + 32 * kb + 8 * c4 + 4 * hh);
#pragma unroll
                    for (int e = 0; e < 4; ++e) S[kb][4 * c4 + e] = S[kb][4 * c4 + e] * dd[e] + U[4 * c4 + e]; }
            }
            HG_BAR();
        }
        finish(63);
        float* so = a.out + O_HP + (size_t)bh * HD * HD + 32 * vb + r;
#pragma unroll
        for (int kb = 0; kb < 4; ++kb)
#pragma unroll
            for (int i = 0; i < 16; ++i) so[(size_t)(32 * kb + crow(i, hh)) * HD] = S[kb][i];
    }
    __syncthreads();
}

template <bool FIRST, bool LAST>
DI void normpass(ArgsRef a, const float* gain, int gw, int ngw, int lane) {
    const bf16* OB = (const bf16*)(a.ws + WS_OB); bf16* H = (bf16*)(a.ws + WS_H); bf16* XN = (bf16*)(a.ws + WS_XN);
    f32x4 g4[8];
#pragma unroll
    for (int j = 0; j < 8; ++j) g4[j] = ((const f32x4*)gain)[lane + 64 * j];
    u32x2 ow[8], own[8]; f32x4 hf[8], hfn[8]; u32x2 hw[8], hwn[8];
    auto ldrow = [&](int m, u32x2 (&o_)[8], f32x4 (&hf_)[8], u32x2 (&hw_)[8]) {
        const u32x2* orow = (const u32x2*)(OB + (size_t)m * D) + lane;
#pragma unroll
        for (int j = 0; j < 8; ++j) o_[j] = orow[64 * j];
        if (FIRST) { const float* hrow = m < MPR ? a.in[I_XP] + (size_t)m * D : a.in[I_XS] + (size_t)(m - MPR) * D;
#pragma unroll
            for (int j = 0; j < 8; ++j) hf_[j] = ((const f32x4*)hrow)[lane + 64 * j]; }
        else { const u32x2* hrow = (const u32x2*)(H + (size_t)m * D) + lane;
#pragma unroll
            for (int j = 0; j < 8; ++j) hw_[j] = hrow[64 * j]; }
    };
    if (gw < MR) ldrow(gw, ow, hf, hw);
    for (int m = gw; m < MR; m += ngw) {
        if (m + ngw < MR) ldrow(m + ngw, own, hfn, hwn);
        f32x4 o[8], hv[8]; float ss = 0.f;
#pragma unroll
        for (int j = 0; j < 8; ++j) { hv[j] = FIRST ? hf[j] : (f32x4){bflo(hw[j].x), bfhi(hw[j].x), bflo(hw[j].y), bfhi(hw[j].y)};
            o[j] = (f32x4){bflo(ow[j].x), bfhi(ow[j].x), bflo(ow[j].y), bfhi(ow[j].y)};
            ss += (o[j][0] * o[j][0] + o[j][1] * o[j][1]) + (o[j][2] * o[j][2] + o[j][3] * o[j][3]); }
        const float rs = rsqrtf(wave_sum(ss) * (1.f / D) + EPS);
        float s2 = 0.f;
#pragma unroll
        for (int j = 0; j < 8; ++j) { hv[j] = hv[j] + o[j] * rs * g4[j]; s2 += (hv[j][0] * hv[j][0] + hv[j][1] * hv[j][1]) + (hv[j][2] * hv[j][2] + hv[j][3] * hv[j][3]); }
        if (LAST) {
            float* y = m < MPR ? a.out + O_YP + (size_t)m * D : a.out + O_YS + (size_t)(m - MPR) * D;
#pragma unroll
            for (int j = 0; j < 8; ++j) ((f32x4*)y)[lane + 64 * j] = hv[j];
        } else {
            const float r2 = rsqrtf(wave_sum(s2) * (1.f / D) + EPS);
            u32x2* xo = (u32x2*)(XN + (size_t)m * D) + lane;
#pragma unroll
            for (int j = 0; j < 8; ++j) { u32x2 hw; hw.x = pk2(hv[j][0], hv[j][1]); hw.y = pk2(hv[j][2], hv[j][3]); ((u32x2*)(H + (size_t)m * D))[lane + 64 * j] = hw;
                u32x2 w; w.x = pk2(hv[j][0] * r2, hv[j][1] * r2); w.y = pk2(hv[j][2] * r2, hv[j][3] * r2); xo[64 * j] = w; }
        }
#pragma unroll
        for (int j = 0; j < 8; ++j) { ow[j] = own[j]; if (FIRST) hf[j] = hfn[j]; else hw[j] = hwn[j]; }
    }
}

DI f32x4 cvlo(u32x4 w) { return (f32x4){bflo(w.x), bfhi(w.x), bflo(w.y), bfhi(w.y)}; }
DI f32x4 cvhi(u32x4 w) { return (f32x4){bflo(w.z), bfhi(w.z), bflo(w.w), bfhi(w.w)}; }
DI void ffn_fixup(ArgsRef a, int layer, int gtid, int nthr) {
    const float* FIX = (const float*)(a.ws + WS_FIX); const float* HALO = (const float*)(a.ws + WS_HALO); bf16* HID = (bf16*)(a.ws + WS_HID);
    const float* wc = a.in[I_WCONV] + (size_t)layer * 3 * FF; const float* bc = a.in[I_BCONV] + (size_t)layer * FF;
    constexpr int C8 = FF / 8;
    for (int it = gtid; it < 512 * C8; it += nthr) {
        const int ri = it / C8, c8 = (it - ri * C8) * 8, blk = ri >> 1, i = ri & 1, row = blk * 64 + i, t = row & (TP - 1);
        const float* fp = FIX + ((size_t)ri * 2) * FF + c8;
        f32x4 cl = *(const f32x4*)(bc + c8), ch = *(const f32x4*)(bc + c8 + 4);
        cl += *(const f32x4*)(wc + 2 * FF + c8) * *(const f32x4*)fp; ch += *(const f32x4*)(wc + 2 * FF + c8 + 4) * *(const f32x4*)(fp + 4);
        if (t >= 1) { const float* p1 = i == 0 ? HALO + ((size_t)((blk - 1) * 2 + 1)) * FF + c8 : FIX + ((size_t)(blk * 2) * 2) * FF + c8;
            cl += *(const f32x4*)(wc + FF + c8) * *(const f32x4*)p1; ch += *(const f32x4*)(wc + FF + c8 + 4) * *(const f32x4*)(p1 + 4); }
        if (t >= 2) { const float* p0 = HALO + ((size_t)((blk - 1) * 2 + i)) * FF + c8;
            cl += *(const f32x4*)(wc + c8) * *(const f32x4*)p0; ch += *(const f32x4*)(wc + c8 + 4) * *(const f32x4*)(p0 + 4); }
        const f32x4 gl = *(const f32x4*)(fp + FF), gh = *(const f32x4*)(fp + FF + 4);
#pragma unroll
        for (int e = 0; e < 4; ++e) { cl[e] = gelu_t(cl[e]) * gl[e]; ch[e] = gelu_t(ch[e]) * gh[e]; }
        *(u32x4*)(HID + (size_t)row * FF + c8) = pack8(cl, ch);
    }
}
DI void gating_pass(ArgsRef a, int layer, int gtid, int nthr) {
    const bf16* AB = (const bf16*)(a.ws + WS_AB); bf16* HID = (bf16*)(a.ws + WS_HID);
    const float* wc = a.in[I_WCONV] + (size_t)layer * 3 * FF; const float* bc = a.in[I_BCONV] + (size_t)layer * FF;
    constexpr int C8 = FF / 8;
    for (int it = gtid; it < MSR * C8; it += nthr) {
        const int row = MPR + it / C8, c8 = (it % C8) * 8;
        const bool prm = row < MPR; const int t = prm ? (row & (TP - 1)) : ((row - MPR) & 3);
        const bf16* ar = AB + (size_t)row * FF2 + c8;
        const u32x4 wa = *(const u32x4*)ar, wb = *(const u32x4*)(ar + FF);
        f32x4 e2l = cvlo(wa), e2h = cvhi(wa), e1l, e1h, e0l, e0h;
        const float* cb = prm ? nullptr : a.in[I_CCONV] + ((size_t)(layer * BS + ((row - MPR) >> 2)) * 2) * FF + c8;
        if (t >= 1) { const u32x4 w = *(const u32x4*)(ar - FF2); e1l = cvlo(w); e1h = cvhi(w); }
        else if (prm) { e1l = (f32x4){0.f, 0.f, 0.f, 0.f}; e1h = e1l; }
        else { e1l = *(const f32x4*)(cb + FF); e1h = *(const f32x4*)(cb + FF + 4); }
        if (t >= 2) { const u32x4 w = *(const u32x4*)(ar - 2 * FF2); e0l = cvlo(w); e0h = cvhi(w); }
        else if (prm) { e0l = (f32x4){0.f, 0.f, 0.f, 0.f}; e0h = e0l; }
        else { e0l = *(const f32x4*)(cb + (size_t)t * FF); e0h = *(const f32x4*)(cb + (size_t)t * FF + 4); }
        const f32x4 w0l = *(const f32x4*)(wc + c8), w0h = *(const f32x4*)(wc + c8 + 4), w1l = *(const f32x4*)(wc + FF + c8), w1h = *(const f32x4*)(wc + FF + c8 + 4);
        const f32x4 w2l = *(const f32x4*)(wc + 2 * FF + c8), w2h = *(const f32x4*)(wc + 2 * FF + c8 + 4), bl = *(const f32x4*)(bc + c8), bh = *(const f32x4*)(bc + c8 + 4);
        f32x4 cl = bl + w0l * e0l + w1l * e1l + w2l * e2l, ch = bh + w0h * e0h + w1h * e1h + w2h * e2h;
        const f32x4 gbl = cvlo(wb), gbh = cvhi(wb);
#pragma unroll
        for (int e = 0; e < 4; ++e) { cl[e] = gelu_t(cl[e]) * gbl[e]; ch[e] = gelu_t(ch[e]) * gbh[e]; }
        *(u32x4*)(HID + (size_t)row * FF + c8) = pack8(cl, ch);
    }
}

DI float alibi_slope2(int head) { return exp2f(-8.f * (float)(head + 1) / 12.f) * LOG2E; }

DI void nsa_cmp_wg(ArgsRef a, LAS unsigned char* lds, int p, int tid) {
    const int wave = __builtin_amdgcn_readfirstlane(tid >> 6), lane = tid & 63;
    const int r = lane & 31, h = lane >> 5;
    const int bg = p >> 3, jq = (p & 7) * 4 + (wave & 3), tau = wave < 4 ? 63 - jq : jq, ntile = (tau >> 4) + 1, b = bg >> 1, g = bg & 1, t0 = tau * 32, row = b * TP + t0 + r, qpos = t0 + r;
    const bf16* QB = (const bf16*)(a.ws + WS_QB); const float* GATES = (const float*)(a.ws + WS_GATES);
    bf16* OCMP = (bf16*)(a.ws + WS_OCMP);
    __syncthreads();
    { const u32x4* kc = (const u32x4*)((const bf16*)(a.ws + WS_KC) + (size_t)bg * 16384); const u32x4* vc = (const u32x4*)((const bf16*)(a.ws + WS_VCT) + (size_t)bg * 16384);
      u32x4 tk[4], tv[4];
#pragma unroll
      for (int j = 0; j < 4; ++j) { tk[j] = kc[j * NTHR + tid]; tv[j] = vc[j * NTHR + tid]; }
#pragma unroll
      for (int j = 0; j < 4; ++j) { ((LAS u32x4*)lds)[j * NTHR + tid] = tk[j]; ((LAS u32x4*)(lds + 32768))[j * NTHR + tid] = tv[j]; } }
    __syncthreads();
    const LAS bf16x8* KL = (const LAS bf16x8*)lds + lane; const LAS bf16x8* VL = (const LAS bf16x8*)(lds + 32768) + lane;
    LAS float* CL = (LAS float*)(lds + 65536 + wave * 8192);
    for (int u = ntile * 512 + lane; u < 2048; u += 64) CL[u] = 0.f;
    for (int hr = 0; hr < HPG; ++hr) {
        const int head = g * HPG + hr; const float slope2 = alibi_slope2(head);
        bf16x8 qf[8]; load_qf(qf, QB + (size_t)row * TOK + head * HD, h);
        float m = -1e30f, l = 0.f;
#pragma unroll 1
        for (int kt = 0; kt < ntile; ++kt) {
            f32x16 s = zero16();
#pragma unroll
            for (int ks = 0; ks < 8; ++ks) s = MFMA32(KL[(kt * 8 + ks) * 64], qf[ks], s);
            float mt = -1e30f;
#pragma unroll
            for (int i = 0; i < 16; ++i) {
                const int n = 32 * kt + crow(i, h), kp = 16 * n + 31;
                float v = s[i] * SCALE2 + slope2 * (float)(kp - t0);
                v = (n < NCP && kp <= qpos) ? v : -1e30f;
                s[i] = v; mt = fmaxf(mt, v);
            }
            mt = fmaxf(mt, __shfl_xor(mt, 32));
            const float mn = fmaxf(m, mt); float ls = 0.f;
#pragma unroll
            for (int i = 0; i < 16; ++i) ls += s[i] > -1e29f ? __builtin_amdgcn_exp2f(s[i] - mn) : 0.f;
            l = l * __builtin_amdgcn_exp2f(m - mn) + ls; m = mn;
        }
        l += __shfl_xor(l, 32);
        const float inv = l > 0.f ? 1.f / l : 0.f;
        f32x16 o[4];
#pragma unroll
        for (int db = 0; db < 4; ++db) o[db] = zero16();
#pragma unroll 1
        for (int kt = 0; kt < ntile; ++kt) {
            f32x16 s = zero16();
#pragma unroll
            for (int ks = 0; ks < 8; ++ks) s = MFMA32(KL[(kt * 8 + ks) * 64], qf[ks], s);
#pragma unroll
            for (int i = 0; i < 16; ++i) {
                const int n = 32 * kt + crow(i, h), kp = 16 * n + 31;
                const float v = s[i] * SCALE2 + slope2 * (float)(kp - t0);
                s[i] = (n < NCP && kp <= qpos) ? __builtin_amdgcn_exp2f(v - m) * inv : 0.f;
            }
#pragma unroll
            for (int c = 0; c < 4; ++c) {
                const float co = (s[4 * c] + s[4 * c + 1]) + (s[4 * c + 2] + s[4 * c + 3]), la = s[4 * c + 3];
                LAS float* cp = CL + ((kt * 4 + c) * 2) * 64 + lane;
                if (hr == 0) { cp[0] = co; cp[64] = la; } else { cp[0] += co; cp[64] += la; }
            }
#pragma unroll
            for (int st = 0; st < 2; ++st) { const bf16x8 pf = packp(s, st);
#pragma unroll
                for (int db = 0; db < 4; ++db) o[db] = MFMA32(VL[(kt * 8 + st * 4 + db) * 64], pf, o[db]); }
        }
        const float g0 = GATES[(size_t)row * 40 + head * 3 + 0];
#pragma unroll
        for (int db = 0; db < 4; ++db) o[db] *= g0;
        store_ot(OCMP + (size_t)row * TOK + head * HD, o, h);
    }
    LDS_WAIT(); asm volatile("" ::: "memory");
    float core[16], last[16];
#pragma unroll
    for (int idx = 0; idx < 16; ++idx) {
        core[idx] = CL[(idx * 2) * 64 + lane]; last[idx] = CL[(idx * 2 + 1) * 64 + lane];
    }
    LDS_WAIT(); asm volatile("" ::: "memory");
    const int cur = qpos >> 6;
    float sc[16], osc[16];
#pragma unroll
    for (int idx = 0; idx < 16; ++idx) {
        const float x = __shfl_xor(last[idx], 32);
        float xp = 0.f; if (idx > 0) xp = __shfl_xor(last[idx > 0 ? idx - 1 : 0], 32);
        const float prev = h ? x : xp;
        const int j = 2 * idx + h;
        const bool valid = j <= cur, forced = (j == 0) || (j == cur) || (j == cur - 1);
        sc[idx] = valid ? (core[idx] + prev) + (forced ? 1e4f : 0.f) : -1e30f;
    }
#pragma unroll
    for (int idx = 0; idx < 16; ++idx) osc[idx] = __shfl_xor(sc[idx], 32);
    unsigned mask = 0u;
#pragma unroll
    for (int idx = 0; idx < 16; ++idx) {
        const int j = 2 * idx + h; const float me = sc[idx]; int rank = 0;
#pragma unroll
        for (int k = 0; k < 16; ++k) {
            const int j1 = 2 * k + h, j2 = 2 * k + 1 - h;
            rank += (sc[k] > me || (sc[k] == me && j1 < j)) ? 1 : 0;
            rank += (osc[k] > me || (osc[k] == me && j2 < j)) ? 1 : 0;
        }
        if (rank < 16 && j <= cur) mask |= 1u << j;
    }
    mask |= __shfl_xor(mask, 32);
    if (h == 0) ((unsigned*)(a.ws + WS_SELM))[(size_t)row * 2 + g] = mask;
}

DI void nsa_selwin_item(ArgsRef a, int it, LAS float* stash, int lane) {
    const int r = lane & 31, h = lane >> 5;
    const int hr = it % HPG, bg = (it / HPG) & 15, tau = 63 - it / (HPG * 16);
    const int b = bg >> 1, g = bg & 1, head = g * HPG + hr, t0 = tau * 32, row = b * TP + t0 + r, qpos = t0 + r;
    const float slope2 = alibi_slope2(head);
    const bf16* QB = (const bf16*)(a.ws + WS_QB); const float* GATES = (const float*)(a.ws + WS_GATES);
    const size_t kvo = (size_t)bg * TP * HD;
    const bf16* KSEL = (const bf16*)(a.ws + WS_KSEL) + kvo; const bf16* VSELT = (const bf16*)(a.ws + WS_VSELT) + kvo;
    const bf16* KWIN = (const bf16*)(a.ws + WS_KWIN) + kvo; const bf16* VWINT = (const bf16*)(a.ws + WS_VWINT) + kvo;
    LAS bf16x8* ql = (LAS bf16x8*)(stash + 2048);
    { bf16x8 qf[8]; load_qf(qf, QB + (size_t)row * TOK + head * HD, h);
#pragma unroll
      for (int ks = 0; ks < 8; ++ks) ql[ks * 64 + lane] = qf[ks]; }
    LDS_WAIT(); asm volatile("" ::: "memory");
    LAS unsigned* stu = (LAS unsigned*)stash;
    const unsigned selm = ((const unsigned*)(a.ws + WS_SELM))[(size_t)row * 2 + g];
    unsigned um = selm;
#pragma unroll
    for (int o = 1; o < 64; o <<= 1) um |= __shfl_xor(um, o);
    um = __builtin_amdgcn_readfirstlane(um);
    unsigned long long x = um;
    x = (x | (x << 16)) & 0x0000FFFF0000FFFFull; x = (x | (x << 8)) & 0x00FF00FF00FF00FFull; x = (x | (x << 4)) & 0x0F0F0F0F0F0F0F0Full;
    x = (x | (x << 2)) & 0x3333333333333333ull; x = (x | (x << 1)) & 0x5555555555555555ull;
    const unsigned long long causal = tau >= 63 ? ~0ull : ((1ull << (tau + 1)) - 1ull);
    const unsigned long long tsel = (x | (x << 1)) & causal;
    const int wlo = tau > 16 ? tau - 16 : 0;
    const unsigned long long twin = causal & ~((1ull << wlo) - 1ull);
    {
        AttnAcc A; attn_init(A);
        attn_run(A, ql, KSEL, VSELT, tsel, slope2, t0, [&](int kt, int kvl) { return ((selm >> (kt >> 1)) & 1u) && (kt * 32 + kvl <= qpos); },
                 [&](int kt) { return kt < tau && __all((selm >> (kt >> 1)) & 1u); }, lane);
        const float g1 = GATES[(size_t)row * 40 + head * 3 + 1] * attn_inv(A);
#pragma unroll
        for (int db = 0; db < 4; ++db)
#pragma unroll
            for (int i = 0; i < 16; i += 2) stu[(db * 8 + (i >> 1)) * 64 + lane] = pk2(A.o[db][i] * g1, A.o[db][i + 1] * g1);
    }
    f32x16 out[4];
    {
        AttnAcc A; attn_init(A);
        attn_run(A, ql, KWIN, VWINT, twin, slope2, t0, [&](int kt, int kvl) { const int dist = qpos - (kt * 32 + kvl); return dist >= 0 && dist < 512; },
                 [&](int kt) { return kt < tau && kt > tau - 16; }, lane);
        const float g2 = GATES[(size_t)row * 40 + head * 3 + 2] * attn_inv(A);
        LDS_WAIT();
#pragma unroll
        for (int db = 0; db < 4; ++db)
#pragma unroll
            for (int i = 0; i < 16; i += 2) { const unsigned w = stu[(db * 8 + (i >> 1)) * 64 + lane]; out[db][i] = bflo(w) + A.o[db][i] * g2; out[db][i + 1] = bfhi(w) + A.o[db][i + 1] * g2; }
    }
    const bf16* oc = (const bf16*)(a.ws + WS_OCMP) + (size_t)row * TOK + head * HD;
    bf16* orow = (bf16*)(a.ws + WS_CAT) + (size_t)row * D + head * HD;
#pragma unroll
    for (int db = 0; db < 4; ++db)
#pragma unroll
        for (int c = 0; c < 4; ++c) {
            const int d = 32 * db + 8 * c + 4 * h;
            const u32x2 w = *(const u32x2*)(oc + d);
            u32x2 o; o.x = pk2(out[db][4 * c] + bflo(w.x), out[db][4 * c + 1] + bfhi(w.x)); o.y = pk2(out[db][4 * c + 2] + bflo(w.y), out[db][4 * c + 3] + bfhi(w.y));
            *(u32x2*)(orow + d) = o;
        }
}

constexpr int SCLD = 1040;
template <int NQ, class KP, class VP, class BF>
DI void wg_attend(LAS float* Qs, LAS float* SC, LAS float* RED, int nkeys, const KP& kptr, const VP& vptr, const BF& bias, int tid) {
    const int wave = tid >> 6, lane = tid & 63;
    {
        const int ks = tid >> 3, sub = tid & 7;
        for (int n0 = 0; n0 < nkeys; n0 += 128) {
            f32x4 k4[2][4]; int nn[2]; bool act[2];
#pragma unroll
            for (int u = 0; u < 2; ++u) { nn[u] = n0 + 64 * u + ks; act[u] = nn[u] < nkeys; const float* kp = kptr(act[u] ? nn[u] : nkeys - 1);
#pragma unroll
                for (int i = 0; i < 4; ++i) k4[u][i] = *(const f32x4*)(kp + 4 * sub + 32 * i); }
#pragma unroll
            for (int u = 0; u < 2; ++u) {
                float part[NQ];
#pragma unroll
                for (int j = 0; j < NQ; ++j) part[j] = 0.f;
#pragma unroll
                for (int i = 0; i < 4; ++i)
#pragma unroll
                    for (int j = 0; j < NQ; ++j) { const f32x4 q4 = *(const LAS f32x4*)(Qs + j * 128 + 4 * sub + 32 * i); part[j] += (k4[u][i][0] * q4[0] + k4[u][i][1] * q4[1]) + (k4[u][i][2] * q4[2] + k4[u][i][3] * q4[3]); }
#pragma unroll
                for (int j = 0; j < NQ; ++j) { float p = part[j]; p += __shfl_xor(p, 1); p += __shfl_xor(p, 2); p += __shfl_xor(p, 4);
                    if (sub == 0 && act[u]) { const float bb = bias(j, nn[u]); SC[j * SCLD + nn[u]] = bb > -1e29f ? p * SCALE2 + bb : -1e30f; } }
            }
        }
    }
    __syncthreads();
    for (int j = wave; j < NQ; j += NWAVES) {
        float m = -1e30f;
        for (int n = lane; n < nkeys; n += 64) m = fmaxf(m, SC[j * SCLD + n]);
        m = wave_max(m);
        float l = 0.f;
        for (int n = lane; n < nkeys; n += 64) { const float s = SC[j * SCLD + n]; const float p = s > -1e29f ? __builtin_amdgcn_exp2f(s - m) : 0.f; SC[j * SCLD + n] = p; l += p; }
        l = wave_sum(l);
        const float inv = l > 0.f ? 1.f / l : 0.f;
        for (int n = lane; n < nkeys; n += 64) SC[j * SCLD + n] *= inv;
    }
    __syncthreads();
    {
        const int part = tid >> 5, dq = tid & 31;
        f32x4 acc[NQ];
#pragma unroll
        for (int j = 0; j < NQ; ++j) acc[j] = (f32x4){0.f, 0.f, 0.f, 0.f};
        for (int n0 = part; n0 < nkeys; n0 += 128) {
            f32x4 v4[8];
#pragma unroll
            for (int u = 0; u < 8; ++u) { const int n = n0 + 16 * u; v4[u] = *(const f32x4*)(vptr(n < nkeys ? n : nkeys - 1) + 4 * dq); }
#pragma unroll
            for (int u = 0; u < 8; ++u) { const int n = n0 + 16 * u;
                if (n < nkeys) {
#pragma unroll
                    for (int j = 0; j < NQ; ++j) acc[j] += SC[j * SCLD + n] * v4[u]; } }
        }
#pragma unroll
        for (int j = 0; j < NQ; ++j) *(LAS f32x4*)(RED + ((part * NQ + j) * 128 + 4 * dq)) = acc[j];
    }
    __syncthreads();
    for (int o = tid; o < NQ * 128; o += NTHR) {
        float s = 0.f;
#pragma unroll
        for (int p = 1; p < 16; ++p) s += RED[p * NQ * 128 + o];
        RED[o] += s;
    }
    __syncthreads();
}
constexpr int SN_Q = 0, SN_SC = 768, SN_RED = SN_SC + 6 * SCLD, SN_IMP = SN_RED + 16 * 6 * 128, SN_PS = SN_IMP + 520, SN_IDX = SN_PS + 136;
static_assert((SN_IDX + 64) * 4 <= RING_BYTES, "sample NSA LDS map");

DI void sn_load_q(ArgsRef a, LAS float* Qs, int srow, int g, int tid) {
    const bf16* QB = (const bf16*)(a.ws + WS_QB) + (size_t)(MPR + srow) * TOK + g * HPG * HD;
    for (int o = tid; o < HPG * HD; o += NTHR) Qs[o] = bf2f(QB[o]);
}
DI void sn_cmp_item(ArgsRef a, LAS unsigned char* lds, int it, int tid) {
    const int b = it >> 3, g = (it >> 2) & 1, t = it & 3, srow = b * 4 + t, qpos = PAST + t;
    LAS float* L = (LAS float*)lds; LAS float* Qs = L + SN_Q; LAS float* SC = L + SN_SC; LAS float* RED = L + SN_RED; LAS float* IMP = L + SN_IMP; LAS float* PS = L + SN_PS;
    __syncthreads();
    sn_load_q(a, Qs, srow, g, tid);
    __syncthreads();
    const float* kc = (const float*)(a.ws + WS_KCS) + (size_t)(b * 2 + g) * 512 * 128; const float* vc = (const float*)(a.ws + WS_VCS) + (size_t)(b * 2 + g) * 512 * 128;
    wg_attend<HPG>(Qs, SC, RED, NCS, [&](int n) { return kc + (size_t)n * 128; }, [&](int n) { return vc + (size_t)n * 128; },
                   [&](int j, int n) { const int kp = 16 * n + 31; return kp <= qpos ? -alibi_slope2(g * HPG + j) * (float)(qpos - kp) : -1e30f; }, tid);
    const float* GATES = (const float*)(a.ws + WS_GATES) + (size_t)(MPR + srow) * 40;
    float* SOC = (float*)(a.ws + WS_SOC) + (size_t)srow * TOK + g * HPG * HD;
    for (int o = tid; o < HPG * HD; o += NTHR) SOC[o] = RED[o] * GATES[(g * HPG + (o >> 7)) * 3 + 0];
    for (int n = tid; n < 520; n += NTHR) { float s = 0.f; if (n < NCS) { for (int j = 0; j < HPG; ++j) s += SC[j * SCLD + n]; } IMP[n] = s; }
    __syncthreads();
    if (tid < NSS) { const int j = tid; float s = 0.f;
        for (int n = 4 * j - 1; n <= 4 * j + 3; ++n) if (n >= 0 && n < NCS) s += IMP[n];
        const bool forced = (j == 0) || (j == NSS - 1) || (j == NSS - 2);
        PS[j] = s + (forced ? 1e4f : 0.f); }
    __syncthreads();
    if (tid < NSS) { const float me = PS[tid]; int rank = 0;
        for (int k = 0; k < NSS; ++k) { const float o = PS[k]; rank += (o > me || (o == me && k < tid)) ? 1 : 0; }
        if (rank < 16) ((int*)(a.ws + WS_SIDX))[(size_t)(srow * 2 + g) * 16 + rank] = tid; }
}
DI void sn_selwin_item(ArgsRef a, LAS unsigned char* lds, int it, int tid) {
    const int b = it >> 3, g = (it >> 2) & 1, t = it & 3, srow = b * 4 + t, qpos = PAST + t;
    LAS float* L = (LAS float*)lds; LAS float* Qs = L + SN_Q; LAS float* SC = L + SN_SC; LAS float* RED = L + SN_RED; LAS int* IDX = (LAS int*)(L + SN_IDX);
    __syncthreads();
    sn_load_q(a, Qs, srow, g, tid);
    if (tid < 16) { const int blk = ((const int*)(a.ws + WS_SIDX))[(size_t)(srow * 2 + g) * 16 + tid]; IDX[tid] = blk;
        IDX[16 + tid] = blk < 128 ? ((const int*)a.in[I_PT])[b * NPAGE + (blk >> 1)] : 0; }
    __syncthreads();
    const float* ckv = a.in[I_CKV]; const float* nkv = a.out + O_KVS + (size_t)(b * 4) * 1024;
    auto selrow = [&](int n, int kind) -> const float* {
        const int sb = n >> 6, s = n & 63, blk = IDX[sb];
        if (blk < 128) return ckv + ((size_t)IDX[16 + sb] * PAGE + (blk & 1) * 64 + s) * 1024 + kind * 256 + g * 128;
        return nkv + (size_t)(s < 4 ? s : 3) * 1024 + kind * 256 + g * 128;
    };
    wg_attend<HPG>(Qs, SC, RED, 1024, [&](int n) { return selrow(n, 2); }, [&](int n) { return selrow(n, 3); },
                   [&](int j, int n) { const int kp = IDX[n >> 6] * 64 + (n & 63); return kp <= qpos ? -alibi_slope2(g * HPG + j) * (float)(qpos - kp) : -1e30f; }, tid);
    const float* GATES = (const float*)(a.ws + WS_GATES) + (size_t)(MPR + srow) * 40;
    float acc[2];
    { const float* SOC = (const float*)(a.ws + WS_SOC) + (size_t)srow * TOK + g * HPG * HD;
      for (int q = 0; q < 2; ++q) { const int o = tid + q * NTHR; acc[q] = o < HPG * HD ? SOC[o] + RED[o] * GATES[(g * HPG + (o >> 7)) * 3 + 1] : 0.f; } }
    __syncthreads();
    const float* cw = a.in[I_CWIN] + (size_t)b * 512 * 512; const float* nw = a.out + O_WS + (size_t)(b * 4) * 512;
    auto winrow = [&](int n, int kind) -> const float* { return n < 512 ? cw + (size_t)n * 512 + kind * 256 + g * 128 : nw + (size_t)(n - 512) * 512 + kind * 256 + g * 128; };
    wg_attend<HPG>(Qs, SC, RED, 516, [&](int n) { return winrow(n, 0); }, [&](int n) { return winrow(n, 1); },
                   [&](int j, int n) { const int dist = qpos - (PAST - 512 + n); return (dist >= 0 && dist < 512) ? -alibi_slope2(g * HPG + j) * (float)dist : -1e30f; }, tid);
    bf16* CAT = (bf16*)(a.ws + WS_CAT) + (size_t)(MPR + srow) * D + g * HPG * HD;
    for (int q = 0; q < 2; ++q) { const int o = tid + q * NTHR; if (o < HPG * HD) CAT[o] = f2bf(acc[q] + RED[o] * GATES[(g * HPG + (o >> 7)) * 3 + 2]); }
}

constexpr int SM_O = 0, SM_Q = RING_BYTES + 2048, SM_ML = SM_Q + 8192, SM_LIST = SM_ML + 2048, SM_MEMB = SM_LIST + 256, SM_UB = SM_MEMB + 544, SM_PG = SM_UB + 32;
static_assert(SM_PG + 256 <= LDS_BYTES && MISC_OFF + 256 <= RING_BYTES + 2048, "sample NSA (MFMA) LDS map");
DI void sn_selwin_mfma(ArgsRef a, LAS unsigned char* lds, int bg, int tid) {
    const int wave = __builtin_amdgcn_readfirstlane(tid >> 6), lane = tid & 63, r = lane & 31, h = lane >> 5;
    const int b = bg >> 1, g = bg & 1, t = r >> 3, js = r & 7, j = js < HPG ? js : HPG - 1, head = g * HPG + j, srow = b * 4 + t, qpos = PAST + t;
    LAS bf16x8* ql = (LAS bf16x8*)(lds + SM_Q); LAS int* LIST = (LAS int*)(lds + SM_LIST); LAS unsigned* MEMB = (LAS unsigned*)(lds + SM_MEMB); LAS unsigned* UB = (LAS unsigned*)(lds + SM_UB);
    LAS int* PG = (LAS int*)(lds + SM_PG); LAS float* ML = (LAS float*)(lds + SM_ML); LAS float* OB = (LAS float*)(lds + SM_O);
    __syncthreads();
    if (wave == 0) LIST[lane] = ((const int*)(a.ws + WS_SIDX))[(size_t)((b * 4 + (lane >> 4)) * 2 + g) * 16 + (lane & 15)];
    if (wave == 1) PG[lane] = ((const int*)a.in[I_PT])[b * NPAGE + lane];
    if (wave == 2) { bf16x8 qf[8]; load_qf(qf, (const bf16*)(a.ws + WS_QB) + (size_t)(MPR + srow) * TOK + head * HD, h);
#pragma unroll
        for (int ks = 0; ks < 8; ++ks) ql[ks * 64 + lane] = qf[ks]; }
    __syncthreads();
    if (tid < 136) { unsigned m = 0u; for (int e = 0; e < 64; ++e) m |= (LIST[e] == tid) ? (1u << (e >> 4)) : 0u; MEMB[tid] = m; }
    __syncthreads();
    if (tid < 8) { unsigned u = 0u; for (int e = 0; e < 32; ++e) { const int blk = 32 * tid + e; u |= (blk < 136 && MEMB[blk] != 0u) ? (1u << e) : 0u; } UB[tid] = u; }
    __syncthreads();
    const float slope2 = alibi_slope2(head);
    auto run_tile = [&](AttnAcc& A, const float* kb, const float* vb, int stride, int nvalid, int pos0, bool member, int maxdist) {
        asm volatile("" : "+s"(stride), "+s"(nvalid) :: "memory");
        {
            LAS unsigned* vl = (LAS unsigned*)(lds + wave * 16384);
            const float* vbl = vb + (unsigned)(h * stride + 4 * r);
            const int lastpair = (nvalid >> 1) - 1;
#pragma unroll
            for (int i = 0; i < 16; ++i) { const int i2 = i < lastpair ? i : lastpair;
                __builtin_amdgcn_global_load_lds((const unsigned*)(vbl + (size_t)(2 * i2 * stride)), vl + i * 256, 16, 0, 0); }
        }
        f32x16 s = zero16();
        { const int kr = r < nvalid ? r : nvalid - 1; const float* kp = kb + (unsigned)(kr * stride + 8 * h);
#pragma unroll
          for (int hk = 0; hk < 2; ++hk) {
              f32x4 kq[4][2];
#pragma unroll
              for (int ks = 0; ks < 4; ++ks) { kq[ks][0] = *(const f32x4*)(kp + 64 * hk + 16 * ks); kq[ks][1] = *(const f32x4*)(kp + 64 * hk + 16 * ks + 4); }
              bf16x8 kf[4];
#pragma unroll
              for (int ks = 0; ks < 4; ++ks) { u32x4 w; w.x = pk2(kq[ks][0][0], kq[ks][0][1]); w.y = pk2(kq[ks][0][2], kq[ks][0][3]); w.z = pk2(kq[ks][1][0], kq[ks][1][1]); w.w = pk2(kq[ks][1][2], kq[ks][1][3]);
                  kf[ks] = __builtin_bit_cast(bf16x8, w); }
              __builtin_amdgcn_sched_barrier(0);
#pragma unroll
              for (int ks = 0; ks < 4; ++ks) s = MFMA32(kf[ks], ql[(4 * hk + ks) * 64 + lane], s);
          } }
        float mt = -1e30f;
#pragma unroll
        for (int i = 0; i < 16; ++i) { const int key = crow(i, h), dist = qpos - (pos0 + key);
            float v = fmaf(s[i], SCALE2, -slope2 * (float)dist);
            v = (member && dist >= 0 && dist < maxdist && key < nvalid) ? v : -1e30f; s[i] = v; mt = fmaxf(mt, v); }
        mt = fmaxf(mt, __shfl_xor(mt, 32));
        float mn = A.m;
        if (__any(mt > A.m + 8.f)) { mn = fmaxf(A.m, mt); const float alpha = __builtin_amdgcn_exp2f(A.m - mn); A.m = mn; A.l *= alpha;
#pragma unroll
            for (int db = 0; db < 4; ++db) A.o[db] *= alpha; }
        float ls = 0.f;
#pragma unroll
        for (int i = 0; i < 16; ++i) { const float p = s[i] > -1e29f ? __builtin_amdgcn_exp2f(s[i] - mn) : 0.f; s[i] = p; ls += p; }
        A.l += ls;
        asm volatile("s_waitcnt vmcnt(0)" ::: "memory");
        { const LAS float* vr = (const LAS float*)(lds + wave * 16384) + 4 * h * 128 + r;
#pragma unroll
          for (int st = 0; st < 2; ++st) { const bf16x8 pf = packp(s, st);
#pragma unroll
            for (int db = 0; db < 4; ++db) { float x[8];
#pragma unroll
                for (int jj = 0; jj < 8; ++jj) x[jj] = vr[(16 * st + 8 * (jj >> 2) + (jj & 3)) * 128 + 32 * db];
                u32x4 w; w.x = pk2(x[0], x[1]); w.y = pk2(x[2], x[3]); w.z = pk2(x[4], x[5]); w.w = pk2(x[6], x[7]);
                A.o[db] = MFMA32(__builtin_bit_cast(bf16x8, w), pf, A.o[db]); } } }
        asm volatile("s_waitcnt lgkmcnt(0)" ::: "memory");
    };
    auto merge = [&](AttnAcc& A, float (&res)[8]) {
        __syncthreads();
        if (wave >= 4) { LAS float* o = OB + (wave - 4) * 4096 + lane; ML[(wave - 4) * 128 + lane] = A.m; ML[(wave - 4) * 128 + 64 + lane] = A.l;
#pragma unroll
            for (int db = 0; db < 4; ++db)
#pragma unroll
                for (int i = 0; i < 16; ++i) o[(db * 16 + i) * 64] = A.o[db][i]; }
        __syncthreads();
        if (wave < 4) { const LAS float* o = OB + wave * 4096 + lane; const float mb = ML[wave * 128 + lane], lb = ML[wave * 128 + 64 + lane];
            const float M = fmaxf(A.m, mb), sa = __builtin_amdgcn_exp2f(A.m - M), sb = __builtin_amdgcn_exp2f(mb - M);
            A.m = M; A.l = A.l * sa + lb * sb;
#pragma unroll
            for (int db = 0; db < 4; ++db)
#pragma unroll
                for (int i = 0; i < 16; ++i) A.o[db][i] = A.o[db][i] * sa + o[(db * 16 + i) * 64] * sb; }
        __syncthreads();
        if (wave < 4) { LAS float* o = OB + wave * 4096 + lane; ML[wave * 128 + lane] = A.m; ML[wave * 128 + 64 + lane] = A.l;
#pragma unroll
            for (int db = 0; db < 4; ++db)
#pragma unroll
                for (int i = 0; i < 16; ++i) o[(db * 16 + i) * 64] = A.o[db][i]; }
        __syncthreads();
        { float M = -1e30f, sc[4], L = 0.f;
#pragma unroll
          for (int w2 = 0; w2 < 4; ++w2) M = fmaxf(M, ML[w2 * 128 + lane]);
#pragma unroll
          for (int w2 = 0; w2 < 4; ++w2) { sc[w2] = __builtin_amdgcn_exp2f(ML[w2 * 128 + lane] - M); L += ML[w2 * 128 + 64 + lane] * sc[w2]; }
          L += __shfl_xor(L, 32);
          const float inv = L > 0.f ? 1.f / L : 0.f;
          const int base = ((wave >> 1) * 16 + 8 * (wave & 1)) * 64 + lane;
#pragma unroll
          for (int e = 0; e < 8; ++e) { float o = 0.f;
#pragma unroll
              for (int w2 = 0; w2 < 4; ++w2) o += OB[w2 * 4096 + base + e * 64] * sc[w2];
              res[e] = o * inv; } }
        __syncthreads();
    };
    {
        AttnAcc A; attn_init(A);
        const float* ckv = a.in[I_CKV]; const float* nkv = a.out + O_KVS + (size_t)(b * 4) * 1024 + 512 + g * 128;
        int cnt = 0;
        for (int w5 = 0; w5 < 5; ++w5) {
            unsigned bits = __builtin_amdgcn_readfirstlane(UB[w5]);
            while (bits) {
                const int blk = 32 * w5 + __builtin_ctz(bits); bits &= bits - 1u;
                const bool member = (MEMB[blk] >> t) & 1u;
                const int page = __builtin_amdgcn_readfirstlane(PG[blk < 128 ? blk >> 1 : 0]);
                const int nt = blk < 128 ? 2 : 1;
#pragma unroll 1
                for (int hf = 0; hf < nt; ++hf, ++cnt) if ((cnt & 7) == wave) {
                    const float* kb = blk < 128 ? ckv + ((size_t)page * PAGE + (blk & 1) * 64 + hf * 32) * 1024 + 512 + g * 128 : nkv;
                    run_tile(A, kb, kb + 256, 1024, blk < 128 ? 32 : 4, blk * 64 + hf * 32, member, 1 << 30);
                }
            }
        }
        float rsel[8];
        merge(A, rsel);
        if (js < HPG) {
            const float g1 = ((const float*)(a.ws + WS_GATES))[(size_t)(MPR + srow) * 40 + head * 3 + 1];
            float* soc = (float*)(a.ws + WS_SOC) + (size_t)srow * TOK + head * HD + 32 * (wave >> 1) + 16 * (wave & 1) + 4 * h;
#pragma unroll
            for (int q = 0; q < 2; ++q) { f32x4 c = *(const f32x4*)(soc + 8 * q);
#pragma unroll
                for (int e = 0; e < 4; ++e) c[e] += rsel[4 * q + e] * g1;
                *(f32x4*)(soc + 8 * q) = c; }
        }
    }
    {
        float rwin[8];
        AttnAcc A; attn_init(A);
        const float* cw = a.in[I_CWIN] + (size_t)b * 512 * 512 + g * 128; const float* nw = a.out + O_WS + (size_t)(b * 4) * 512 + g * 128;
#pragma unroll 1
        for (int wt = 7 - wave; wt < 17; wt += 8) {
            const float* kb = wt < 16 ? cw + (size_t)(32 * wt) * 512 : nw;
            run_tile(A, kb, kb + 256, 512, wt < 16 ? 32 : 4, PAST - 512 + 32 * wt, true, 512);
        }
        merge(A, rwin);
        if (js < HPG) {
            const float* GATES = (const float*)(a.ws + WS_GATES) + (size_t)(MPR + srow) * 40 + head * 3;
            const float g2 = GATES[2];
            const int d0 = 32 * (wave >> 1) + 16 * (wave & 1) + 4 * h;
            const float* soc = (const float*)(a.ws + WS_SOC) + (size_t)srow * TOK + head * HD + d0;
            bf16* cat = (bf16*)(a.ws + WS_CAT) + (size_t)(MPR + srow) * D + head * HD + d0;
#pragma unroll
            for (int q = 0; q < 2; ++q) { const f32x4 c = *(const f32x4*)(soc + 8 * q);
                u32x2 w; w.x = pk2(c[0] + rwin[4 * q] * g2, c[1] + rwin[4 * q + 1] * g2);
                w.y = pk2(c[2] + rwin[4 * q + 2] * g2, c[3] + rwin[4 * q + 3] * g2);
                *(u32x2*)(cat + 8 * q) = w; }
        }
    }
    __syncthreads();
}

constexpr int CW_Q13 = 4000;
constexpr int CW_BAR = 4096;
static_assert((CW_BAR + XCD_BAR_WORDS) * 4 <= (int)CTL_BYTES, "control block");

#define GEMM_CALL(FN, fnobj, Aoff, Boff, Mrows, Ncols, Kdim, cperm) do { \
    pg8::Gemm g_{(const pg8::bf16_t*)(a.ws + (Aoff)), (const pg8::bf16_t*)(a.ws + (Boff)), (Mrows), (Ncols), (Kdim)}; \
    pg8::StaticOrder S_; S_.init((Mrows), (Ncols), G, (cperm)); \
    EpiFn<FN> E_{fnobj}; \
    pg8::gemm_phase<EpiFn<FN>, pg8::StaticOrder, true, true>(lds, g_, S_, E_); } while (0)

__global__ void __launch_bounds__(NTHR, 2) yoco_fwd(Args a_) {
    extern __shared__ __attribute__((aligned(16))) unsigned char lds_raw[];
    LAS unsigned char* lds = (LAS unsigned char*)lds_raw;
    const int tid0 = threadIdx.x, wave0 = __builtin_amdgcn_readfirstlane(tid0 >> 6);
    const int G = gridDim.x, bx = blockIdx.x, ngw = G * NWAVES;
    volatile LAS unsigned* MISC = (volatile LAS unsigned*)(lds + MISC_OFF);
    for (int u = tid0; u < (LDS_BYTES - RING_BYTES) / 4; u += NTHR) ((LAS unsigned*)(lds + RING_BYTES))[u] = 0u;
    __syncthreads();
    XcdBarrier bar = xcd_barrier_post((unsigned*)(a_.ws + WS_CTL) + CW_BAR, MISC + 8);
#define PH ArgsRef a = *phase_args(); float* out = a.out; (void)out; int tid = tid0, wave = wave0; asm volatile("" : "+v"(tid)); asm volatile("" : "+s"(wave)); const int lane = tid & 63, gw = bx * NWAVES + wave; (void)lane; (void)gw;

    { PH wg_transpose_run(a, lds, bx, TL_A0 + (TL_END - TL_LATE1), G, [](int t) { return t < TL_A0 ? t : t - TL_A0 + TL_LATE1; }, tid); }
    { PH p0_prologue(a, lds, gw, ngw, wave, lane); }
    xcd_barrier(bar);
    { PH for (int it = bx; it < 256; it += G) cmpgemm_direct(a, lds, it, tid); }

    { PH
        FnA fa{(bf16*)(a.ws + WS_QA), (float*)(a.ws + WS_FA), (bf16*)(a.ws + WS_VA), (bf16*)(a.ws + WS_OGA), (bf16*)(a.ws + WS_MEMQ), (const float*)(a.ws + WS_LB)};
        EpiA ea{(bf16*)(a.ws + WS_QP), (bf16*)(a.ws + WS_KP), (bf16*)(a.ws + WS_KT), (bf16*)(a.ws + WS_VF), (float*)(a.ws + WS_DV), (bf16*)(a.ws + WS_OGA), (bf16*)(a.ws + WS_MEMQ), (const float*)(a.ws + WS_LB), fa};
        { pg8::Gemm g_{(const pg8::bf16_t*)(a.ws + WS_XN), (const pg8::bf16_t*)(a.ws + WS_BTA), MPAD, NA, 2048};
          pg8::StaticOrder S_; S_.init(MPAD, NA, G, bx);
          pg8::gemm_phase<EpiA, pg8::StaticOrder, true, true>(lds, g_, S_, ea); }
    }
    { PH
        FnM fm{out, (bf16*)(a.ws + WS_MK), (bf16*)(a.ws + WS_MVT)};
        GEMM_CALL(FnM, fm, WS_MEMPB, WS_BTM, 2048, 2048, 2048, (bx + 64) % G);
    }
    xcd_barrier(bar);

    { PH
        const bool split = G > 96;
        if (!split || bx < 96) { for (int k = bx; k < BP * NH; k += (split ? 96 : G)) hgrn_mfma_item(a, lds, k, tid); }
        if (!split || bx >= 96) {
            const int w2 = split ? bx - 96 : bx, nw = split ? G - 96 : G;
            for (int k = w2; k < BS * NH; k += nw) hgrn_sample_item(a, lds, k / NH, k % NH, tid);
            for (int it = (w2 + nw - 64 % nw) % nw; it < 256 + BS * MEMH; it += nw) memattn_wg(a, 0, it, lds, tid);
        }
    }
    __syncthreads();
    { PH
        constexpr int NREC = TL_LATE0 + 288;
        auto idm = [](int t) { return t; };
        if (G > 96) { if (bx < 96) wg_transpose_run(a, lds, TL_LATE0 + bx, NREC, 96, idm, tid);
                      else wg_transpose_run(a, lds, NREC + (bx - 96), TL_LATE1, G - 96, idm, tid); }
        else wg_transpose_run(a, lds, TL_LATE0 + bx, TL_LATE1, G, idm, tid);
    }
    xcd_barrier(bar);

    { PH FnO fo{(bf16*)(a.ws + WS_OB), D}; GEMM_CALL(FnO, fo, WS_CAT, WS_BTO0, MPR, D, 2048, bx);
      skinny_gemm<8>(fo, (const bf16*)(a.ws + WS_CAT) + (size_t)MPR * 2048, (const bf16*)(a.ws + WS_BTO0), D, 2048, lds, bx, G, tid); }
    xcd_barrier(bar);
    { PH normpass<true, false>(a, a.in[I_NG] + 1 * D, gw, ngw, lane); }
    xcd_barrier(bar);
    { PH EpiF1 ef{(bf16*)(a.ws + WS_HID), (float*)(a.ws + WS_FIX), (float*)(a.ws + WS_HALO), out, a.in[I_WCONV] + (size_t)0 * 3 * FF, a.in[I_BCONV] + (size_t)0 * FF, 0};
      { pg8::Gemm g_{(const pg8::bf16_t*)(a.ws + WS_XN), (const pg8::bf16_t*)(a.ws + WS_BTF10), MPR, FF2, 2048}; pg8::StaticOrder S_; S_.init(MPR, FF2, G, bx);
        pg8::gemm_phase<EpiF1, pg8::StaticOrder, true, true>(lds, g_, S_, ef); }
      FnF1 ff{(bf16*)(a.ws + WS_AB), out, 0};
      skinny_gemm<8>(ff, (const bf16*)(a.ws + WS_XN) + (size_t)MPR * 2048, (const bf16*)(a.ws + WS_BTF10), FF2, 2048, lds, bx, G, tid); }
    xcd_barrier(bar);
    { PH ffn_fixup(a, 0, bx * NTHR + tid, G * NTHR); gating_pass(a, 0, bx * NTHR + tid, G * NTHR); }
    xcd_barrier(bar);
    { PH FnO fo{(bf16*)(a.ws + WS_OB), D}; GEMM_CALL(FnO, fo, WS_HID, WS_BTF20, MPR, D, FF, bx);
      skinny_gemm<8>(fo, (const bf16*)(a.ws + WS_HID) + (size_t)MPR * FF, (const bf16*)(a.ws + WS_BTF20), D, FF, lds, bx, G, tid); }
    xcd_barrier(bar);
    { PH normpass<false, false>(a, a.in[I_NG] + 3 * D, gw, ngw, lane); }
    xcd_barrier(bar);

    { PH
        FnB fb{(bf16*)(a.ws + WS_QB), (bf16*)(a.ws + WS_MEMQ), (float*)(a.ws + WS_GATES), out, (bf16*)(a.ws + WS_KCMP), (bf16*)(a.ws + WS_VCMP),
               (bf16*)(a.ws + WS_KSEL), (bf16*)(a.ws + WS_VSELT), (bf16*)(a.ws + WS_KWIN), (bf16*)(a.ws + WS_VWINT)};
        GEMM_CALL(FnB, fb, WS_XN, WS_BTB, MPAD, NBM, 2048, bx);
    }
    xcd_barrier(bar);

    { PH FnC fk{(float*)(a.ws + WS_PPP), 256};
      skinny_gemm<8>(fk, (const bf16*)(a.ws + WS_KCMP), (const bf16*)(a.ws + WS_BTC), 256, 2048, lds, bx, G, tid, 64, 0); }
    { PH FnC fv{(float*)(a.ws + WS_PPP) + (size_t)2048 * 256, 256};
      skinny_gemm<8>(fv, (const bf16*)(a.ws + WS_VCMP), (const bf16*)(a.ws + WS_BTC) + (size_t)256 * 2048, 256, 2048, lds, (bx + G / 2) % G, G, tid, 64, 0); }
    { PH for (int it = bx; it < 256 + BS * MEMH; it += G) memattn_wg(a, 1, it, lds, tid); }
    { PH for (int it = 128 + gw; it < 128 + 2048; it += ngw) cmp2_item(a, it, lane); }
    xcd_barrier(bar);
    { PH for (int it = gw; it < 128; it += ngw) cmp2_item(a, it, lane); }
    xcd_barrier(bar);
    { PH for (int w = bx; w < 128; w += G) nsa_cmp_wg(a, lds, w, tid); }
    { PH for (int w = (bx + G - 128 % G) % G; w < 128; w += G) { sn_cmp_item(a, lds, 2 * w, tid); sn_cmp_item(a, lds, 2 * w + 1, tid); } }
    xcd_barrier(bar);
    { PH for (int it = bx; it < BS * 2; it += G) sn_selwin_mfma(a, lds, it, tid); }
    __syncthreads();
    { PH
        LAS unsigned* TK = (LAS unsigned*)(lds + RING_BYTES + 1024);
        unsigned* qctr = (unsigned*)(a.ws + WS_CTL) + CW_Q13;
        int grp = bx, par = 0;
        while (grp < 6144 / NWAVES) {
            unsigned nx = 0u;
            if (tid == 0) nx = atomicAdd(qctr, 1u);
            nsa_selwin_item(a, grp * NWAVES + wave, (LAS float*)(lds + wave * 16384), lane);
            if (tid == 0) TK[par] = nx;
            __syncthreads();
            grp = G + (int)TK[par]; par ^= 1;
        }
    }
    xcd_barrier(bar);

    { PH FnO fo{(bf16*)(a.ws + WS_OB), D}; GEMM_CALL(FnO, fo, WS_CAT, WS_BTO1, MPR, D, 2048, bx);
      skinny_gemm<8>(fo, (const bf16*)(a.ws + WS_CAT) + (size_t)MPR * 2048, (const bf16*)(a.ws + WS_BTO1), D, 2048, lds, bx, G, tid); }
    xcd_barrier(bar);
    { PH normpass<false, false>(a, a.in[I_NG] + 5 * D, gw, ngw, lane); }
    xcd_barrier(bar);
    { PH EpiF1 ef{(bf16*)(a.ws + WS_HID), (float*)(a.ws + WS_FIX), (float*)(a.ws + WS_HALO), out, a.in[I_WCONV] + (size_t)1 * 3 * FF, a.in[I_BCONV] + (size_t)1 * FF, 1};
      { pg8::Gemm g_{(const pg8::bf16_t*)(a.ws + WS_XN), (const pg8::bf16_t*)(a.ws + WS_BTF11), MPR, FF2, 2048}; pg8::StaticOrder S_; S_.init(MPR, FF2, G, bx);
        pg8::gemm_phase<EpiF1, pg8::StaticOrder, true, true>(lds, g_, S_, ef); }
      FnF1 ff{(bf16*)(a.ws + WS_AB), out, 1};
      skinny_gemm<8>(ff, (const bf16*)(a.ws + WS_XN) + (size_t)MPR * 2048, (const bf16*)(a.ws + WS_BTF11), FF2, 2048, lds, bx, G, tid); }
    xcd_barrier(bar);
    { PH ffn_fixup(a, 1, bx * NTHR + tid, G * NTHR); gating_pass(a, 1, bx * NTHR + tid, G * NTHR); }
    xcd_barrier(bar);
    { PH FnO fo{(bf16*)(a.ws + WS_OB), D}; GEMM_CALL(FnO, fo, WS_HID, WS_BTF21, MPR, D, FF, bx);
      skinny_gemm<8>(fo, (const bf16*)(a.ws + WS_HID) + (size_t)MPR * FF, (const bf16*)(a.ws + WS_BTF21), D, FF, lds, bx, G, tid); }
    xcd_barrier(bar);
    { PH normpass<false, true>(a, a.in[I_NG] + 7 * D, gw, ngw, lane); }
}

extern "C" void kernel_launch(void* const* d_in, const int* in_sizes, int n_in, void* d_out, int out_size, void* d_ws, size_t ws_size, hipStream_t stream) {
    static int grid = 0;
    if (grid == 0) {
        if (n_in != 25 || out_size != (int)O_END || ws_size < WS_END) { fprintf(stderr, "kernel_launch: unexpected shapes (n_in %d out %d ws %zu, need ws %zu)\n", n_in, out_size, ws_size, (size_t)WS_END); grid = -1; return; }
        int dev = 0, cus = 0, per_cu = 0;
        if (hipGetDevice(&dev) != hipSuccess || hipDeviceGetAttribute(&cus, hipDeviceAttributeMultiprocessorCount, dev) != hipSuccess) { grid = -1; return; }
        if (hipFuncSetAttribute((const void*)yoco_fwd, hipFuncAttributeMaxDynamicSharedMemorySize, LDS_BYTES) != hipSuccess) { fprintf(stderr, "kernel_launch: hipFuncSetAttribute failed\n"); grid = -1; return; }
        if (hipOccupancyMaxActiveBlocksPerMultiprocessor(&per_cu, (const void*)yoco_fwd, NTHR, LDS_BYTES) != hipSuccess || per_cu < 1)
            fprintf(stderr, "kernel_launch: note: occupancy query reports %d workgroups per CU\n", per_cu);
        (void)hipGetLastError();
        grid = cus;
    }
    if (grid < 0) return;
    if (hipMemsetAsync((char*)d_ws + WS_CTL + (size_t)CW_Q13 * 4, 0, (size_t)(CW_BAR - CW_Q13 + XCD_BAR_WORDS) * 4, stream) != hipSuccess) { fprintf(stderr, "kernel_launch: memset failed\n"); return; }
    Args a{};
    for (int i = 0; i < 25; ++i) a.in[i] = (const float*)d_in[i];
    a.out = (float*)d_out; a.ws = (unsigned char*)d_ws;
    hipLaunchKernelGGL(yoco_fwd, dim3(grid), dim3(NTHR), LDS_BYTES, stream, a);
    const hipError_t le = hipPeekAtLastError();
    if (le != hipSuccess) fprintf(stderr, "kernel_launch: launch failed: %s\n", hipGetErrorName(le));
}
```
